# Optimizing an MI355X kernel written in HIP

```python
import math
import jax, jax.numpy as jnp
from jax import lax
import numpy as np


D_MODEL = 1024
BATCH = 16
SEQ = 4096
DEPTH = 1

CHUNK = 64
Q_BLOCK = 128
MEM_LEN = 256
DA_HEADS = 4
DA_DH = 64
DA_WIDTH = DA_HEADS * 2 * DA_DH
RW_HEADS = 4
RW_DH = 64
RW_WIDTH = RW_HEADS * RW_DH
RW_DECAY_RANK = 64
RW_A_RANK = 64
RW_GATE_RANK = 128
RW_COLS = 3 * RW_WIDTH + RW_DECAY_RANK + RW_A_RANK + RW_GATE_RANK
XA_HEADS = 4
XA_DH = 64
XA_WIDTH = XA_HEADS * XA_DH
N_BRANCH = 3
PROJ_COLS = 3 * DA_WIDTH + RW_COLS + XA_WIDTH + N_BRANCH * D_MODEL
D_FF = 2816
ROPE_THETA = 500000.0
ROT_DIM = DA_DH // 4
EPS = 1e-6
RW_GN_EPS = 64e-5

kernel_name = 'hybrid_diffattn_rwkv7_memxattn_macaron'


def rms_norm(x, gain):
    xf = x.astype(jnp.float32)
    y = xf * lax.rsqrt(jnp.mean(xf * xf, axis=-1, keepdims=True) + EPS)
    return (y * gain.astype(jnp.float32)).astype(x.dtype)


def swiglu_half_step(x, norm_g, w1, w3, w2):
    h = rms_norm(x, norm_g)
    return x + 0.5 * ((jax.nn.silu(h @ w1) * (h @ w3)) @ w2)


def apply_partial_rope(t, positions):
    half = ROT_DIM // 2
    inv_freq = jnp.power(jnp.float32(ROPE_THETA), -jnp.arange(half, dtype=jnp.float32) * (2.0 / ROT_DIM))
    ang = positions.astype(jnp.float32)[..., None] * inv_freq
    cos = jnp.cos(ang)[:, :, None, :]
    sin = jnp.sin(ang)[:, :, None, :]
    tr = t[..., :ROT_DIM].astype(jnp.float32)
    t1, t2 = tr[..., :half], tr[..., half:]
    rot = jnp.concatenate([t1 * cos - t2 * sin, t2 * cos + t1 * sin], axis=-1).astype(t.dtype)
    return jnp.concatenate([rot, t[..., ROT_DIM:]], axis=-1)


def diff_attention(q, k, v, lam, positions):
    B, S, _ = q.shape
    q = apply_partial_rope(q.reshape(B, S, 2 * DA_HEADS, DA_DH), positions)
    k = apply_partial_rope(k.reshape(B, S, 2 * DA_HEADS, DA_DH), positions)
    q = q.reshape(B, S, DA_HEADS, 2, DA_DH).transpose(0, 2, 3, 1, 4)
    k = k.reshape(B, S, DA_HEADS, 2, DA_DH).transpose(0, 2, 3, 1, 4)
    v = v.reshape(B, S, DA_HEADS, 2 * DA_DH).transpose(0, 2, 1, 3)
    scale = DA_DH ** -0.5
    outs = []
    for i in range(S // Q_BLOCK):
        q0 = i * Q_BLOCK
        kv_len = q0 + Q_BLOCK
        s = jnp.einsum('bhmqd,bhmkd->bhmqk', q[:, :, :, q0:kv_len], k[:, :, :, :kv_len]).astype(jnp.float32) * scale
        q_chunk = (q0 + jnp.arange(Q_BLOCK)) // CHUNK
        k_chunk = jnp.arange(kv_len) // CHUNK
        allowed = k_chunk[None, :] <= q_chunk[:, None]
        p = jax.nn.softmax(jnp.where(allowed, s, -jnp.inf), axis=-1)
        attn = p[:, :, 0] - lam * p[:, :, 1]
        outs.append(jnp.einsum('bhqk,bhkd->bhqd', attn.astype(v.dtype), v[:, :, :kv_len]))
    return jnp.concatenate(outs, axis=2)


def token_shift(u, mu):
    prev = jnp.pad(u, ((0, 0), (1, 0), (0, 0)))[:, :-1]
    return u + (prev - u) * mu


def rwkv7_recurrence(r, w, k, v, a_vec, b_vec):
    B, S, H, N = r.shape

    def step(state, inp):
        r_t, w_t, k_t, v_t, a_t, b_t = inp
        sa = jnp.einsum('bhij,bhj->bhi', state, a_t)
        state = state * w_t[:, :, None, :] + sa[..., None] * b_t[:, :, None, :] + v_t[..., None] * k_t[:, :, None, :]
        return state, jnp.einsum('bhij,bhj->bhi', state, r_t)

    seq_first = lambda t: jnp.swapaxes(t, 0, 1)
    xs = (seq_first(r), seq_first(w), seq_first(k), seq_first(v), seq_first(a_vec), seq_first(b_vec))
    _, ys = lax.scan(step, jnp.zeros((B, H, N, N), jnp.float32), xs)
    return jnp.swapaxes(ys, 0, 1)


def rwkv7_time_mix(u, mu, w0, w2, a0, a2, g2, k_k, k_a, r_k, ln_w, ln_b):
    B, S, _ = u.shape
    u = token_shift(u, mu)
    i1 = RW_WIDTH
    i2 = 2 * RW_WIDTH
    i3 = 3 * RW_WIDTH
    i4 = i3 + RW_DECAY_RANK
    i5 = i4 + RW_A_RANK
    r, k, v, dw, da, dg = jnp.split(u, [i1, i2, i3, i4, i5], axis=-1)
    w_log = -jax.nn.softplus(-(w0 + jnp.tanh(dw) @ w2).astype(jnp.float32)) - 0.5
    decay = jnp.exp(-jnp.exp(w_log))
    a = jax.nn.sigmoid((a0 + da @ a2).astype(jnp.float32))
    g = (jax.nn.sigmoid(dg) @ g2).astype(jnp.float32)
    heads = lambda t: t.astype(jnp.float32).reshape(B, S, RW_HEADS, RW_DH)
    per_head = lambda p: p.astype(jnp.float32).reshape(RW_HEADS, RW_DH)
    r_h, k_h, v_h, a_h, w_h = heads(r), heads(k), heads(v), heads(a), heads(decay)
    kk = k_h * per_head(k_k)
    kk = kk / jnp.maximum(jnp.sqrt(jnp.sum(kk * kk, axis=-1, keepdims=True)), 1e-12)
    k_h = k_h * (1.0 + (a_h - 1.0) * per_head(k_a))
    y = rwkv7_recurrence(r_h, w_h, k_h, v_h, -kk, kk * a_h)
    mean = jnp.mean(y, axis=-1, keepdims=True)
    var = jnp.mean(jnp.square(y - mean), axis=-1, keepdims=True)
    y = (y - mean) * lax.rsqrt(var + RW_GN_EPS) * per_head(ln_w) + per_head(ln_b)
    y = y + jnp.sum(r_h * k_h * per_head(r_k), axis=-1, keepdims=True) * v_h
    return (y.reshape(B, S, RW_WIDTH) * g).astype(u.dtype)


def memory_attention(q, mem_h, w_kv):
    B, S, _ = q.shape
    M = mem_h.shape[1]
    k, v = jnp.split(mem_h @ w_kv, 2, axis=-1)
    q = q.reshape(B, S, XA_HEADS, XA_DH)
    k = k.reshape(B, M, XA_HEADS, XA_DH)
    v = v.reshape(B, M, XA_HEADS, XA_DH)
    s = jnp.einsum('bqhd,bkhd->bhqk', q, k).astype(jnp.float32) * (XA_DH ** -0.5)
    p = jax.nn.softmax(s, axis=-1)
    o = jnp.einsum('bhqk,bkhd->bqhd', p.astype(v.dtype), v)
    return o.reshape(B, S, XA_WIDTH)


def setup_inputs(seed: int = 0) -> dict:
    key = jax.random.key(seed)
    ks = iter(jax.random.split(key, 48))
    nrm = lambda shape, scale: jax.random.normal(next(ks), shape, jnp.float32) * scale
    gain = lambda shape: 1.0 + 0.02 * jax.random.normal(next(ks), shape, jnp.float32)
    L = DEPTH
    offsets = jax.random.randint(next(ks), (BATCH,), 0, 64) * CHUNK
    positions = (offsets[:, None] + jnp.arange(SEQ)[None, :]).astype(jnp.int32)
    return {
        'x': nrm((BATCH, SEQ, D_MODEL), 1.0),
        'mem': nrm((BATCH, MEM_LEN, D_MODEL), 1.0),
        'positions': positions,
        'ffn1_norm': gain((L, D_MODEL)),
        'ffn1_w1': nrm((L, D_MODEL, D_FF), D_MODEL ** -0.5),
        'ffn1_w3': nrm((L, D_MODEL, D_FF), D_MODEL ** -0.5),
        'ffn1_w2': nrm((L, D_FF, D_MODEL), D_FF ** -0.5),
        'mix_norm': gain((L, D_MODEL)),
        'w_in': nrm((L, D_MODEL, PROJ_COLS), D_MODEL ** -0.5),
        'gate_bias': nrm((L, N_BRANCH * D_MODEL), 0.02),
        'da_lambda_q1': nrm((L, DA_DH), 0.1),
        'da_lambda_k1': nrm((L, DA_DH), 0.1),
        'da_lambda_q2': nrm((L, DA_DH), 0.1),
        'da_lambda_k2': nrm((L, DA_DH), 0.1),
        'da_subln': gain((L, 2 * DA_DH)),
        'rw_mu': jax.random.uniform(next(ks), (L, RW_COLS), jnp.float32),
        'rw_w0': -1.0 - 5.0 * jax.random.uniform(next(ks), (L, RW_WIDTH), jnp.float32),
        'rw_w2': nrm((L, RW_DECAY_RANK, RW_WIDTH), 0.1 * RW_DECAY_RANK ** -0.5),
        'rw_a0': nrm((L, RW_WIDTH), 0.1),
        'rw_a2': nrm((L, RW_A_RANK, RW_WIDTH), 0.1 * RW_A_RANK ** -0.5),
        'rw_g2': nrm((L, RW_GATE_RANK, RW_WIDTH), RW_GATE_RANK ** -0.5),
        'rw_k_k': 0.85 + nrm((L, RW_WIDTH), 0.02),
        'rw_k_a': gain((L, RW_WIDTH)),
        'rw_r_k': nrm((L, RW_WIDTH), 0.1),
        'rw_ln_w': gain((L, RW_WIDTH)),
        'rw_ln_b': nrm((L, RW_WIDTH), 0.02),
        'mem_norm': gain((L, D_MODEL)),
        'w_mem_kv': nrm((L, D_MODEL, 2 * XA_WIDTH), D_MODEL ** -0.5),
        'w_up_a': nrm((L, DA_WIDTH, D_MODEL), DA_WIDTH ** -0.5),
        'w_up_b': nrm((L, RW_WIDTH, D_MODEL), RW_WIDTH ** -0.5),
        'w_up_c': nrm((L, XA_WIDTH, D_MODEL), XA_WIDTH ** -0.5),
        'w_out': nrm((L, D_MODEL, D_MODEL), D_MODEL ** -0.5),
        'ffn2_norm': gain((L, D_MODEL)),
        'ffn2_w1': nrm((L, D_MODEL, D_FF), D_MODEL ** -0.5),
        'ffn2_w3': nrm((L, D_MODEL, D_FF), D_MODEL ** -0.5),
        'ffn2_w2': nrm((L, D_FF, D_MODEL), D_FF ** -0.5),
        'final_norm': gain((D_MODEL,)),
    }


def reference(x, mem, positions, ffn1_norm, ffn1_w1, ffn1_w3, ffn1_w2, mix_norm, w_in, gate_bias,
              da_lambda_q1, da_lambda_k1, da_lambda_q2, da_lambda_k2, da_subln,
              rw_mu, rw_w0, rw_w2, rw_a0, rw_a2, rw_g2, rw_k_k, rw_k_a, rw_r_k, rw_ln_w, rw_ln_b,
              mem_norm, w_mem_kv, w_up_a, w_up_b, w_up_c, w_out,
              ffn2_norm, ffn2_w1, ffn2_w3, ffn2_w2, final_norm):
    B, S, D = x.shape
    c1 = DA_WIDTH
    c2 = 2 * DA_WIDTH
    c3 = 3 * DA_WIDTH
    c4 = c3 + RW_COLS
    c5 = c4 + XA_WIDTH
    for l in range(DEPTH):
        x = swiglu_half_step(x, ffn1_norm[l], ffn1_w1[l], ffn1_w3[l], ffn1_w2[l])
        h = rms_norm(x, mix_norm[l])
        proj = h @ w_in[l]
        q_da, k_da, v_da, u_rw, q_x, gate_lin = jnp.split(proj, [c1, c2, c3, c4, c5], axis=-1)
        lam_init = 0.8 - 0.6 * math.exp(-0.3 * l)
        lam = (jnp.exp(jnp.sum(da_lambda_q1[l] * da_lambda_k1[l]).astype(jnp.float32))
               - jnp.exp(jnp.sum(da_lambda_q2[l] * da_lambda_k2[l]).astype(jnp.float32)) + lam_init)
        o_a = diff_attention(q_da, k_da, v_da, lam, positions)
        o_a = rms_norm(o_a, da_subln[l]) * (1.0 - lam_init)
        o_a = o_a.transpose(0, 2, 1, 3).reshape(B, S, DA_WIDTH)
        o_b = rwkv7_time_mix(u_rw, rw_mu[l], rw_w0[l], rw_w2[l], rw_a0[l], rw_a2[l], rw_g2[l],
                             rw_k_k[l], rw_k_a[l], rw_r_k[l], rw_ln_w[l], rw_ln_b[l])
        o_c = memory_attention(q_x, rms_norm(mem, mem_norm[l]), w_mem_kv[l])
        gates = jax.nn.sigmoid((gate_lin + gate_bias[l]).astype(jnp.float32)).astype(x.dtype)
        gates = gates.reshape(B, S, N_BRANCH, D)
        merged = (gates[:, :, 0] * (o_a @ w_up_a[l])
                  + gates[:, :, 1] * (o_b @ w_up_b[l])
                  + gates[:, :, 2] * (o_c @ w_up_c[l]))
        x = x + merged @ w_out[l]
        x = swiglu_half_step(x, ffn2_norm[l], ffn2_w1[l], ffn2_w3[l], ffn2_w2[l])
    return rms_norm(x, final_norm)
```

```cpp
#include <hip/hip_runtime.h>
#include <hip/hip_cooperative_groups.h>
#include <cstdio>
namespace pg8 {
#define PG8_LAS __attribute__((address_space(3)))
typedef unsigned short bf16_t;
typedef short bf16x8 __attribute__((ext_vector_type(8)));
typedef float f32x4 __attribute__((ext_vector_type(4)));
typedef unsigned u32x4 __attribute__((ext_vector_type(4)));
constexpr int BM = 256, BK = 64, HALF = 128, HTB = HALF * BK * 2  , STAGE_BYTES = 8 * HTB, NXCD = 8, WGM = 8;

__host__ __device__ __forceinline__ int lds_byte(int r, int c) { const int st = (r >> 4) * 2 + (c >> 5), rr = r & 15, cc = c & 31, ob = rr * 64 + cc * 2; return st * 1024 + (ob ^ (((ob >> 9) & 1) << 5)); }
__host__ __device__ __forceinline__ void stage_rc(int b, int& R, int& C) { const int st = b / 1024, sb = b % 1024, swz = sb ^ (((sb >> 9) & 1) << 5); R = (st >> 1) * 16 + swz / 64; C = (st & 1) * 32 + (swz % 64) / 2; }
__host__ __device__ __forceinline__ int perm32(int rho) { const int n = rho >> 4, i = rho & 15; return 8 * (i >> 2) + 4 * n + (i & 3); }

struct Unit { int pm, pn; };
struct Gemm { const bf16_t* A; const bf16_t* Bt; int M, N, K; };

struct StaticOrder {
    int nM, nN, nwg, G, c;
    __host__ __device__ void init(int M, int N, int G_, int c_) { nM = M / BM; nN = N / BM; nwg = nM * nN; G = G_; c = c_; }
    __host__ __device__ bool next(int i, Unit& u) const {
        const long L = (long)i * G + c; if (L >= nwg) return false;
        int wgid = (int)L; { const int q = nwg / NXCD, r = nwg % NXCD, xcd = wgid % NXCD, off = wgid / NXCD; wgid = (xcd < r ? xcd * (q + 1) : r * (q + 1) + (xcd - r) * q) + off; }
        const int nig = WGM * nN, gid = wgid / nig, fm = gid * WGM, gsz = (nM - fm) < WGM ? (nM - fm) : WGM;
        u.pm = fm + ((wgid % nig) % gsz); u.pn = (wgid % nig) / gsz; return true;
    }
    __device__ __forceinline__ void a_ready(const Unit&) const {}
    __device__ __forceinline__ void done(const Unit&) const {}
};
typedef float f32x2_c __attribute__((ext_vector_type(2))); typedef __bf16 bf16x2_c __attribute__((ext_vector_type(2)));
__device__ __forceinline__ unsigned cvt_pk_bf16(float lo, float hi) { const f32x2_c v = {lo, hi}; const bf16x2_c b = __builtin_convertvector(v, bf16x2_c); return __builtin_bit_cast(unsigned, b); }
template <class Epi, class Sched, bool STAMP = false>
__device__ __forceinline__ void gemm_phase(PG8_LAS unsigned char* lds, const Gemm g, const Sched& S, const Epi& E, unsigned long long* stamps) {
    int tid_l = threadIdx.x; asm volatile("" : "+v"(tid_l)); const int tid = tid_l, wid = __builtin_amdgcn_readfirstlane(tid >> 6), lane = tid & 63, wr = wid >> 2, wc = wid & 3, fr = lane & 15, fq = lane >> 4;
    const int K = g.K, nt = K / BK;
    int ts_lo = 0, ts_hi = 0, nts = 0; const unsigned long long rt_entry = STAMP ? (unsigned long long)wall_clock64() : 0ull;
#define PG8_STAMP() do { if (STAMP && wid == 0 && nts < 64) { const unsigned long long _c = (unsigned long long)clock64(); \
        ts_lo = (lane == nts) ? (int)(unsigned)_c : ts_lo; ts_hi = (lane == nts) ? (int)(unsigned)(_c >> 32) : ts_hi; ++nts; } } while (0)
    PG8_STAMP();
    unsigned voffA[2], voffB[2];
#pragma unroll
    for (int i = 0; i < 2; ++i) { int R, C; stage_rc(tid * 16 + i * 8192, R, C); const int Rb = Epi::PERM ? ((R & ~31) + perm32(R & 31)) : R;
        voffA[i] = (unsigned)(R * K + C) * 2u; voffB[i] = (unsigned)(Rb * K + C) * 2u; }
    const size_t kstep = (size_t)(BK * 2);
    const size_t hstep = (size_t)HALF * K * 2;
    const size_t tstep = 2 * hstep;
    const unsigned ldsw = (unsigned)wid * 1024u;
    const int aoff = lds_byte(wr * 64 + fr, fq * 8), boff = lds_byte(wc * 32 + fr, fq * 8);
#define PG8_SA(b, h) (((b) * 2 + (h)) * HTB)
#define PG8_SB(b, h) ((4 + (b) * 2 + (h)) * HTB)
#define PG8_STAGE(bufoff, gbase, voff) do { _Pragma("unroll") for (int _i = 0; _i < 2; ++_i) \
        __builtin_amdgcn_global_load_lds((const unsigned*)((const char*)(gbase) + (voff)[_i]), (PG8_LAS unsigned*)(lds + (bufoff) + ldsw + _i * 8192), 16, 0, 0); } while (0)
#define PG8_LDA(dst, b, h) do { _Pragma("unroll") for (int m = 0; m < 4; ++m) _Pragma("unroll") for (int k = 0; k < 2; ++k) dst[m][k] = *(const PG8_LAS bf16x8*)(lds + PG8_SA(b, h) + aoff + m * 2048 + k * 1024); } while (0)
#define PG8_LDB(dst, b, h) do { _Pragma("unroll") for (int n = 0; n < 2; ++n) _Pragma("unroll") for (int k = 0; k < 2; ++k) dst[n][k] = *(const PG8_LAS bf16x8*)(lds + PG8_SB(b, h) + boff + n * 2048 + k * 1024); } while (0)
#define PG8_MMA(ai, bj, At, Bt) do { __builtin_amdgcn_s_setprio(1); _Pragma("unroll") for (int m = 0; m < 4; ++m) _Pragma("unroll") for (int n = 0; n < 2; ++n) _Pragma("unroll") for (int k = 0; k < 2; ++k) \
        acc[ai][bj][m][n] = __builtin_amdgcn_mfma_f32_16x16x32_bf16(Bt[n][k], At[m][k], acc[ai][bj][m][n], 0, 0, 0); __builtin_amdgcn_s_setprio(0); } while (0)
#define PG8_WAIT_V(n) asm volatile("s_waitcnt vmcnt(" #n ")" ::: "memory")
#define PG8_WAIT_L(n) asm volatile("s_waitcnt lgkmcnt(" #n ")" ::: "memory")
#define PG8_BAR __builtin_amdgcn_s_barrier()
#define PG8_SCHED __builtin_amdgcn_sched_barrier(0)
    Unit cur, nxt; int ui = 0;
    if (!S.next(0, cur)) return;
    f32x4 acc[2][2][4][2];
#pragma unroll
    for (int a = 0; a < 2; ++a)
#pragma unroll
        for (int b = 0; b < 2; ++b)
#pragma unroll
            for (int m = 0; m < 4; ++m)
#pragma unroll
                for (int n = 0; n < 2; ++n) acc[a][b][m][n] = (f32x4){0.f, 0.f, 0.f, 0.f};
    bf16x8 At[4][2], B0[2][2], B1[2][2];
    const char* cA = (const char*)g.A + (size_t)cur.pm * tstep; const char* cB = (const char*)g.Bt + (size_t)cur.pn * tstep;
    S.a_ready(cur);
    PG8_STAGE(PG8_SB(0, 0), cB, voffB); PG8_STAGE(PG8_SA(0, 0), cA, voffA); PG8_STAGE(PG8_SB(0, 1), cB + hstep, voffB); PG8_STAGE(PG8_SA(0, 1), cA + hstep, voffA);
    if (wr == 1) PG8_BAR;
    PG8_WAIT_V(4); PG8_BAR;
    PG8_STAGE(PG8_SB(1, 0), cB + kstep, voffB); PG8_STAGE(PG8_SA(1, 0), cA + kstep, voffA); PG8_STAGE(PG8_SB(1, 1), cB + hstep + kstep, voffB);
    PG8_WAIT_V(6); PG8_BAR;
    PG8_STAMP();
    for (;;) {
        const bool has_next = S.next(ui + 1, nxt);
        const char* nA = has_next ? (const char*)g.A + (size_t)nxt.pm * tstep : cA; const char* nB = has_next ? (const char*)g.Bt + (size_t)nxt.pn * tstep : cB;
        for (int t = 0; t < nt; t += 2) {
            const bool last = (t == nt - 2);
            const char* a1 = cA + (size_t)(t + 1) * kstep;
            const char* a2 = last ? nA : cA + (size_t)(t + 2) * kstep; const char* b2 = last ? nB : cB + (size_t)(t + 2) * kstep;
            const char* a3 = a2 + kstep; const char* b3 = b2 + kstep;
            if (last && has_next) S.a_ready(nxt);
            PG8_LDB(B0, 0, 0); PG8_SCHED; PG8_LDA(At, 0, 0); PG8_STAGE(PG8_SA(1, 1), a1 + hstep, voffA);
            PG8_WAIT_L(8); PG8_BAR; PG8_WAIT_L(0); PG8_MMA(0, 0, At, B0); PG8_BAR; PG8_SCHED;
            PG8_LDB(B1, 0, 1); PG8_STAGE(PG8_SB(0, 0), b2, voffB);
            PG8_BAR; PG8_WAIT_L(0); PG8_MMA(0, 1, At, B1); PG8_BAR;
            PG8_LDA(At, 0, 1); PG8_STAGE(PG8_SA(0, 0), a2, voffA);
            PG8_BAR; PG8_WAIT_L(0); PG8_MMA(1, 0, At, B0); PG8_BAR; PG8_SCHED;
            PG8_STAGE(PG8_SB(0, 1), b2 + hstep, voffB);
            PG8_WAIT_V(6); PG8_BAR; PG8_MMA(1, 1, At, B1); PG8_BAR;
            PG8_LDB(B0, 1, 0); PG8_SCHED; PG8_LDA(At, 1, 0); PG8_STAGE(PG8_SA(0, 1), a2 + hstep, voffA);
            PG8_WAIT_L(8); PG8_BAR; PG8_WAIT_L(0); PG8_MMA(0, 0, At, B0); PG8_BAR; PG8_SCHED;
            PG8_LDB(B1, 1, 1); PG8_STAGE(PG8_SB(1, 0), b3, voffB);
            PG8_BAR; PG8_WAIT_L(0); PG8_MMA(0, 1, At, B1); PG8_BAR;
            PG8_LDA(At, 1, 1); PG8_STAGE(PG8_SA(1, 0), a3, voffA);
            PG8_BAR; PG8_WAIT_L(0); PG8_MMA(1, 0, At, B0); PG8_BAR; PG8_SCHED;
            PG8_STAGE(PG8_SB(1, 1), b3 + hstep, voffB);
            PG8_WAIT_V(6); PG8_BAR; PG8_MMA(1, 1, At, B1); PG8_BAR;
        }
        PG8_STAMP();
        if constexpr (!Epi::AFTER_DRAIN) { E(acc, cur, wr, wc, fr, fq); S.done(cur); }
        PG8_STAMP();
        if (!has_next) break;
#pragma unroll
        for (int a = 0; a < 2; ++a)
#pragma unroll
            for (int b = 0; b < 2; ++b)
#pragma unroll
                for (int m = 0; m < 4; ++m)
#pragma unroll
                    for (int n = 0; n < 2; ++n) acc[a][b][m][n] = (f32x4){0.f, 0.f, 0.f, 0.f};
        cur = nxt; cA = nA; cB = nB; ++ui;
    }
    PG8_WAIT_V(0);
    if (wr == 0) PG8_BAR;
    PG8_BAR;
    if constexpr (Epi::AFTER_DRAIN) { E.fused(acc, cur, wr, wc, fr, fq, lds, wid, lane); S.done(cur); }
    PG8_STAMP();
    if (STAMP && wid == 0) { stamps[lane] = lane < nts ? (((unsigned long long)(unsigned)ts_hi << 32) | (unsigned)ts_lo) : 0ull;
        if (lane == 62) stamps[62] = rt_entry; if (lane == 63) stamps[63] = (unsigned long long)wall_clock64(); }
#undef PG8_STAMP
#undef PG8_SA
#undef PG8_SB
#undef PG8_STAGE
#undef PG8_LDA
#undef PG8_LDB
#undef PG8_MMA
#undef PG8_WAIT_V
#undef PG8_WAIT_L
#undef PG8_BAR
#undef PG8_SCHED
}
}
namespace cg = cooperative_groups;
using pg8::bf16_t; using pg8::bf16x8; using pg8::f32x4; using pg8::cvt_pk_bf16; using pg8::Unit; using pg8::Gemm; using pg8::StaticOrder;
typedef unsigned u32x2 __attribute__((ext_vector_type(2)));
typedef unsigned u32x4 __attribute__((ext_vector_type(4)));
#define LAS PG8_LAS

constexpr int T = 65536, SEQ = 4096, DM = 1024, DFF = 2816, PCOLS = 5888, PLO = 2816, MEMT = 4096;
constexpr int NSCAN = 64;
#ifndef RUN_SCAN
#define RUN_SCAN 1
#endif
#ifndef RUN_ATTN
#define RUN_ATTN 1
#endif
#ifndef EXPORT
#define EXPORT 0
#endif
#ifndef RUN_MIX
#define RUN_MIX 1
#endif
#ifndef RUN_FFN2
#define RUN_FFN2 1
#endif

constexpr size_t W_UP1 = 0;
constexpr size_t W_DN1 = W_UP1 + (size_t)5632 * 1024 * 2;
constexpr size_t W_UP2 = W_DN1 + (size_t)1024 * 2816 * 2;
constexpr size_t W_DN2 = W_UP2 + (size_t)5632 * 1024 * 2;
constexpr size_t W_INLO = W_DN2 + (size_t)1024 * 2816 * 2;
constexpr size_t W_GATE = W_INLO + (size_t)2816 * 1024 * 2;
constexpr size_t W_UPA = W_GATE + (size_t)3072 * 1024 * 2;
constexpr size_t W_UPB = W_UPA + (size_t)1024 * 512 * 2;
constexpr size_t W_UPC = W_UPB + (size_t)1024 * 256 * 2;
constexpr size_t W_OUT = W_UPC + (size_t)1024 * 256 * 2;
constexpr size_t W_MKV = W_OUT + (size_t)1024 * 1024 * 2;
constexpr size_t W_LR = W_MKV + (size_t)512 * 1024 * 2;
constexpr size_t WS_ACT = W_LR + (size_t)768 * 256 * 2;
constexpr size_t WS_H = WS_ACT + (size_t)T * 2816 * 2;
constexpr size_t WS_DEC = WS_H + (size_t)T * 1024 * 2;
constexpr size_t WS_ASG = WS_DEC + (size_t)T * 256 * 4;
constexpr size_t WS_GG = WS_ASG + (size_t)T * 256 * 2;
constexpr size_t WS_OA = WS_GG + (size_t)T * 256 * 2;
constexpr size_t WS_OB = WS_OA + (size_t)T * 512 * 2;
constexpr size_t WS_OC = WS_OB + (size_t)T * 256 * 2;
constexpr size_t WS_ALR = WS_OC + (size_t)T * 256 * 2;
constexpr size_t WS_CS = WS_ALR + (size_t)T * 256 * 2;
constexpr size_t WS_HM = WS_CS + (size_t)T * 16 * 4;
constexpr size_t WS_KVM = WS_HM + (size_t)MEMT * 1024 * 2;
constexpr size_t WS_BAR = WS_KVM + (size_t)MEMT * 512 * 2;
constexpr size_t WS_END = WS_BAR + 256;

struct Params {
    const float* x; const float* mem; const int* pos;
    const float *ffn1_norm, *ffn1_w1, *ffn1_w3, *ffn1_w2, *mix_norm, *w_in, *gate_bias;
    const float *lq1, *lk1, *lq2, *lk2, *subln;
    const float *rw_mu, *rw_w0, *rw_w2, *rw_a0, *rw_a2, *rw_g2, *rw_k_k, *rw_k_a, *rw_r_k, *rw_ln_w, *rw_ln_b;
    const float *mem_norm, *w_mem_kv, *w_up_a, *w_up_b, *w_up_c, *w_out;
    const float *ffn2_norm, *ffn2_w1, *ffn2_w3, *ffn2_w2, *final_norm;
    float* out; unsigned char* ws;
};

__constant__ float INVF[8] = {1.0f, 0.1939227432012558f, 0.03760603070259094f, 0.007292664609849453f, 0.0014142135623842478f,
                              0.00027424818836152554f, 5.3182957344688475e-05f, 1.0313385246263351e-05f};

__device__ __forceinline__ float bf2f(bf16_t b) { return __uint_as_float(((unsigned)b) << 16); }
__device__ __forceinline__ float bflo(unsigned w) { return __uint_as_float(w << 16); }
__device__ __forceinline__ float bfhi(unsigned w) { return __uint_as_float(w & 0xffff0000u); }
__device__ __forceinline__ bf16_t f2bf(float f) { return (bf16_t)(cvt_pk_bf16(f, 0.f) & 0xffffu); }
__device__ __forceinline__ float wave_sum(float v) {
#pragma unroll
    for (int o = 32; o; o >>= 1) v += __shfl_xor(v, o);
    return v;
}
__device__ __forceinline__ float fast_rcp(float x) { return __builtin_amdgcn_rcpf(x); }
__device__ __forceinline__ float sigmoidf_(float x) { return fast_rcp(1.0f + __expf(-x)); }
__device__ __forceinline__ int opaque_tid() { int t = threadIdx.x; asm volatile("" : "+v"(t)); return t; }
#define DPP_F(v, ctrl) __int_as_float(__builtin_amdgcn_update_dpp(0, __float_as_int(v), ctrl, 0xF, 0xF, true))
__device__ __forceinline__ float red8(float v) { v += DPP_F(v, 0xB1); v += DPP_F(v, 0x4E); v += DPP_F(v, 0x141); return v; }

template <class F>
__device__ __forceinline__ void conv_w(bf16_t* dst, int N, int K, F src, LAS unsigned char* lds) {
    LAS float* tl = (LAS float*)lds;
    const int tid = opaque_tid(), kt = K >> 6, ntiles = (N >> 6) * kt;
    for (int tile = blockIdx.x; tile < ntiles; tile += gridDim.x) {
        const int R0 = (tile / kt) * 64, k0 = (tile % kt) * 64;
#pragma unroll
        for (int j = 0; j < 8; ++j) { const int e = tid + 512 * j, r = e & 63, kk = e >> 6; tl[r * 65 + kk] = src(R0 + r, k0 + kk); }
        __syncthreads();
        { const int r = tid >> 3, k8 = (tid & 7) * 8; LAS const float* p = tl + r * 65 + k8;
          u32x4 w; w.x = cvt_pk_bf16(p[0], p[1]); w.y = cvt_pk_bf16(p[2], p[3]); w.z = cvt_pk_bf16(p[4], p[5]); w.w = cvt_pk_bf16(p[6], p[7]);
          *(u32x4*)(dst + (size_t)(R0 + r) * K + k0 + k8) = w; }
        __syncthreads();
    }
}
__device__ __forceinline__ int perm_col(int R, bool rope) {
    const int Gb = R & ~31, rho = R & 31, n = rho >> 4, fq = (rho >> 2) & 3, e = rho & 3;
    int d;
    if (rope && (Gb & 32) == 0) d = fq < 2 ? 4 * fq + 8 * n + e : 16 + (fq - 2) * 8 + 4 * n + e;
    else d = 8 * fq + 4 * n + e;
    return Gb + d;
}

__device__ __forceinline__ void norm_rows(const float* in, const float* gain, bf16_t* outb, float* outf, int rows) {
    const int tid = opaque_tid(), wave = tid >> 6, lane = tid & 63;
    for (int row = blockIdx.x * 8 + wave; row < rows; row += gridDim.x * 8) {
        const float4* p = (const float4*)(in + (size_t)row * 1024);
        float4 v[4]; float ss = 0.f;
#pragma unroll
        for (int j = 0; j < 4; ++j) { v[j] = p[j * 64 + lane]; ss += v[j].x * v[j].x + v[j].y * v[j].y + v[j].z * v[j].z + v[j].w * v[j].w; }
        ss = wave_sum(ss);
        const float r = rsqrtf(ss * (1.0f / 1024.0f) + 1e-6f);
#pragma unroll
        for (int j = 0; j < 4; ++j) {
            const float4 g = ((const float4*)gain)[j * 64 + lane];
            float4 y; y.x = v[j].x * r * g.x; y.y = v[j].y * r * g.y; y.z = v[j].z * r * g.z; y.w = v[j].w * r * g.w;
            if (outf) ((float4*)(outf + (size_t)row * 1024))[j * 64 + lane] = y;
            else { u32x2 w; w.x = cvt_pk_bf16(y.x, y.y); w.y = cvt_pk_bf16(y.z, y.w); *(u32x2*)(outb + (size_t)row * 1024 + (j * 64 + lane) * 4) = w; }
        }
    }
}

struct EpiSwiglu {
    static constexpr bool PERM = false, AFTER_DRAIN = false;
    bf16_t* act;
    __device__ __forceinline__ void operator()(const f32x4 (&acc)[2][2][4][2], const Unit& u, int wr, int wc, int fr, int fq) const {
        const int row0 = u.pm * 256 + wr * 64 + fr;
#pragma unroll
        for (int ai = 0; ai < 2; ++ai)
#pragma unroll
            for (int m = 0; m < 4; ++m) { bf16_t* rowp = act + (size_t)(row0 + ai * 128 + m * 16) * DFF;
#pragma unroll
                for (int bj = 0; bj < 2; ++bj) { const int G = 8 * u.pn + 4 * bj + wc; const f32x4 g = acc[ai][bj][m][0], v = acc[ai][bj][m][1];
                    float o[4];
#pragma unroll
                    for (int e = 0; e < 4; ++e) o[e] = g[e] * fast_rcp(1.0f + __expf(-g[e])) * v[e];
                    u32x2 w; w.x = cvt_pk_bf16(o[0], o[1]); w.y = cvt_pk_bf16(o[2], o[3]);
                    *(u32x2*)(rowp + 16 * G + 4 * fq) = w; } }
    }
};
struct EpiRes {
    static constexpr bool PERM = false, AFTER_DRAIN = false;
    const float* res; float* out; float scale;
    __device__ __forceinline__ void operator()(const f32x4 (&acc)[2][2][4][2], const Unit& u, int wr, int wc, int fr, int fq) const {
        const int row0 = u.pm * 256 + wr * 64 + fr, col0 = u.pn * 256 + wc * 32 + 4 * fq;
#pragma unroll
        for (int ai = 0; ai < 2; ++ai)
#pragma unroll
            for (int m = 0; m < 4; ++m) { const size_t off = (size_t)(row0 + ai * 128 + m * 16) * 1024 + col0;
#pragma unroll
                for (int bj = 0; bj < 2; ++bj)
#pragma unroll
                    for (int n = 0; n < 2; ++n) { const f32x4 r = *(const f32x4*)(res + off + bj * 128 + n * 16);
                        *(f32x4*)(out + off + bj * 128 + n * 16) = r + acc[ai][bj][m][n] * scale; } }
    }
};
struct EpiPerm {
    static constexpr bool PERM = false, AFTER_DRAIN = false;
    bf16_t* O; int ld; const float* cs;
    __device__ __forceinline__ void operator()(const f32x4 (&acc)[2][2][4][2], const Unit& u, int wr, int wc, int fr, int fq) const {
        const int row0 = u.pm * 256 + wr * 64 + fr;
        const bool rope = cs != nullptr && u.pn < 4 && (wc & 1) == 0 && fq < 2;
#pragma unroll
        for (int ai = 0; ai < 2; ++ai)
#pragma unroll
            for (int m = 0; m < 4; ++m) { const int row = row0 + ai * 128 + m * 16; bf16_t* rowp = O + (size_t)row * ld;
                f32x4 c4 = {1.f, 1.f, 1.f, 1.f}, s4 = {0.f, 0.f, 0.f, 0.f};
                if (rope) { const float* t = cs + (size_t)row * 16 + fq * 8; const f32x4 a = *(const f32x4*)t, b = *(const f32x4*)(t + 4);
                    c4[0] = a[0]; s4[0] = a[1]; c4[1] = a[2]; s4[1] = a[3]; c4[2] = b[0]; s4[2] = b[1]; c4[3] = b[2]; s4[3] = b[3]; }
#pragma unroll
                for (int bj = 0; bj < 2; ++bj) { const f32x4 x1 = acc[ai][bj][m][0], x2 = acc[ai][bj][m][1];
                    const f32x4 y1 = x1 * c4 - x2 * s4, y2 = x2 * c4 + x1 * s4;
                    u32x4 w; w.x = cvt_pk_bf16(y1[0], y1[1]); w.y = cvt_pk_bf16(y1[2], y1[3]); w.z = cvt_pk_bf16(y2[0], y2[1]); w.w = cvt_pk_bf16(y2[2], y2[3]);
                    *(u32x4*)(rowp + u.pn * 256 + bj * 128 + wc * 32 + 8 * fq) = w; } }
    }
};
struct EpiLR {
    static constexpr bool PERM = false, AFTER_DRAIN = false;
    float* dec; bf16_t* asg; bf16_t* gg; const float* w0; const float* a0;
    __device__ __forceinline__ void operator()(const f32x4 (&acc)[2][2][4][2], const Unit& u, int wr, int wc, int fr, int fq) const {
        const int row0 = u.pm * 256 + wr * 64 + fr, col0 = wc * 32 + 4 * fq;
#pragma unroll
        for (int ai = 0; ai < 2; ++ai)
#pragma unroll
            for (int m = 0; m < 4; ++m) { const size_t off = (size_t)(row0 + ai * 128 + m * 16) * 256 + col0;
#pragma unroll
                for (int bj = 0; bj < 2; ++bj)
#pragma unroll
                    for (int n = 0; n < 2; ++n) { const int c = col0 + bj * 128 + n * 16; const size_t o = off + bj * 128 + n * 16; const f32x4 a = acc[ai][bj][m][n];
                        if (u.pn == 0) { const f32x4 b = *(const f32x4*)(w0 + c); f32x4 d;
#pragma unroll
                            for (int e = 0; e < 4; ++e) { const float z = -(b[e] + a[e]);
                                const float sp = fmaxf(z, 0.f) + __logf(1.0f + __expf(-fabsf(z)));
                                d[e] = __expf(-__expf(-sp - 0.5f)); }
                            *(f32x4*)(dec + o) = d; }
                        else if (u.pn == 1) { const f32x4 b = *(const f32x4*)(a0 + c); u32x2 w;
                            w.x = cvt_pk_bf16(sigmoidf_(b[0] + a[0]), sigmoidf_(b[1] + a[1])); w.y = cvt_pk_bf16(sigmoidf_(b[2] + a[2]), sigmoidf_(b[3] + a[3]));
                            *(u32x2*)(asg + o) = w; }
                        else { u32x2 w; w.x = cvt_pk_bf16(a[0], a[1]); w.y = cvt_pk_bf16(a[2], a[3]); *(u32x2*)(gg + o) = w; } } }
    }
};
struct EpiTmp {
    static constexpr bool PERM = false, AFTER_DRAIN = false;
    float* tmp;
    __device__ __forceinline__ void operator()(const f32x4 (&acc)[2][2][4][2], const Unit& u, int wr, int wc, int fr, int fq) const {
        const int row0 = u.pm * 256 + wr * 64 + fr, col0 = u.pn * 256 + wc * 32 + 4 * fq;
#pragma unroll
        for (int ai = 0; ai < 2; ++ai)
#pragma unroll
            for (int m = 0; m < 4; ++m) { const size_t off = (size_t)(row0 + ai * 128 + m * 16) * 1024 + col0;
#pragma unroll
                for (int bj = 0; bj < 2; ++bj)
#pragma unroll
                    for (int n = 0; n < 2; ++n) *(f32x4*)(tmp + off + bj * 128 + n * 16) = acc[ai][bj][m][n]; }
    }
};
struct EpiGate {
    static constexpr bool PERM = false, AFTER_DRAIN = false;
    const float* tmp; const float* bias; bf16_t* merged; int first;
    __device__ __forceinline__ void operator()(const f32x4 (&acc)[2][2][4][2], const Unit& u, int wr, int wc, int fr, int fq) const {
        const int row0 = u.pm * 256 + wr * 64 + fr, col0 = u.pn * 256 + wc * 32 + 4 * fq;
#pragma unroll
        for (int ai = 0; ai < 2; ++ai)
#pragma unroll
            for (int m = 0; m < 4; ++m) { const size_t off = (size_t)(row0 + ai * 128 + m * 16) * 1024 + col0;
#pragma unroll
                for (int bj = 0; bj < 2; ++bj)
#pragma unroll
                    for (int n = 0; n < 2; ++n) { const size_t o = off + bj * 128 + n * 16; const f32x4 tv = *(const f32x4*)(tmp + o), b = *(const f32x4*)(bias + col0 + bj * 128 + n * 16), a = acc[ai][bj][m][n];
                        f32x4 v;
#pragma unroll
                        for (int e = 0; e < 4; ++e) v[e] = sigmoidf_(a[e] + b[e]) * tv[e];
                        if (!first) { const u32x2 old = *(const u32x2*)(merged + o); v[0] += bflo(old.x); v[1] += bfhi(old.x); v[2] += bflo(old.y); v[3] += bfhi(old.y); }
                        u32x2 w; w.x = cvt_pk_bf16(v[0], v[1]); w.y = cvt_pk_bf16(v[2], v[3]); *(u32x2*)(merged + o) = w; } }
    }
};

template <class Epi>
__device__ __forceinline__ void run_gemm(LAS unsigned char* lds, const bf16_t* A, const bf16_t* Bt, int M, int N, int K, const Epi& E) {
    Gemm g; g.A = A; g.Bt = Bt; g.M = M; g.N = N; g.K = K;
    StaticOrder S; S.init(M, N, (int)gridDim.x, (int)blockIdx.x);
    pg8::gemm_phase<Epi, StaticOrder, false>(lds, g, S, E, nullptr);
    __syncthreads();
}

constexpr int KSTR = 144, VSTR = 136;
constexpr int LK0 = 0, LK1 = 64 * KSTR, LVT = 2 * 64 * KSTR, LEX = 36864;
constexpr float SC_LOG2E = 0.125f * 1.4426950408889634f;

template <int DV, bool TWO>
__device__ __forceinline__ void attn_core(LAS unsigned char* lds, const bf16_t* Qw, int ldq, const bf16_t* K0p, const bf16_t* K1p, int ldk,
                                          const bf16_t* Vp, int ldv, int ntiles, bool skip_last, f32x4 (&o)[DV / 16][2]) {
    const int tid = opaque_tid(), wave = tid >> 6, lane = tid & 63, r = lane & 15, quad = lane >> 4;
    const int kmap = TWO ? (wave >> 2) : 0;
    bf16x8 qf[2][2];
#pragma unroll
    for (int qt = 0; qt < 2; ++qt)
#pragma unroll
        for (int ks = 0; ks < 2; ++ks) qf[qt][ks] = *(const bf16x8*)(Qw + (size_t)(qt * 16 + r) * ldq + ks * 32 + quad * 8);
    float mrow[2] = {-INFINITY, -INFINITY}, lrow[2] = {0.f, 0.f};
#pragma unroll
    for (int dt = 0; dt < DV / 16; ++dt) { o[dt][0] = (f32x4){0.f, 0.f, 0.f, 0.f}; o[dt][1] = (f32x4){0.f, 0.f, 0.f, 0.f}; }
    u32x4 kreg[2], vreg[2];
    const int k_map = TWO ? (tid >> 8) : 0, k_row = TWO ? ((tid >> 2) & 63) : (tid >> 3), k_d = TWO ? (tid & 3) * 16 : (tid & 7) * 8;
    const bf16_t* kbase = (k_map ? K1p : K0p) + (size_t)k_row * ldk + k_d;
    const bool v_on = (DV == 128) || tid < 256;
    const int v_kp = (DV == 128) ? (tid >> 4) : (tid >> 3), v_dg = (DV == 128) ? (tid & 15) : (tid & 7);
    const bf16_t* vbase = Vp + (size_t)(2 * v_kp) * ldv + v_dg * 8;
    auto gload = [&](int tile) {
        const bf16_t* kp = kbase + (size_t)tile * 64 * ldk;
        kreg[0] = *(const u32x4*)kp; if (TWO) kreg[1] = *(const u32x4*)(kp + 8);
        if (v_on) { const bf16_t* vp = vbase + (size_t)tile * 64 * ldv; vreg[0] = *(const u32x4*)vp; vreg[1] = *(const u32x4*)(vp + ldv); }
    };
    gload(0);
    for (int tile = 0; tile < ntiles; ++tile) {
        __syncthreads();
        { LAS unsigned char* kd = lds + (k_map ? LK1 : LK0) + k_row * KSTR + k_d * 2;
          *(LAS u32x4*)kd = kreg[0]; if (TWO) *(LAS u32x4*)(kd + 16) = kreg[1];
          if (v_on) {
#pragma unroll
              for (int e = 0; e < 8; ++e) { const unsigned a = vreg[0][e >> 1], b = vreg[1][e >> 1];
                  const unsigned w = (e & 1) ? ((a >> 16) | (b & 0xffff0000u)) : ((a & 0xffffu) | (b << 16));
                  *(LAS unsigned*)(lds + LVT + (v_dg * 8 + e) * VSTR + v_kp * 4) = w; } } }
        __syncthreads();
        if (tile + 1 < ntiles) gload(tile + 1);
        if (skip_last && tile == ntiles - 1) continue;
        f32x4 s[4][2];
#pragma unroll
        for (int kt = 0; kt < 4; ++kt) { s[kt][0] = (f32x4){0.f, 0.f, 0.f, 0.f}; s[kt][1] = (f32x4){0.f, 0.f, 0.f, 0.f};
#pragma unroll
            for (int ks = 0; ks < 2; ++ks) { const bf16x8 kf = *(const LAS bf16x8*)(lds + (kmap ? LK1 : LK0) + (kt * 16 + r) * KSTR + (ks * 32 + quad * 8) * 2);
                s[kt][0] = __builtin_amdgcn_mfma_f32_16x16x32_bf16(kf, qf[0][ks], s[kt][0], 0, 0, 0);
                s[kt][1] = __builtin_amdgcn_mfma_f32_16x16x32_bf16(kf, qf[1][ks], s[kt][1], 0, 0, 0); } }
        bf16x8 pb[2][2];
#pragma unroll
        for (int qt = 0; qt < 2; ++qt) {
            float mx = s[0][qt][0];
#pragma unroll
            for (int kt = 0; kt < 4; ++kt)
#pragma unroll
                for (int j = 0; j < 4; ++j) mx = fmaxf(mx, s[kt][qt][j]);
            mx = fmaxf(mx, __shfl_xor(mx, 16)); mx = fmaxf(mx, __shfl_xor(mx, 32));
            const float mn = fmaxf(mrow[qt], mx * SC_LOG2E);
            const float alpha = __builtin_amdgcn_exp2f(mrow[qt] - mn); mrow[qt] = mn;
            float ps = 0.f; float p[4][4];
#pragma unroll
            for (int kt = 0; kt < 4; ++kt)
#pragma unroll
                for (int j = 0; j < 4; ++j) { p[kt][j] = __builtin_amdgcn_exp2f(s[kt][qt][j] * SC_LOG2E - mn); ps += p[kt][j]; }
            lrow[qt] = lrow[qt] * alpha + ps;
#pragma unroll
            for (int dt = 0; dt < DV / 16; ++dt) o[dt][qt] *= alpha;
#pragma unroll
            for (int kk = 0; kk < 2; ++kk) { u32x4 w; w.x = cvt_pk_bf16(p[2 * kk][0], p[2 * kk][1]); w.y = cvt_pk_bf16(p[2 * kk][2], p[2 * kk][3]);
                w.z = cvt_pk_bf16(p[2 * kk + 1][0], p[2 * kk + 1][1]); w.w = cvt_pk_bf16(p[2 * kk + 1][2], p[2 * kk + 1][3]);
                pb[qt][kk] = __builtin_bit_cast(bf16x8, w); }
        }
#pragma unroll
        for (int dt = 0; dt < DV / 16; ++dt)
#pragma unroll
            for (int kk = 0; kk < 2; ++kk) { LAS const unsigned char* vp = lds + LVT + (dt * 16 + r) * VSTR + (32 * kk + quad * 4) * 2;
                const u32x2 lo = *(LAS const u32x2*)vp, hi = *(LAS const u32x2*)(vp + 32);
                u32x4 w; w.x = lo.x; w.y = lo.y; w.z = hi.x; w.w = hi.y; const bf16x8 vf = __builtin_bit_cast(bf16x8, w);
                o[dt][0] = __builtin_amdgcn_mfma_f32_16x16x32_bf16(vf, pb[0][kk], o[dt][0], 0, 0, 0);
                o[dt][1] = __builtin_amdgcn_mfma_f32_16x16x32_bf16(vf, pb[1][kk], o[dt][1], 0, 0, 0); }
    }
#pragma unroll
    for (int qt = 0; qt < 2; ++qt) { float l = lrow[qt]; l += __shfl_xor(l, 16); l += __shfl_xor(l, 32); const float inv = 1.0f / l;
#pragma unroll
        for (int dt = 0; dt < DV / 16; ++dt) o[dt][qt] *= inv; }
}

__device__ __forceinline__ void attention_phase(const Params& P, LAS unsigned char* lds, int widx, int nw) {
    const int tid = opaque_tid(), wave = tid >> 6, lane = tid & 63, r = lane & 15, quad = lane >> 4;
    const bf16_t* proj = (const bf16_t*)(P.ws + WS_ACT);
    const bf16_t* kvm = (const bf16_t*)(P.ws + WS_KVM);
    bf16_t* oa = (bf16_t*)(P.ws + WS_OA); bf16_t* oc = (bf16_t*)(P.ws + WS_OC);
    float lam;
    { const float s1 = wave_sum(P.lq1[lane] * P.lk1[lane]), s2 = wave_sum(P.lq2[lane] * P.lk2[lane]); lam = expf(s1) - expf(s2) + 0.2f; }
    for (int it = widx; it < 2048; it += nw) {
        const int qb = 31 - (it >> 6), bh = it & 63, b = bh >> 2, h = bh & 3, map = wave >> 2, wq = wave & 3;
        const size_t tok0 = (size_t)b * SEQ;
        const int q0 = qb * 128 + wq * 32;
        f32x4 o[8][2];
        attn_core<128, true>(lds, proj + (tok0 + q0) * PLO + (2 * h + map) * 64, PLO, proj + tok0 * PLO + 512 + (2 * h) * 64, proj + tok0 * PLO + 512 + (2 * h + 1) * 64, PLO,
                             proj + tok0 * PLO + 1024 + h * 128, PLO, 2 * qb + 2, wq < 2, o);
        LAS float* ex = (LAS float*)(lds + LEX) + (size_t)wq * 4096 + lane;
        if (map == 1) {
#pragma unroll
            for (int dt = 0; dt < 8; ++dt)
#pragma unroll
                for (int qt = 0; qt < 2; ++qt)
#pragma unroll
                    for (int j = 0; j < 4; ++j) ex[((dt * 2 + qt) * 4 + j) * 64] = o[dt][qt][j] * lam;
        }
        __syncthreads();
        if (map == 0) {
#pragma unroll
            for (int qt = 0; qt < 2; ++qt) { float ss = 0.f;
#pragma unroll
                for (int dt = 0; dt < 8; ++dt)
#pragma unroll
                    for (int j = 0; j < 4; ++j) { const float v = o[dt][qt][j] - ex[((dt * 2 + qt) * 4 + j) * 64]; o[dt][qt][j] = v; ss += v * v; }
                ss += __shfl_xor(ss, 16); ss += __shfl_xor(ss, 32);
                const float rs = rsqrtf(ss * (1.0f / 128.0f) + 1e-6f) * 0.8f;
                bf16_t* op = oa + (tok0 + q0 + qt * 16 + r) * 512 + h * 128 + quad * 4;
#pragma unroll
                for (int dt = 0; dt < 8; ++dt) { const f32x4 g = *(const f32x4*)(P.subln + dt * 16 + quad * 4); const f32x4 v = o[dt][qt] * g * rs;
                    u32x2 w; w.x = cvt_pk_bf16(v[0], v[1]); w.y = cvt_pk_bf16(v[2], v[3]); *(u32x2*)(op + dt * 16) = w; } }
        }
    }
    for (int it = widx; it < 1024; it += nw) {
        const int qblk = it >> 2, hx = it & 3, b = qblk >> 4;
        const size_t tokq = (size_t)qblk * 256 + wave * 32;
        f32x4 o[4][2];
        attn_core<64, false>(lds, proj + tokq * PLO + 2560 + hx * 64, PLO, kvm + (size_t)b * 256 * 512 + hx * 64, nullptr, 512,
                             kvm + (size_t)b * 256 * 512 + 256 + hx * 64, 512, 4, false, o);
#pragma unroll
        for (int qt = 0; qt < 2; ++qt) { bf16_t* op = oc + (tokq + qt * 16 + r) * 256 + hx * 64 + quad * 4;
#pragma unroll
            for (int dt = 0; dt < 4; ++dt) { const f32x4 v = o[dt][qt]; u32x2 w; w.x = cvt_pk_bf16(v[0], v[1]); w.y = cvt_pk_bf16(v[2], v[3]); *(u32x2*)(op + dt * 16) = w; } }
    }
}

__device__ __forceinline__ void rwkv_scan(const Params& P, LAS unsigned char* lds, int bh) {
    const int b = bh >> 2, h = bh & 3, tid = opaque_tid(), wave = tid >> 6, lane = tid & 63;
    LAS float* vec = (LAS float*)lds;
    LAS float* ybuf = vec + 16 * 384;
    const bf16_t* proj = (const bf16_t*)(P.ws + WS_ACT);
    const float* dec = (const float*)(P.ws + WS_DEC);
    const bf16_t* asg = (const bf16_t*)(P.ws + WS_ASG);
    const bf16_t* ggp = (const bf16_t*)(P.ws + WS_GG);
    bf16_t* ob = (bf16_t*)(P.ws + WS_OB);
    const int c = h * 64 + lane;
    const float mu_r = P.rw_mu[c], mu_k = P.rw_mu[256 + c], mu_v = P.rw_mu[512 + c];
    const float kkp = P.rw_k_k[c], kap = P.rw_k_a[c], rkp = P.rw_r_k[c], lnw = P.rw_ln_w[c], lnb = P.rw_ln_b[c];
    const int i = tid >> 3, g8 = (tid & 7) * 8;
    float s0 = 0.f, s1 = 0.f, s2 = 0.f, s3 = 0.f, s4 = 0.f, s5 = 0.f, s6 = 0.f, s7 = 0.f;
    float ur[2], urp[2], uk[2], ukp[2], uv[2], uvp[2], dc[2], as_[2], gr[2];
    float vcur[2], boncur[2], gcur[2];
    const size_t tokb = (size_t)b * SEQ;
    auto load_raw = [&](int blk) {
#pragma unroll
        for (int q = 0; q < 2; ++q) { const int tt = blk * 16 + wave + 8 * q; const size_t tok = tokb + tt;
            const bf16_t* base = proj + tok * PLO + 1536 + c;
            ur[q] = bf2f(base[0]); uk[q] = bf2f(base[256]); uv[q] = bf2f(base[512]);
            if (tt > 0) { urp[q] = bf2f(*(base - PLO)); ukp[q] = bf2f(*(base - PLO + 256)); uvp[q] = bf2f(*(base - PLO + 512)); }
            else { urp[q] = 0.f; ukp[q] = 0.f; uvp[q] = 0.f; }
            dc[q] = dec[tok * 256 + c]; as_[q] = bf2f(asg[tok * 256 + c]); gr[q] = bf2f(ggp[tok * 256 + c]); }
    };
    auto prep = [&]() {
#pragma unroll
        for (int q = 0; q < 2; ++q) { const int tl = wave + 8 * q;
            const float rr = ur[q] + (urp[q] - ur[q]) * mu_r, kx = uk[q] + (ukp[q] - uk[q]) * mu_k, vv = uv[q] + (uvp[q] - uv[q]) * mu_v;
            float kk = kx * kkp; const float nrm = sqrtf(wave_sum(kk * kk)); kk = kk / fmaxf(nrm, 1e-12f);
            const float a = as_[q]; const float kmod = kx * (1.0f + (a - 1.0f) * kap);
            const float bon = wave_sum(rr * kmod * rkp);
            LAS float* vt = vec + tl * 384 + lane;
            vt[0] = rr; vt[64] = dc[q]; vt[128] = kmod; vt[192] = -kk; vt[256] = kk * a; vt[320] = vv;
            vcur[q] = vv; boncur[q] = bon; gcur[q] = gr[q]; }
    };
    load_raw(0); prep(); __syncthreads();
    for (int blk = 0; blk < SEQ / 16; ++blk) {
        if (blk + 1 < SEQ / 16) load_raw(blk + 1);
#pragma unroll 2
        for (int t = 0; t < 16; ++t) { LAS const float* vt = vec + t * 384;
            const f32x4 a0 = *(LAS const f32x4*)(vt + 192 + g8), a1 = *(LAS const f32x4*)(vt + 192 + g8 + 4);
            float sa = s0 * a0[0] + s1 * a0[1] + s2 * a0[2] + s3 * a0[3] + s4 * a1[0] + s5 * a1[1] + s6 * a1[2] + s7 * a1[3];
            sa = red8(sa);
            const f32x4 w0 = *(LAS const f32x4*)(vt + 64 + g8), w1 = *(LAS const f32x4*)(vt + 64 + g8 + 4);
            const f32x4 b0 = *(LAS const f32x4*)(vt + 256 + g8), b1 = *(LAS const f32x4*)(vt + 256 + g8 + 4);
            const f32x4 k0 = *(LAS const f32x4*)(vt + 128 + g8), k1 = *(LAS const f32x4*)(vt + 128 + g8 + 4);
            const float vi = vt[320 + i];
            s0 = s0 * w0[0] + (sa * b0[0] + vi * k0[0]); s1 = s1 * w0[1] + (sa * b0[1] + vi * k0[1]);
            s2 = s2 * w0[2] + (sa * b0[2] + vi * k0[2]); s3 = s3 * w0[3] + (sa * b0[3] + vi * k0[3]);
            s4 = s4 * w1[0] + (sa * b1[0] + vi * k1[0]); s5 = s5 * w1[1] + (sa * b1[1] + vi * k1[1]);
            s6 = s6 * w1[2] + (sa * b1[2] + vi * k1[2]); s7 = s7 * w1[3] + (sa * b1[3] + vi * k1[3]);
            const f32x4 r0 = *(LAS const f32x4*)(vt + g8), r1 = *(LAS const f32x4*)(vt + g8 + 4);
            float y = s0 * r0[0] + s1 * r0[1] + s2 * r0[2] + s3 * r0[3] + s4 * r1[0] + s5 * r1[1] + s6 * r1[2] + s7 * r1[3];
            y = red8(y);
            if ((tid & 7) == 0) ybuf[t * 64 + i] = y; }
        __syncthreads();
#pragma unroll
        for (int q = 0; q < 2; ++q) { const int tl = wave + 8 * q; const size_t tok = tokb + blk * 16 + tl;
            const float y = ybuf[tl * 64 + lane]; const float mean = wave_sum(y) * (1.0f / 64.0f); const float d = y - mean;
            const float var = wave_sum(d * d) * (1.0f / 64.0f);
            float yn = d * rsqrtf(var + 64e-5f) * lnw + lnb; yn += boncur[q] * vcur[q];
            ob[tok * 256 + c] = f2bf(yn * gcur[q]); }
        if (blk + 1 < SEQ / 16) prep();
        __syncthreads();
    }
}


__device__ __forceinline__ void my_grid_sync(unsigned* bar, unsigned target) {
    asm volatile("s_waitcnt vmcnt(0) lgkmcnt(0)" ::: "memory");
    __syncthreads();
    if (threadIdx.x == 0) {
        __builtin_amdgcn_fence(__ATOMIC_RELEASE, "agent");
        __hip_atomic_fetch_add(bar, 1u, __ATOMIC_RELAXED, __HIP_MEMORY_SCOPE_AGENT);
        while (__hip_atomic_load(bar, __ATOMIC_RELAXED, __HIP_MEMORY_SCOPE_AGENT) < target) __builtin_amdgcn_s_sleep(2);
    }
    __syncthreads();
    __builtin_amdgcn_fence(__ATOMIC_ACQUIRE, "agent");
    asm volatile("s_waitcnt vmcnt(0) lgkmcnt(0)" ::: "memory");
}
#define GRID_SYNC() do { ++sync_no; my_grid_sync((unsigned*)(ws + WS_BAR), sync_no * gridDim.x); } while (0)
__global__ void __launch_bounds__(512, 2) fwd_megakernel(Params P) {
    extern __shared__ __attribute__((aligned(16))) unsigned char shm[];
    LAS unsigned char* lds = (LAS unsigned char*)shm;
    cg::grid_group grid = cg::this_grid();
    unsigned char* ws = P.ws;
    const int nth = gridDim.x * 512;
#define GTID ((int)blockIdx.x * 512 + opaque_tid())
    bf16_t* H = (bf16_t*)(ws + WS_H); bf16_t* ACT = (bf16_t*)(ws + WS_ACT); float* X = P.out;
    float* CS = (float*)(ws + WS_CS);
    unsigned sync_no = 0;
    grid.sync();

#ifndef NREP
#define NREP 1
#endif
    for (int rep = 0; rep < NREP; ++rep) {
    { const float *w1 = P.ffn1_w1, *w3 = P.ffn1_w3, *w2 = P.ffn1_w2;
      conv_w((bf16_t*)(ws + W_UP1), 5632, 1024, [=](int R, int k) { const int G = R >> 5, n = (R >> 4) & 1, i = R & 15; return (n ? w3 : w1)[(size_t)k * DFF + 16 * G + i]; }, lds);
      conv_w((bf16_t*)(ws + W_DN1), 1024, 2816, [=](int R, int k) { return w2[(size_t)k * 1024 + R]; }, lds); }
    { const float *w1 = P.ffn2_w1, *w3 = P.ffn2_w3, *w2 = P.ffn2_w2;
      conv_w((bf16_t*)(ws + W_UP2), 5632, 1024, [=](int R, int k) { const int G = R >> 5, n = (R >> 4) & 1, i = R & 15; return (n ? w3 : w1)[(size_t)k * DFF + 16 * G + i]; }, lds);
      conv_w((bf16_t*)(ws + W_DN2), 1024, 2816, [=](int R, int k) { return w2[(size_t)k * 1024 + R]; }, lds); }
    { const float* wi = P.w_in;
      conv_w((bf16_t*)(ws + W_INLO), 2816, 1024, [=](int R, int k) { return wi[(size_t)k * PCOLS + perm_col(R, R < 1024)]; }, lds);
      conv_w((bf16_t*)(ws + W_GATE), 3072, 1024, [=](int R, int k) { return wi[(size_t)k * PCOLS + 2816 + R]; }, lds); }
    { const float *ua = P.w_up_a, *ub = P.w_up_b, *uc = P.w_up_c, *wo = P.w_out, *mk = P.w_mem_kv;
      conv_w((bf16_t*)(ws + W_UPA), 1024, 512, [=](int R, int k) { return ua[(size_t)k * 1024 + R]; }, lds);
      conv_w((bf16_t*)(ws + W_UPB), 1024, 256, [=](int R, int k) { return ub[(size_t)k * 1024 + R]; }, lds);
      conv_w((bf16_t*)(ws + W_UPC), 1024, 256, [=](int R, int k) { return uc[(size_t)k * 1024 + R]; }, lds);
      conv_w((bf16_t*)(ws + W_OUT), 1024, 1024, [=](int R, int k) { return wo[(size_t)k * 1024 + R]; }, lds);
      conv_w((bf16_t*)(ws + W_MKV), 512, 1024, [=](int R, int k) { return mk[(size_t)k * 512 + perm_col(R, false)]; }, lds); }
    { const float *w2 = P.rw_w2, *a2 = P.rw_a2, *g2 = P.rw_g2;
      conv_w((bf16_t*)(ws + W_LR), 768, 256, [=](int R, int k) { float v = 0.f;
          if (R < 256) { if (k < 64) v = w2[k * 256 + R]; }
          else if (R < 512) { if (k >= 64 && k < 128) v = a2[(k - 64) * 256 + (R - 256)]; }
          else { if (k >= 128) v = g2[(k - 128) * 256 + (R - 512)]; }
          return v; }, lds); }
    norm_rows(P.x, P.ffn1_norm, H, nullptr, T);
    norm_rows(P.mem, P.mem_norm, (bf16_t*)(ws + WS_HM), nullptr, MEMT);
    for (int idx = GTID; idx < T * 8; idx += nth) {
        const int t = idx >> 3, i = idx & 7;
        const float ang = (float)P.pos[t] * INVF[i];
        const double rev = (double)ang * 0.15915494309189535; const double fr = rev - rint(rev); const double rr = fr * 6.283185307179586, r2 = rr * rr;
        double cterm = 1.0, sterm = rr, cc = 1.0, sn = rr;
#pragma unroll
        for (int k = 1; k <= 14; ++k) { cterm *= -r2 * (1.0 / ((2.0 * k - 1.0) * (2.0 * k))); sterm *= -r2 * (1.0 / ((2.0 * k) * (2.0 * k + 1.0))); cc += cterm; sn += sterm; }
        CS[idx * 2] = (float)cc; CS[idx * 2 + 1] = (float)sn;
    }
    GRID_SYNC();
    { EpiSwiglu e; e.act = ACT; run_gemm(lds, H, (const bf16_t*)(ws + W_UP1), T, 5632, 1024, e); }
    { EpiPerm e; e.O = (bf16_t*)(ws + WS_KVM); e.ld = 512; e.cs = nullptr; run_gemm(lds, (const bf16_t*)(ws + WS_HM), (const bf16_t*)(ws + W_MKV), MEMT, 512, 1024, e); }
    GRID_SYNC();
    { EpiRes e; e.res = P.x; e.out = X; e.scale = 0.5f; run_gemm(lds, ACT, (const bf16_t*)(ws + W_DN1), T, 1024, 2816, e); }
    GRID_SYNC();
#if RUN_MIX
    norm_rows(X, P.mix_norm, H, nullptr, T);
    GRID_SYNC();
    { EpiPerm e; e.O = ACT; e.ld = PLO; e.cs = CS; run_gemm(lds, H, (const bf16_t*)(ws + W_INLO), T, 2816, 1024, e); }
    GRID_SYNC();
    { bf16_t* alr = (bf16_t*)(ws + WS_ALR);
      for (int idx = GTID; idx < T * 32; idx += nth) {
          const int t = idx >> 5, col = (idx & 31) * 8;
          const bf16_t* up = ACT + (size_t)t * PLO + 1536 + 768 + col;
          const u32x4 cur = *(const u32x4*)up; u32x4 prv = {0u, 0u, 0u, 0u}; if ((t & (SEQ - 1)) != 0) prv = *(const u32x4*)(up - PLO);
          const f32x4 m0 = *(const f32x4*)(P.rw_mu + 768 + col), m1 = *(const f32x4*)(P.rw_mu + 768 + col + 4);
          float v[8];
#pragma unroll
          for (int e = 0; e < 8; ++e) { const float cu = (e & 1) ? bfhi(cur[e >> 1]) : bflo(cur[e >> 1]), pv = (e & 1) ? bfhi(prv[e >> 1]) : bflo(prv[e >> 1]);
              const float mu = e < 4 ? m0[e & 3] : m1[e & 3]; const float xs = cu + (pv - cu) * mu;
              v[e] = col < 64 ? (1.0f - 2.0f * fast_rcp(__expf(2.0f * xs) + 1.0f)) : (col < 128 ? xs : sigmoidf_(xs)); }
          u32x4 w; w.x = cvt_pk_bf16(v[0], v[1]); w.y = cvt_pk_bf16(v[2], v[3]); w.z = cvt_pk_bf16(v[4], v[5]); w.w = cvt_pk_bf16(v[6], v[7]);
          *(u32x4*)(alr + (size_t)t * 256 + col) = w; } }
    GRID_SYNC();
    { EpiLR e; e.dec = (float*)(ws + WS_DEC); e.asg = (bf16_t*)(ws + WS_ASG); e.gg = (bf16_t*)(ws + WS_GG); e.w0 = P.rw_w0; e.a0 = P.rw_a0;
      run_gemm(lds, (const bf16_t*)(ws + WS_ALR), (const bf16_t*)(ws + W_LR), T, 768, 256, e); }
    GRID_SYNC();
#if EXPORT == 6
    { const u32x4* src = (const u32x4*)(ws + WS_DEC); u32x4* dst = (u32x4*)(ws + WS_END);
      for (size_t i = (size_t)blockIdx.x * 512 + opaque_tid(); i < (size_t)T * 128; i += (size_t)gridDim.x * 512) dst[i] = src[i]; }
#endif
#if EXPORT == 7
    { const u32x4* src = (const u32x4*)(ws + WS_ALR); u32x4* dst = (u32x4*)(ws + WS_END);
      for (size_t i = (size_t)blockIdx.x * 512 + opaque_tid(); i < (size_t)T * 32; i += (size_t)gridDim.x * 512) dst[i] = src[i]; }
#endif
    if ((int)blockIdx.x < NSCAN) {
#if RUN_SCAN
        rwkv_scan(P, lds, blockIdx.x);
#else
        { unsigned* z = (unsigned*)(ws + WS_OB); for (int i = blockIdx.x * 512 + opaque_tid(); i < T * 128; i += NSCAN * 512) z[i] = 0u; }
#endif
    } else {
#if RUN_ATTN
        attention_phase(P, lds, (int)blockIdx.x - NSCAN, (int)gridDim.x - NSCAN);
#else
        { unsigned* z = (unsigned*)(ws + WS_OA); unsigned* z2 = (unsigned*)(ws + WS_OC);
          for (int i = ((int)blockIdx.x - NSCAN) * 512 + opaque_tid(); i < T * 256; i += ((int)gridDim.x - NSCAN) * 512) z[i] = 0u;
          for (int i = ((int)blockIdx.x - NSCAN) * 512 + opaque_tid(); i < T * 128; i += ((int)gridDim.x - NSCAN) * 512) z2[i] = 0u; }
#endif
    }
    GRID_SYNC();
    { float* tmp = (float*)(ws + WS_ACT); bf16_t* merged = (bf16_t*)(ws + WS_DEC);
      const bf16_t* obr[3] = {(const bf16_t*)(ws + WS_OA), (const bf16_t*)(ws + WS_OB), (const bf16_t*)(ws + WS_OC)};
#pragma unroll
      for (int br = 0; br < 3; ++br) {
          { EpiTmp e; e.tmp = tmp; run_gemm(lds, br == 0 ? (const bf16_t*)(ws + WS_OA) : (br == 1 ? (const bf16_t*)(ws + WS_OB) : (const bf16_t*)(ws + WS_OC)),
                                            (const bf16_t*)(ws + (br == 0 ? W_UPA : (br == 1 ? W_UPB : W_UPC))), T, 1024, br == 0 ? 512 : 256, e); }
          { EpiGate e; e.tmp = tmp; e.bias = P.gate_bias + br * 1024; e.merged = merged; e.first = (br == 0);
            run_gemm(lds, H, (const bf16_t*)(ws + W_GATE) + (size_t)br * 1024 * 1024, T, 1024, 1024, e); }
      }
      (void)obr; }
    GRID_SYNC();
    { EpiRes e; e.res = X; e.out = X; e.scale = 1.0f; run_gemm(lds, (const bf16_t*)(ws + WS_DEC), (const bf16_t*)(ws + W_OUT), T, 1024, 1024, e); }
    GRID_SYNC();
#endif
#if RUN_FFN2
    norm_rows(X, P.ffn2_norm, H, nullptr, T);
    GRID_SYNC();
    { EpiSwiglu e; e.act = ACT; run_gemm(lds, H, (const bf16_t*)(ws + W_UP2), T, 5632, 1024, e); }
    GRID_SYNC();
    { EpiRes e; e.res = X; e.out = X; e.scale = 0.5f; run_gemm(lds, ACT, (const bf16_t*)(ws + W_DN2), T, 1024, 2816, e); }
    GRID_SYNC();
#endif
    norm_rows(X, P.final_norm, nullptr, X, T);
#if EXPORT
    GRID_SYNC();
    for (size_t i = (size_t)blockIdx.x * 512 + opaque_tid(); i < (size_t)T * 1024; i += (size_t)gridDim.x * 512) {
        const size_t t = i >> 10; const int c = (int)(i & 1023); bf16_t v;
#if EXPORT == 1
        if (c < 512) v = ((const bf16_t*)(ws + WS_OA))[t * 512 + c]; else if (c < 768) v = ((const bf16_t*)(ws + WS_OB))[t * 256 + c - 512]; else v = ((const bf16_t*)(ws + WS_OC))[t * 256 + c - 768];
#elif EXPORT == 2
        v = ((const bf16_t*)(ws + WS_DEC))[i];
#elif EXPORT == 6
        { const unsigned char* sp = ws + WS_END; v = 0;
          if (i < (size_t)T * 256) { X[i] = ((const float*)sp)[i]; continue; }
          else if (i < (size_t)T * 768) v = ((const bf16_t*)(sp + (size_t)T * 1024))[i - (size_t)T * 256]; }
#elif EXPORT == 7
        { const unsigned char* sp = ws + WS_END; v = 0; if (i < (size_t)T * 256) v = ((const bf16_t*)sp)[i]; }
#elif EXPORT == 3
        v = ((const bf16_t*)(ws + WS_OB))[t * 256 + (c & 255)];
#elif EXPORT == 4
        v = ((const bf16_t*)(ws + WS_OA))[t * 512 + (c & 511)];
#elif EXPORT == 5
        v = ((const bf16_t*)(ws + WS_OC))[t * 256 + (c & 255)];
#endif
        X[i] = bf2f(v); }
#endif
    if (rep + 1 < NREP) GRID_SYNC();
    }
}

extern "C" void kernel_launch(void* const* d_in, const int* in_sizes, int n_in, void* d_out, int out_size, void* d_ws, size_t ws_size, hipStream_t stream) {
    constexpr int LDS_BYTES = 131072;
    static int grid_blocks = 0;
    if (grid_blocks == 0) {
        if (n_in != 37 || ws_size < WS_END) { fprintf(stderr, "kernel_launch: unexpected inputs (n_in %d, ws %zu, need %zu)\n", n_in, ws_size, (size_t)WS_END); grid_blocks = -1; return; }
        int dev = 0, cus = 0, per_cu = 0;
        hipGetDevice(&dev);
        hipDeviceGetAttribute(&cus, hipDeviceAttributeMultiprocessorCount, dev);
        hipFuncSetAttribute((const void*)fwd_megakernel, hipFuncAttributeMaxDynamicSharedMemorySize, LDS_BYTES);
        hipOccupancyMaxActiveBlocksPerMultiprocessor(&per_cu, (const void*)fwd_megakernel, 512, LDS_BYTES);
        if (per_cu < 1) per_cu = 1;
        grid_blocks = cus * per_cu;
        (void)hipGetLastError();
    }
    if (grid_blocks < 0) return;
    hipMemsetAsync((unsigned char*)d_ws + WS_BAR, 0, 256, stream);
    Params p{};
    const float** fp = (const float**)&p;
    (void)fp;
    p.x = (const float*)d_in[0]; p.mem = (const float*)d_in[1]; p.pos = (const int*)d_in[2];
    p.ffn1_norm = (const float*)d_in[3]; p.ffn1_w1 = (const float*)d_in[4]; p.ffn1_w3 = (const float*)d_in[5]; p.ffn1_w2 = (const float*)d_in[6];
    p.mix_norm = (const float*)d_in[7]; p.w_in = (const float*)d_in[8]; p.gate_bias = (const float*)d_in[9];
    p.lq1 = (const float*)d_in[10]; p.lk1 = (const float*)d_in[11]; p.lq2 = (const float*)d_in[12]; p.lk2 = (const float*)d_in[13]; p.subln = (const float*)d_in[14];
    p.rw_mu = (const float*)d_in[15]; p.rw_w0 = (const float*)d_in[16]; p.rw_w2 = (const float*)d_in[17]; p.rw_a0 = (const float*)d_in[18]; p.rw_a2 = (const float*)d_in[19];
    p.rw_g2 = (const float*)d_in[20]; p.rw_k_k = (const float*)d_in[21]; p.rw_k_a = (const float*)d_in[22]; p.rw_r_k = (const float*)d_in[23];
    p.rw_ln_w = (const float*)d_in[24]; p.rw_ln_b = (const float*)d_in[25];
    p.mem_norm = (const float*)d_in[26]; p.w_mem_kv = (const float*)d_in[27]; p.w_up_a = (const float*)d_in[28]; p.w_up_b = (const float*)d_in[29]; p.w_up_c = (const float*)d_in[30];
    p.w_out = (const float*)d_in[31]; p.ffn2_norm = (const float*)d_in[32]; p.ffn2_w1 = (const float*)d_in[33]; p.ffn2_w3 = (const float*)d_in[34]; p.ffn2_w2 = (const float*)d_in[35];
    p.final_norm = (const float*)d_in[36];
    p.out = (float*)d_out; p.ws = (unsigned char*)d_ws;
    void* args[] = {&p};
#ifndef NLAUNCH
#define NLAUNCH 1
#endif
    hipError_t e = hipSuccess;
    for (int li = 0; li < NLAUNCH; ++li) e = hipLaunchCooperativeKernel((const void*)fwd_megakernel, dim3(grid_blocks), dim3(512), args, LDS_BYTES, stream);
    if (e != hipSuccess) fprintf(stderr, "cooperative launch failed: %s (grid %d)\n", hipGetErrorString(e), grid_blocks);
}
```

```cpp
#include <hip/hip_runtime.h>
#include <hip/hip_cooperative_groups.h>
#include <cstdio>
namespace pg8 {
#define PG8_LAS __attribute__((address_space(3)))
typedef unsigned short bf16_t;
typedef short bf16x8 __attribute__((ext_vector_type(8)));
typedef float f32x4 __attribute__((ext_vector_type(4)));
typedef unsigned u32x4 __attribute__((ext_vector_type(4)));
constexpr int BM = 256, BK = 64, HALF = 128, HTB = HALF * BK * 2  , STAGE_BYTES = 8 * HTB, NXCD = 8, WGM = 8;

__host__ __device__ __forceinline__ int lds_byte(int r, int c) { const int st = (r >> 4) * 2 + (c >> 5), rr = r & 15, cc = c & 31, ob = rr * 64 + cc * 2; return st * 1024 + (ob ^ (((ob >> 9) & 1) << 5)); }
__host__ __device__ __forceinline__ void stage_rc(int b, int& R, int& C) { const int st = b / 1024, sb = b % 1024, swz = sb ^ (((sb >> 9) & 1) << 5); R = (st >> 1) * 16 + swz / 64; C = (st & 1) * 32 + (swz % 64) / 2; }
__host__ __device__ __forceinline__ int perm32(int rho) { const int n = rho >> 4, i = rho & 15; return 8 * (i >> 2) + 4 * n + (i & 3); }

struct Unit { int pm, pn; };
struct Gemm { const bf16_t* A; const bf16_t* Bt; int M, N, K; };

struct StaticOrder {
    int nM, nN, nwg, G, c;
    __host__ __device__ void init(int M, int N, int G_, int c_) { nM = M / BM; nN = N / BM; nwg = nM * nN; G = G_; c = c_; }
    __host__ __device__ bool next(int i, Unit& u) const {
        const long L = (long)i * G + c; if (L >= nwg) return false;
        int wgid = (int)L; { const int q = nwg / NXCD, r = nwg % NXCD, xcd = wgid % NXCD, off = wgid / NXCD; wgid = (xcd < r ? xcd * (q + 1) : r * (q + 1) + (xcd - r) * q) + off; }
        const int nig = WGM * nN, gid = wgid / nig, fm = gid * WGM, gsz = (nM - fm) < WGM ? (nM - fm) : WGM;
        u.pm = fm + ((wgid % nig) % gsz); u.pn = (wgid % nig) / gsz; return true;
    }
    __device__ __forceinline__ void a_ready(const Unit&) const {}
    __device__ __forceinline__ void done(const Unit&) const {}
};
typedef float f32x2_c __attribute__((ext_vector_type(2))); typedef __bf16 bf16x2_c __attribute__((ext_vector_type(2)));
__device__ __forceinline__ unsigned cvt_pk_bf16(float lo, float hi) { const f32x2_c v = {lo, hi}; const bf16x2_c b = __builtin_convertvector(v, bf16x2_c); return __builtin_bit_cast(unsigned, b); }
template <class Epi, class Sched, bool STAMP = false>
__device__ __forceinline__ void gemm_phase(PG8_LAS unsigned char* lds, const Gemm g, const Sched& S, const Epi& E, unsigned long long* stamps) {
    int tid_l = threadIdx.x; asm volatile("" : "+v"(tid_l)); const int tid = tid_l, wid = __builtin_amdgcn_readfirstlane(tid >> 6), lane = tid & 63, wr = wid >> 2, wc = wid & 3, fr = lane & 15, fq = lane >> 4;
    const int K = g.K, nt = K / BK;
    int ts_lo = 0, ts_hi = 0, nts = 0; const unsigned long long rt_entry = STAMP ? (unsigned long long)wall_clock64() : 0ull;
#define PG8_STAMP() do { if (STAMP && wid == 0 && nts < 64) { const unsigned long long _c = (unsigned long long)clock64(); \
        ts_lo = (lane == nts) ? (int)(unsigned)_c : ts_lo; ts_hi = (lane == nts) ? (int)(unsigned)(_c >> 32) : ts_hi; ++nts; } } while (0)
    PG8_STAMP();
    unsigned voffA[2], voffB[2];
#pragma unroll
    for (int i = 0; i < 2; ++i) { int R, C; stage_rc(tid * 16 + i * 8192, R, C); const int Rb = Epi::PERM ? ((R & ~31) + perm32(R & 31)) : R;
        voffA[i] = (unsigned)(R * K + C) * 2u; voffB[i] = (unsigned)(Rb * K + C) * 2u; }
    const size_t kstep = (size_t)(BK * 2);
    const size_t hstep = (size_t)HALF * K * 2;
    const size_t tstep = 2 * hstep;
    const unsigned ldsw = (unsigned)wid * 1024u;
    const int aoff = lds_byte(wr * 64 + fr, fq * 8), boff = lds_byte(wc * 32 + fr, fq * 8);
#define PG8_SA(b, h) (((b) * 2 + (h)) * HTB)
#define PG8_SB(b, h) ((4 + (b) * 2 + (h)) * HTB)
#define PG8_STAGE(bufoff, gbase, voff) do { _Pragma("unroll") for (int _i = 0; _i < 2; ++_i) \
        __builtin_amdgcn_global_load_lds((const unsigned*)((const char*)(gbase) + (voff)[_i]), (PG8_LAS unsigned*)(lds + (bufoff) + ldsw + _i * 8192), 16, 0, 0); } while (0)
#define PG8_LDA(dst, b, h) do { _Pragma("unroll") for (int m = 0; m < 4; ++m) _Pragma("unroll") for (int k = 0; k < 2; ++k) dst[m][k] = *(const PG8_LAS bf16x8*)(lds + PG8_SA(b, h) + aoff + m * 2048 + k * 1024); } while (0)
#define PG8_LDB(dst, b, h) do { _Pragma("unroll") for (int n = 0; n < 2; ++n) _Pragma("unroll") for (int k = 0; k < 2; ++k) dst[n][k] = *(const PG8_LAS bf16x8*)(lds + PG8_SB(b, h) + boff + n * 2048 + k * 1024); } while (0)
#define PG8_MMA(ai, bj, At, Bt) do { __builtin_amdgcn_s_setprio(1); _Pragma("unroll") for (int m = 0; m < 4; ++m) _Pragma("unroll") for (int n = 0; n < 2; ++n) _Pragma("unroll") for (int k = 0; k < 2; ++k) \
        acc[ai][bj][m][n] = __builtin_amdgcn_mfma_f32_16x16x32_bf16(Bt[n][k], At[m][k], acc[ai][bj][m][n], 0, 0, 0); __builtin_amdgcn_s_setprio(0); } while (0)
#define PG8_WAIT_V(n) asm volatile("s_waitcnt vmcnt(" #n ")" ::: "memory")
#define PG8_WAIT_L(n) asm volatile("s_waitcnt lgkmcnt(" #n ")" ::: "memory")
#define PG8_BAR __builtin_amdgcn_s_barrier()
#define PG8_SCHED __builtin_amdgcn_sched_barrier(0)
    Unit cur, nxt; int ui = 0;
    if (!S.next(0, cur)) return;
    f32x4 acc[2][2][4][2];
#pragma unroll
    for (int a = 0; a < 2; ++a)
#pragma unroll
        for (int b = 0; b < 2; ++b)
#pragma unroll
            for (int m = 0; m < 4; ++m)
#pragma unroll
                for (int n = 0; n < 2; ++n) acc[a][b][m][n] = (f32x4){0.f, 0.f, 0.f, 0.f};
    bf16x8 At[4][2], B0[2][2], B1[2][2];
    const char* cA = (const char*)g.A + (size_t)cur.pm * tstep; const char* cB = (const char*)g.Bt + (size_t)cur.pn * tstep;
    S.a_ready(cur);
    PG8_STAGE(PG8_SB(0, 0), cB, voffB); PG8_STAGE(PG8_SA(0, 0), cA, voffA); PG8_STAGE(PG8_SB(0, 1), cB + hstep, voffB); PG8_STAGE(PG8_SA(0, 1), cA + hstep, voffA);
    if (wr == 1) PG8_BAR;
    PG8_WAIT_V(4); PG8_BAR;
    PG8_STAGE(PG8_SB(1, 0), cB + kstep, voffB); PG8_STAGE(PG8_SA(1, 0), cA + kstep, voffA); PG8_STAGE(PG8_SB(1, 1), cB + hstep + kstep, voffB);
    PG8_WAIT_V(6); PG8_BAR;
    PG8_STAMP();
    for (;;) {
        const bool has_next = S.next(ui + 1, nxt);
        const char* nA = has_next ? (const char*)g.A + (size_t)nxt.pm * tstep : cA; const char* nB = has_next ? (const char*)g.Bt + (size_t)nxt.pn * tstep : cB;
        for (int t = 0; t < nt; t += 2) {
            const bool last = (t == nt - 2);
            const char* a1 = cA + (size_t)(t + 1) * kstep;
            const char* a2 = last ? nA : cA + (size_t)(t + 2) * kstep; const char* b2 = last ? nB : cB + (size_t)(t + 2) * kstep;
            const char* a3 = a2 + kstep; const char* b3 = b2 + kstep;
            if (last && has_next) S.a_ready(nxt);
            if constexpr (Epi::MID) E.mid(acc, cur, t, wr, wc, fr, fq);
            PG8_LDB(B0, 0, 0); PG8_SCHED; PG8_LDA(At, 0, 0); PG8_STAGE(PG8_SA(1, 1), a1 + hstep, voffA);
            PG8_WAIT_L(8); PG8_BAR; PG8_WAIT_L(0); PG8_MMA(0, 0, At, B0); PG8_BAR; PG8_SCHED;
            PG8_LDB(B1, 0, 1); PG8_STAGE(PG8_SB(0, 0), b2, voffB);
            PG8_BAR; PG8_WAIT_L(0); PG8_MMA(0, 1, At, B1); PG8_BAR;
            PG8_LDA(At, 0, 1); PG8_STAGE(PG8_SA(0, 0), a2, voffA);
            PG8_BAR; PG8_WAIT_L(0); PG8_MMA(1, 0, At, B0); PG8_BAR; PG8_SCHED;
            PG8_STAGE(PG8_SB(0, 1), b2 + hstep, voffB);
            PG8_WAIT_V(6); PG8_BAR; PG8_MMA(1, 1, At, B1); PG8_BAR;
            PG8_LDB(B0, 1, 0); PG8_SCHED; PG8_LDA(At, 1, 0); PG8_STAGE(PG8_SA(0, 1), a2 + hstep, voffA);
            PG8_WAIT_L(8); PG8_BAR; PG8_WAIT_L(0); PG8_MMA(0, 0, At, B0); PG8_BAR; PG8_SCHED;
            PG8_LDB(B1, 1, 1); PG8_STAGE(PG8_SB(1, 0), b3, voffB);
            PG8_BAR; PG8_WAIT_L(0); PG8_MMA(0, 1, At, B1); PG8_BAR;
            PG8_LDA(At, 1, 1); PG8_STAGE(PG8_SA(1, 0), a3, voffA);
            PG8_BAR; PG8_WAIT_L(0); PG8_MMA(1, 0, At, B0); PG8_BAR; PG8_SCHED;
            PG8_STAGE(PG8_SB(1, 1), b3 + hstep, voffB);
            PG8_WAIT_V(6); PG8_BAR; PG8_MMA(1, 1, At, B1); PG8_BAR;
        }
        PG8_STAMP();
        if constexpr (!Epi::AFTER_DRAIN) { E(acc, cur, wr, wc, fr, fq); S.done(cur); }
        PG8_STAMP();
        if (!has_next) break;
#pragma unroll
        for (int a = 0; a < 2; ++a)
#pragma unroll
            for (int b = 0; b < 2; ++b)
#pragma unroll
                for (int m = 0; m < 4; ++m)
#pragma unroll
                    for (int n = 0; n < 2; ++n) acc[a][b][m][n] = (f32x4){0.f, 0.f, 0.f, 0.f};
        cur = nxt; cA = nA; cB = nB; ++ui;
    }
    PG8_WAIT_V(0);
    if (wr == 0) PG8_BAR;
    PG8_BAR;
    if constexpr (Epi::AFTER_DRAIN) { E.fused(acc, cur, wr, wc, fr, fq, lds, wid, lane); S.done(cur); }
    PG8_STAMP();
    if (STAMP && wid == 0) { stamps[lane] = lane < nts ? (((unsigned long long)(unsigned)ts_hi << 32) | (unsigned)ts_lo) : 0ull;
        if (lane == 62) stamps[62] = rt_entry; if (lane == 63) stamps[63] = (unsigned long long)wall_clock64(); }
#undef PG8_STAMP
#undef PG8_SA
#undef PG8_SB
#undef PG8_STAGE
#undef PG8_LDA
#undef PG8_LDB
#undef PG8_MMA
#undef PG8_WAIT_V
#undef PG8_WAIT_L
#undef PG8_BAR
#undef PG8_SCHED
}
}
namespace cg = cooperative_groups;
using pg8::bf16_t; using pg8::bf16x8; using pg8::f32x4; using pg8::cvt_pk_bf16; using pg8::Unit; using pg8::Gemm; using pg8::StaticOrder;
typedef unsigned u32x2 __attribute__((ext_vector_type(2)));
typedef unsigned u32x4 __attribute__((ext_vector_type(4)));
#define LAS PG8_LAS

constexpr int T = 65536, SEQ = 4096, DM = 1024, DFF = 2816, PCOLS = 5888, PLO = 2816, MEMT = 4096;
constexpr int NSCAN = 128;

constexpr size_t W_UP1 = 0;
constexpr size_t W_DN1 = W_UP1 + (size_t)5632 * 1024 * 2;
constexpr size_t W_UP2 = W_DN1 + (size_t)1024 * 2816 * 2;
constexpr size_t W_DN2 = W_UP2 + (size_t)5632 * 1024 * 2;
constexpr size_t W_INLO = W_DN2 + (size_t)1024 * 2816 * 2;
constexpr size_t W_GATE = W_INLO + (size_t)2816 * 1024 * 2;
constexpr size_t W_UPA = W_GATE + (size_t)3072 * 1024 * 2;
constexpr size_t W_UPB = W_UPA + (size_t)1024 * 512 * 2;
constexpr size_t W_UPC = W_UPB + (size_t)1024 * 256 * 2;
constexpr size_t W_OUT = W_UPC + (size_t)1024 * 256 * 2;
constexpr size_t W_MKV = W_OUT + (size_t)1024 * 1024 * 2;
constexpr size_t W_LR = W_MKV + (size_t)512 * 1024 * 2;
constexpr size_t WS_ACT = W_LR + (size_t)768 * 256 * 2;
constexpr size_t WS_ALR = WS_ACT + (size_t)T * 2816 * 2;
constexpr size_t WS_H = WS_ALR + (size_t)T * 256 * 2;
constexpr size_t WS_DEC = WS_H + (size_t)T * 1024 * 2;
constexpr size_t WS_ASG = WS_DEC + (size_t)T * 256 * 4;
constexpr size_t WS_GG = WS_ASG + (size_t)T * 256 * 2;
constexpr size_t WS_OA = WS_GG + (size_t)T * 256 * 2;
constexpr size_t WS_OB = WS_OA + (size_t)T * 512 * 2;
constexpr size_t WS_OC = WS_OB + (size_t)T * 256 * 2;
constexpr size_t WS_CS = WS_OC + (size_t)T * 256 * 2;
constexpr size_t WS_HM = WS_CS + (size_t)T * 16 * 4;
constexpr size_t WS_KVM = WS_HM + (size_t)MEMT * 1024 * 2;
constexpr size_t WS_BAR = WS_KVM + (size_t)MEMT * 512 * 2;
constexpr size_t WS_QCTR = WS_BAR + 16384;
constexpr size_t WS_SS1 = WS_BAR + 16384 + 2048;
constexpr size_t WS_SS2 = WS_SS1 + (size_t)T * 4;
constexpr size_t WS_YRAW = WS_SS2 + (size_t)T * 4;
constexpr size_t WS_END = WS_YRAW + (size_t)T * 256 * 4;

struct Params {
    const float* x; const float* mem; const int* pos;
    const float *ffn1_norm, *ffn1_w1, *ffn1_w3, *ffn1_w2, *mix_norm, *w_in, *gate_bias;
    const float *lq1, *lk1, *lq2, *lk2, *subln;
    const float *rw_mu, *rw_w0, *rw_w2, *rw_a0, *rw_a2, *rw_g2, *rw_k_k, *rw_k_a, *rw_r_k, *rw_ln_w, *rw_ln_b;
    const float *mem_norm, *w_mem_kv, *w_up_a, *w_up_b, *w_up_c, *w_out;
    const float *ffn2_norm, *ffn2_w1, *ffn2_w3, *ffn2_w2, *final_norm;
    float* out; unsigned char* ws;
};

typedef const __attribute__((address_space(4))) Params* KP;
__device__ __forceinline__ KP kp_fresh() { KP p = (KP)__builtin_amdgcn_kernarg_segment_ptr(); asm volatile("" : "+s"(p)); return p; }

__constant__ float INVF[8] = {1.0f, 0.1939227432012558f, 0.03760603070259094f, 0.007292664609849453f, 0.0014142135623842478f,
                              0.00027424818836152554f, 5.3182957344688475e-05f, 1.0313385246263351e-05f};

__device__ __forceinline__ float bf2f(bf16_t b) { return __uint_as_float(((unsigned)b) << 16); }
__device__ __forceinline__ float bflo(unsigned w) { return __uint_as_float(w << 16); }
__device__ __forceinline__ float bfhi(unsigned w) { return __uint_as_float(w & 0xffff0000u); }
__device__ __forceinline__ bf16_t f2bf(float f) { return (bf16_t)(cvt_pk_bf16(f, 0.f) & 0xffffu); }
__device__ __forceinline__ f32x4 unpk4(u32x2 w) { f32x4 r; r[0] = bflo(w.x); r[1] = bfhi(w.x); r[2] = bflo(w.y); r[3] = bfhi(w.y); return r; }
__device__ __forceinline__ float xquad_max(float x) {
    auto a = __builtin_amdgcn_permlane32_swap(__float_as_uint(x), __float_as_uint(x), false, false);
    const float m = fmaxf(__uint_as_float(a[0]), __uint_as_float(a[1]));
    auto b = __builtin_amdgcn_permlane16_swap(__float_as_uint(m), __float_as_uint(m), false, false);
    return fmaxf(__uint_as_float(b[0]), __uint_as_float(b[1]));
}
__device__ __forceinline__ float xquad_sum(float x) {
    auto a = __builtin_amdgcn_permlane32_swap(__float_as_uint(x), __float_as_uint(x), false, false);
    const float m = __uint_as_float(a[0]) + __uint_as_float(a[1]);
    auto b = __builtin_amdgcn_permlane16_swap(__float_as_uint(m), __float_as_uint(m), false, false);
    return __uint_as_float(b[0]) + __uint_as_float(b[1]);
}
__device__ __forceinline__ float fast_rcp(float x) { return __builtin_amdgcn_rcpf(x); }
__device__ __forceinline__ float sigmoidf_(float x) { return fast_rcp(1.0f + __expf(-x)); }
__device__ __forceinline__ int opaque_tid() { int t = threadIdx.x; asm volatile("" : "+v"(t)); return t; }
#define DPP_F(v, ctrl) __int_as_float(__builtin_amdgcn_update_dpp(0, __float_as_int(v), ctrl, 0xF, 0xF, true))
__device__ __forceinline__ float wave_sum(float v) { v += DPP_F(v, 0xB1); v += DPP_F(v, 0x4E); v += DPP_F(v, 0x141); v += DPP_F(v, 0x140); return xquad_sum(v); }
__device__ __forceinline__ float red8(float v) { v += DPP_F(v, 0xB1); v += DPP_F(v, 0x4E); v += DPP_F(v, 0x141); return v; }

template <class F>
__device__ __forceinline__ void conv_w(bf16_t* dst, int N, int K, F src, LAS unsigned char* lds) {
    LAS float* tl = (LAS float*)lds;
    const int tid = opaque_tid(), kt = K >> 6, ntiles = (N >> 6) * kt;
    float cur[8];
    int tile = blockIdx.x;
    if (tile < ntiles) { const int R0 = (tile / kt) * 64, k0 = (tile % kt) * 64;
#pragma unroll
        for (int j = 0; j < 8; ++j) { const int e = tid + 512 * j; cur[j] = src(R0 + (e & 63), k0 + (e >> 6)); } }
    for (; tile < ntiles; tile += gridDim.x) {
        const int R0 = (tile / kt) * 64, k0 = (tile % kt) * 64;
#pragma unroll
        for (int j = 0; j < 8; ++j) { const int e = tid + 512 * j; tl[(e & 63) * 65 + (e >> 6)] = cur[j]; }
        const int nt2 = tile + gridDim.x;
        if (nt2 < ntiles) { const int R1 = (nt2 / kt) * 64, k1 = (nt2 % kt) * 64;
#pragma unroll
            for (int j = 0; j < 8; ++j) { const int e = tid + 512 * j; cur[j] = src(R1 + (e & 63), k1 + (e >> 6)); } }
        __syncthreads();
        { const int r = tid >> 3, k8 = (tid & 7) * 8; LAS const float* p = tl + r * 65 + k8;
          u32x4 w; w.x = cvt_pk_bf16(p[0], p[1]); w.y = cvt_pk_bf16(p[2], p[3]); w.z = cvt_pk_bf16(p[4], p[5]); w.w = cvt_pk_bf16(p[6], p[7]);
          *(u32x4*)(dst + (size_t)(R0 + r) * K + k0 + k8) = w; }
        __syncthreads();
    }
}
__device__ __forceinline__ int perm_col(int R, bool rope) {
    const int Gb = R & ~31, rho = R & 31, n = rho >> 4, fq = (rho >> 2) & 3, e = rho & 3;
    int d;
    if (rope && (Gb & 32) == 0) d = fq < 2 ? 4 * fq + 8 * n + e : 16 + (fq - 2) * 8 + 4 * n + e;
    else d = 8 * fq + 4 * n + e;
    return Gb + d;
}

__device__ __forceinline__ int swiglu_col(int R) { const int pn = R >> 8, wcg = (R >> 5) & 3, rho = R & 31; return pn * 128 + wcg * 32 + 8 * ((rho >> 2) & 3) + 4 * (rho >> 4) + (rho & 3); }

__device__ __forceinline__ void norm_rows(const float* in, const float* gain, bf16_t* outb, float* outf, int rows) {
    const int tid = opaque_tid(), wave = tid >> 6, lane = tid & 63, stride = gridDim.x * 8;
    int row = blockIdx.x * 8 + wave;
    float4 nx[4];
    if (row < rows) { const float4* p = (const float4*)(in + (size_t)row * 1024);
#pragma unroll
        for (int j = 0; j < 4; ++j) nx[j] = p[j * 64 + lane]; }
    for (; row < rows; row += stride) {
        float4 v[4]; float ss = 0.f;
#pragma unroll
        for (int j = 0; j < 4; ++j) { v[j] = nx[j]; ss += v[j].x * v[j].x + v[j].y * v[j].y + v[j].z * v[j].z + v[j].w * v[j].w; }
        if (row + stride < rows) { const float4* p = (const float4*)(in + (size_t)(row + stride) * 1024);
#pragma unroll
            for (int j = 0; j < 4; ++j) nx[j] = p[j * 64 + lane]; }
        ss = wave_sum(ss);
        const float r = rsqrtf(ss * (1.0f / 1024.0f) + 1e-6f);
#pragma unroll
        for (int j = 0; j < 4; ++j) {
            const float4 g = ((const float4*)gain)[j * 64 + lane];
            float4 y; y.x = v[j].x * r * g.x; y.y = v[j].y * r * g.y; y.z = v[j].z * r * g.z; y.w = v[j].w * r * g.w;
            if (outf) ((float4*)(outf + (size_t)row * 1024))[j * 64 + lane] = y;
            else { u32x2 w; w.x = cvt_pk_bf16(y.x, y.y); w.y = cvt_pk_bf16(y.z, y.w); *(u32x2*)(outb + (size_t)row * 1024 + (j * 64 + lane) * 4) = w; }
        }
    }
}

__device__ __forceinline__ void unpk8(u32x4 w, f32x4& lo, f32x4& hi) { lo[0] = bflo(w.x); lo[1] = bfhi(w.x); lo[2] = bflo(w.y); lo[3] = bfhi(w.y); hi[0] = bflo(w.z); hi[1] = bfhi(w.z); hi[2] = bflo(w.w); hi[3] = bfhi(w.w); }
__device__ __forceinline__ void norm_rows_b(const bf16_t* in, const float* gain, float* outf, int rows) {
    const int tid = opaque_tid(), wave = tid >> 6, lane = tid & 63, stride = gridDim.x * 8;
    int row = blockIdx.x * 8 + wave;
    u32x4 nx[2];
    if (row < rows) { const u32x4* p = (const u32x4*)(in + (size_t)row * 1024); nx[0] = p[lane]; nx[1] = p[64 + lane]; }
    for (; row < rows; row += stride) {
        f32x4 v[4]; float ss = 0.f;
        unpk8(nx[0], v[0], v[1]); unpk8(nx[1], v[2], v[3]);
#pragma unroll
        for (int j = 0; j < 4; ++j) ss += v[j][0] * v[j][0] + v[j][1] * v[j][1] + v[j][2] * v[j][2] + v[j][3] * v[j][3];
        if (row + stride < rows) { const u32x4* p = (const u32x4*)(in + (size_t)(row + stride) * 1024); nx[0] = p[lane]; nx[1] = p[64 + lane]; }
        ss = wave_sum(ss);
        const float r = rsqrtf(ss * (1.0f / 1024.0f) + 1e-6f);
#pragma unroll
        for (int j = 0; j < 2; ++j) { const int c = (j * 64 + lane) * 8;
            const f32x4 g0 = *(const f32x4*)(gain + c), g1 = *(const f32x4*)(gain + c + 4);
            *(f32x4*)(outf + (size_t)row * 1024 + c) = v[2 * j] * r * g0; *(f32x4*)(outf + (size_t)row * 1024 + c + 4) = v[2 * j + 1] * r * g1; }
    }
}

struct EpiSwiglu {
    static constexpr bool PERM = false, AFTER_DRAIN = false, MID = true;
    bf16_t* act; const float* rowss; int tlast; mutable float rsv[8];
    __device__ __forceinline__ void mid(f32x4 (&)[2][2][4][2], const Unit& u, int t, int wr, int wc, int fr, int fq) const {
        if (rowss == nullptr || t != tlast) return;
        const float* rp = rowss + u.pm * 256 + wr * 64 + fr;
#pragma unroll
        for (int i = 0; i < 8; ++i) rsv[i] = rp[(i >> 2) * 128 + (i & 3) * 16];
    }
    __device__ __forceinline__ void operator()(const f32x4 (&acc)[2][2][4][2], const Unit& u, int wr, int wc, int fr, int fq) const {
        const int row0 = u.pm * 256 + wr * 64 + fr;
#pragma unroll
        for (int ai = 0; ai < 2; ++ai)
#pragma unroll
            for (int m = 0; m < 4; ++m) { const int row = row0 + ai * 128 + m * 16; bf16_t* rowp = act + (size_t)row * DFF + u.pn * 128 + wc * 32 + 8 * fq;
                const float rs = rowss ? rsqrtf(rsv[ai * 4 + m] * (1.0f / 1024.0f) + 1e-6f) : 1.0f;
                float o[8];
#pragma unroll
                for (int n = 0; n < 2; ++n) { const f32x4 g = acc[ai][0][m][n] * rs, v = acc[ai][1][m][n] * rs;
#pragma unroll
                    for (int e = 0; e < 4; ++e) o[4 * n + e] = g[e] * fast_rcp(1.0f + __expf(-g[e])) * v[e]; }
                u32x4 w; w.x = cvt_pk_bf16(o[0], o[1]); w.y = cvt_pk_bf16(o[2], o[3]); w.z = cvt_pk_bf16(o[4], o[5]); w.w = cvt_pk_bf16(o[6], o[7]);
                *(u32x4*)rowp = w; }
    }
};
template <bool HALF, bool RESB, bool OUTF, bool STATS> struct EpiRes {
    static constexpr bool PERM = false, AFTER_DRAIN = false, MID = false;
    const float* resf; const bf16_t* resb; float* outf; bf16_t* outb; float* rowss;
    __device__ __forceinline__ void ldres(size_t off, f32x4 (&r)[4]) const {
        if (RESB) { r[0] = __builtin_bit_cast(f32x4, *(const u32x4*)(resb + off)); r[1] = __builtin_bit_cast(f32x4, *(const u32x4*)(resb + off + 128)); }
        else { r[0] = *(const f32x4*)(resf + off); r[1] = *(const f32x4*)(resf + off + 4); r[2] = *(const f32x4*)(resf + off + 128); r[3] = *(const f32x4*)(resf + off + 132); }
    }
    __device__ __forceinline__ void operator()(const f32x4 (&acc)[2][2][4][2], const Unit& u, int wr, int wc, int fr, int fq) const {
        const int row0 = u.pm * 256 + wr * 64 + fr, col0 = u.pn * 256 + wc * 32 + 8 * fq;
        size_t off = (size_t)row0 * 1024 + col0; int row = row0;
        f32x4 cur[4]; ldres(off, cur);
#pragma unroll
        for (int g = 0; g < 8; ++g) {
            const int ai = g >> 2, m = g & 3;
            size_t offn = off + ((m == 3) ? (size_t)80 * 1024 : (size_t)16 * 1024);
            asm volatile("" : "+v"(offn));
            f32x4 nxt[4]; if (g < 7) ldres(offn, nxt);
            float ss = 0.f;
#pragma unroll
            for (int bj = 0; bj < 2; ++bj) { f32x4 r0, r1;
                if (RESB) unpk8(__builtin_bit_cast(u32x4, cur[bj]), r0, r1); else { r0 = cur[2 * bj]; r1 = cur[2 * bj + 1]; }
                const f32x4 v0 = r0 + acc[ai][bj][m][0] * (HALF ? 0.5f : 1.0f), v1 = r1 + acc[ai][bj][m][1] * (HALF ? 0.5f : 1.0f);
                if (OUTF) { *(f32x4*)(outf + off + bj * 128) = v0; *(f32x4*)(outf + off + bj * 128 + 4) = v1; }
                else { u32x4 w; w.x = cvt_pk_bf16(v0[0], v0[1]); w.y = cvt_pk_bf16(v0[2], v0[3]); w.z = cvt_pk_bf16(v1[0], v1[1]); w.w = cvt_pk_bf16(v1[2], v1[3]); *(u32x4*)(outb + off + bj * 128) = w; }
                if (STATS) ss += v0[0] * v0[0] + v0[1] * v0[1] + v0[2] * v0[2] + v0[3] * v0[3] + v1[0] * v1[0] + v1[1] * v1[1] + v1[2] * v1[2] + v1[3] * v1[3]; }
            if (STATS) { ss = xquad_sum(ss); if (fq == 0) atomicAdd(rowss + row, ss); }
            asm volatile("" ::: "memory");
            off = offn; row += (m == 3) ? 80 : 16;
#pragma unroll
            for (int k = 0; k < 4; ++k) cur[k] = nxt[k];
        }
    }
};
struct EpiPerm {
    static constexpr bool PERM = false, AFTER_DRAIN = false, MID = true;
    bf16_t* O; int ld; const float* cs; const float* rowss; int tlast; mutable float rsv[8];
    __device__ __forceinline__ void mid(f32x4 (&)[2][2][4][2], const Unit& u, int t, int wr, int wc, int fr, int fq) const {
        if (rowss == nullptr || t != tlast) return;
        const float* rp = rowss + u.pm * 256 + wr * 64 + fr;
#pragma unroll
        for (int i = 0; i < 8; ++i) rsv[i] = rp[(i >> 2) * 128 + (i & 3) * 16];
    }
    __device__ __forceinline__ void operator()(const f32x4 (&acc)[2][2][4][2], const Unit& u, int wr, int wc, int fr, int fq) const {
        const int row0 = u.pm * 256 + wr * 64 + fr;
        const bool rope = cs != nullptr && u.pn < 4 && (wc & 1) == 0 && fq < 2;
#pragma unroll
        for (int ai = 0; ai < 2; ++ai)
#pragma unroll
            for (int m = 0; m < 4; ++m) { const int row = row0 + ai * 128 + m * 16; bf16_t* rowp = O + (size_t)row * ld;
                f32x4 c4 = {1.f, 1.f, 1.f, 1.f}, s4 = {0.f, 0.f, 0.f, 0.f};
                if (rope) { const float* t = cs + (size_t)row * 16 + fq * 8; const f32x4 a = *(const f32x4*)t, b = *(const f32x4*)(t + 4);
                    c4[0] = a[0]; s4[0] = a[1]; c4[1] = a[2]; s4[1] = a[3]; c4[2] = b[0]; s4[2] = b[1]; c4[3] = b[2]; s4[3] = b[3]; }
                const float rs = rowss ? rsqrtf(rsv[ai * 4 + m] * (1.0f / 1024.0f) + 1e-6f) : 1.0f;
#pragma unroll
                for (int bj = 0; bj < 2; ++bj) { const f32x4 x1 = acc[ai][bj][m][0] * rs, x2 = acc[ai][bj][m][1] * rs;
                    const f32x4 y1 = x1 * c4 - x2 * s4, y2 = x2 * c4 + x1 * s4;
                    u32x4 w; w.x = cvt_pk_bf16(y1[0], y1[1]); w.y = cvt_pk_bf16(y1[2], y1[3]); w.z = cvt_pk_bf16(y2[0], y2[1]); w.w = cvt_pk_bf16(y2[2], y2[3]);
                    *(u32x4*)(rowp + u.pn * 256 + bj * 128 + wc * 32 + 8 * fq) = w; } }
    }
};
struct EpiLR {
    static constexpr bool PERM = false, AFTER_DRAIN = false, MID = false;
    float* dec; bf16_t* asg; bf16_t* gg; const float* w0; const float* a0;
    __device__ __forceinline__ void operator()(const f32x4 (&acc)[2][2][4][2], const Unit& u, int wr, int wc, int fr, int fq) const {
        const int row0 = u.pm * 256 + wr * 64 + fr, col0 = wc * 32 + 4 * fq;
#pragma unroll
        for (int ai = 0; ai < 2; ++ai)
#pragma unroll
            for (int m = 0; m < 4; ++m) { const size_t off = (size_t)(row0 + ai * 128 + m * 16) * 256 + col0;
#pragma unroll
                for (int bj = 0; bj < 2; ++bj)
#pragma unroll
                    for (int n = 0; n < 2; ++n) { const int c = col0 + bj * 128 + n * 16; const size_t o = off + bj * 128 + n * 16; const f32x4 a = acc[ai][bj][m][n];
                        if (u.pn == 0) { const f32x4 b = *(const f32x4*)(w0 + c); f32x4 d;
#pragma unroll
                            for (int e = 0; e < 4; ++e) { const float z = -(b[e] + a[e]);
                                const float sp = fmaxf(z, 0.f) + __logf(1.0f + __expf(-fabsf(z)));
                                d[e] = __expf(-__expf(-sp - 0.5f)); }
                            *(f32x4*)(dec + o) = d; }
                        else if (u.pn == 1) { const f32x4 b = *(const f32x4*)(a0 + c); u32x2 w;
                            w.x = cvt_pk_bf16(sigmoidf_(b[0] + a[0]), sigmoidf_(b[1] + a[1])); w.y = cvt_pk_bf16(sigmoidf_(b[2] + a[2]), sigmoidf_(b[3] + a[3]));
                            *(u32x2*)(asg + o) = w; }
                        else { u32x2 w; w.x = cvt_pk_bf16(a[0], a[1]); w.y = cvt_pk_bf16(a[2], a[3]); *(u32x2*)(gg + o) = w; } } }
    }
};
struct EpiTmp {
    static constexpr bool PERM = false, AFTER_DRAIN = false, MID = false;
    float* tmp;
    __device__ __forceinline__ void operator()(const f32x4 (&acc)[2][2][4][2], const Unit& u, int wr, int wc, int fr, int fq) const {
        const int row0 = u.pm * 256 + wr * 64 + fr, col0 = u.pn * 256 + wc * 32 + 4 * fq;
#pragma unroll
        for (int ai = 0; ai < 2; ++ai)
#pragma unroll
            for (int m = 0; m < 4; ++m) { const size_t off = (size_t)(row0 + ai * 128 + m * 16) * 1024 + col0;
#pragma unroll
                for (int bj = 0; bj < 2; ++bj)
#pragma unroll
                    for (int n = 0; n < 2; ++n) *(f32x4*)(tmp + off + bj * 128 + n * 16) = acc[ai][bj][m][n]; }
    }
};
struct EpiGate {
    static constexpr bool PERM = false, AFTER_DRAIN = false, MID = false;
    const float* tmp; const float* bias; bf16_t* merged; int first;
    __device__ __forceinline__ void operator()(const f32x4 (&acc)[2][2][4][2], const Unit& u, int wr, int wc, int fr, int fq) const {
        const int row0 = u.pm * 256 + wr * 64 + fr, col0 = u.pn * 256 + wc * 32 + 4 * fq;
#pragma unroll
        for (int ai = 0; ai < 2; ++ai)
#pragma unroll
            for (int m = 0; m < 4; ++m) { const size_t off = (size_t)(row0 + ai * 128 + m * 16) * 1024 + col0;
#pragma unroll
                for (int bj = 0; bj < 2; ++bj)
#pragma unroll
                    for (int n = 0; n < 2; ++n) { const size_t o = off + bj * 128 + n * 16; const f32x4 tv = *(const f32x4*)(tmp + o), b = *(const f32x4*)(bias + col0 + bj * 128 + n * 16), a = acc[ai][bj][m][n];
                        f32x4 v;
#pragma unroll
                        for (int e = 0; e < 4; ++e) v[e] = sigmoidf_(a[e] + b[e]) * tv[e];
                        if (!first) { const u32x2 old = *(const u32x2*)(merged + o); v[0] += bflo(old.x); v[1] += bfhi(old.x); v[2] += bflo(old.y); v[3] += bfhi(old.y); }
                        u32x2 w; w.x = cvt_pk_bf16(v[0], v[1]); w.y = cvt_pk_bf16(v[2], v[3]); *(u32x2*)(merged + o) = w; } }
    }
};

struct EpiSig {
    static constexpr bool PERM = false, AFTER_DRAIN = false, MID = true;
    bf16_t* G; const float* bias; const float* rowss; int tlast; mutable float rsv[8];
    __device__ __forceinline__ void mid(f32x4 (&)[2][2][4][2], const Unit& u, int t, int wr, int wc, int fr, int fq) const {
        if (rowss == nullptr || t != tlast) return;
        const float* rp = rowss + u.pm * 256 + wr * 64 + fr;
#pragma unroll
        for (int i = 0; i < 8; ++i) rsv[i] = rp[(i >> 2) * 128 + (i & 3) * 16];
    }
    __device__ __forceinline__ void operator()(const f32x4 (&acc)[2][2][4][2], const Unit& u, int wr, int wc, int fr, int fq) const {
        const int row0 = u.pm * 256 + wr * 64 + fr, col0 = u.pn * 256 + wc * 32 + 8 * fq;
#pragma unroll
        for (int ai = 0; ai < 2; ++ai)
#pragma unroll
            for (int m = 0; m < 4; ++m) { const int row = row0 + ai * 128 + m * 16; const size_t off = (size_t)row * 3072 + col0; const float rs = rsqrtf(rsv[ai * 4 + m] * (1.0f / 1024.0f) + 1e-6f);
#pragma unroll
                for (int bj = 0; bj < 2; ++bj) { const f32x4 b0 = *(const f32x4*)(bias + col0 + bj * 128), b1 = *(const f32x4*)(bias + col0 + bj * 128 + 4), a0 = acc[ai][bj][m][0], a1 = acc[ai][bj][m][1];
                    u32x4 w; w.x = cvt_pk_bf16(sigmoidf_(a0[0] * rs + b0[0]), sigmoidf_(a0[1] * rs + b0[1])); w.y = cvt_pk_bf16(sigmoidf_(a0[2] * rs + b0[2]), sigmoidf_(a0[3] * rs + b0[3]));
                    w.z = cvt_pk_bf16(sigmoidf_(a1[0] * rs + b1[0]), sigmoidf_(a1[1] * rs + b1[1])); w.w = cvt_pk_bf16(sigmoidf_(a1[2] * rs + b1[2]), sigmoidf_(a1[3] * rs + b1[3]));
                    *(u32x4*)(G + off + bj * 128) = w; } }
    }
};
struct EpiMix {
    static constexpr bool PERM = false, AFTER_DRAIN = false, MID = true;
    const bf16_t* G; bf16_t* merged;
    __device__ __forceinline__ void mid(f32x4 (&acc)[2][2][4][2], const Unit& u, int t, int wr, int wc, int fr, int fq) const {
        if (t != 8 && t != 12) return;
        const bf16_t* gp = G + (size_t)(u.pm * 256 + wr * 64 + fr) * 3072 + ((t == 8) ? 0 : 1024) + u.pn * 256 + wc * 32 + 8 * fq;
#pragma unroll
        for (int ai = 0; ai < 2; ++ai) {
#pragma unroll
            for (int m = 0; m < 4; ++m) {
#pragma unroll
                for (int bj = 0; bj < 2; ++bj) { f32x4 n0, n1, d0, d1; unpk8(*(const u32x4*)(gp + bj * 128), n0, n1); unpk8(*(const u32x4*)(gp + 1024 + bj * 128), d0, d1);
                    f32x4 r0, r1;
#pragma unroll
                    for (int e = 0; e < 4; ++e) { r0[e] = n0[e] * fast_rcp(d0[e]); r1[e] = n1[e] * fast_rcp(d1[e]); }
                    acc[ai][bj][m][0] *= r0; acc[ai][bj][m][1] *= r1; }
                gp += 16 * 3072; asm volatile("" : "+v"(gp) :: "memory"); }
            gp += 64 * 3072; asm volatile("" : "+v"(gp)); }
    }
    __device__ __forceinline__ void operator()(const f32x4 (&acc)[2][2][4][2], const Unit& u, int wr, int wc, int fr, int fq) const {
        const int row0 = u.pm * 256 + wr * 64 + fr, col0 = u.pn * 256 + wc * 32 + 8 * fq;
        const bf16_t* gp = G + (size_t)row0 * 3072 + 2048 + col0; bf16_t* mp = merged + (size_t)row0 * 1024 + col0;
        u32x4 c0 = *(const u32x4*)gp, c1 = *(const u32x4*)(gp + 128);
#pragma unroll
        for (int g = 0; g < 8; ++g) {
            const int ai = g >> 2, m = g & 3;
            const bf16_t* gn = gp + ((m == 3) ? 80 * 3072 : 16 * 3072);
            asm volatile("" : "+v"(gn));
            u32x4 n0 = c0, n1 = c1; if (g < 7) { n0 = *(const u32x4*)gn; n1 = *(const u32x4*)(gn + 128); }
#pragma unroll
            for (int bj = 0; bj < 2; ++bj) { f32x4 g0, g1; unpk8(bj ? c1 : c0, g0, g1); const f32x4 v0 = acc[ai][bj][m][0] * g0, v1 = acc[ai][bj][m][1] * g1;
                u32x4 w; w.x = cvt_pk_bf16(v0[0], v0[1]); w.y = cvt_pk_bf16(v0[2], v0[3]); w.z = cvt_pk_bf16(v1[0], v1[1]); w.w = cvt_pk_bf16(v1[2], v1[3]); *(u32x4*)(mp + bj * 128) = w; }
            asm volatile("" ::: "memory");
            gp = gn; mp += (m == 3) ? 80 * 1024 : 16 * 1024; c0 = n0; c1 = n1;
        }
    }
};

template <class Epi>
__device__ __forceinline__ void run_gemm(LAS unsigned char* lds, const bf16_t* A, const bf16_t* Bt, int M, int N, int K, const Epi& E) {
    Gemm g; g.A = A; g.Bt = Bt; g.M = M; g.N = N; g.K = K;
    StaticOrder S; S.init(M, N, (int)gridDim.x, (int)blockIdx.x);
    pg8::gemm_phase<Epi, StaticOrder, false>(lds, g, S, E, nullptr);
    __syncthreads();
}

constexpr int KSTR = 144, VSTR = 136;
constexpr int LK0 = 0, LK1 = 64 * KSTR, LVT = 2 * 64 * KSTR, LVTSZ = 128 * VSTR, LEX = LVT + 2 * LVTSZ;
constexpr float SC_LOG2E = 0.125f * 1.4426950408889634f;

template <int DV, bool TWO>
__device__ __forceinline__ void attn_core(LAS unsigned char* lds, const bf16_t* Qw, int ldq, const bf16_t* K0p, const bf16_t* K1p, int ldk,
                                          const bf16_t* Vp, int ldv, int ntiles, bool skip_last, f32x4 (&o)[DV / 16][2]) {
    const int tid = opaque_tid(), wave = tid >> 6, lane = tid & 63, r = lane & 15, quad = lane >> 4;
    const int kmap = TWO ? (wave >> 2) : 0;
    bf16x8 qf[2][2];
#pragma unroll
    for (int qt = 0; qt < 2; ++qt)
#pragma unroll
        for (int ks = 0; ks < 2; ++ks) qf[qt][ks] = *(const bf16x8*)(Qw + (size_t)(qt * 16 + r) * ldq + ks * 32 + quad * 8);
    float mrow[2] = {-INFINITY, -INFINITY}, lrow[2] = {0.f, 0.f};
#pragma unroll
    for (int dt = 0; dt < DV / 16; ++dt) { o[dt][0] = (f32x4){0.f, 0.f, 0.f, 0.f}; o[dt][1] = (f32x4){0.f, 0.f, 0.f, 0.f}; }
    u32x4 kreg[2], vreg[2];
    const int k_map = TWO ? (tid >> 8) : 0, k_row = TWO ? ((tid >> 2) & 63) : (tid >> 3), k_d = TWO ? (tid & 3) * 16 : (tid & 7) * 8;
    const bf16_t* kbase = (k_map ? K1p : K0p) + (size_t)k_row * ldk + k_d;
    const bool v_on = (DV == 128) || tid < 256;
    const int v_kp = (DV == 128) ? (tid >> 4) : (tid >> 3), v_dg = (DV == 128) ? (tid & 15) : (tid & 7);
    const bf16_t* vbase = Vp + (size_t)(2 * v_kp) * ldv + v_dg * 8;
    auto gload = [&](int tile) {
        const bf16_t* kp = kbase + (size_t)tile * 64 * ldk;
        kreg[0] = *(const u32x4*)kp; if (TWO) kreg[1] = *(const u32x4*)(kp + 8);
        if (v_on) { const bf16_t* vp = vbase + (size_t)tile * 64 * ldv; vreg[0] = *(const u32x4*)vp; vreg[1] = *(const u32x4*)(vp + ldv); }
    };
    bf16x8 pbp[2][2];
    bool prev = false;
    auto pv_half = [&](int vbuf, int h) {
#pragma unroll
        for (int d2 = 0; d2 < DV / 32; ++d2) { const int dt = h * (DV / 32) + d2;
#pragma unroll
            for (int kk = 0; kk < 2; ++kk) { LAS const unsigned char* vrow = lds + LVT + vbuf * LVTSZ + (dt * 16 + r) * VSTR;
                const u32x2 lo = *(LAS const u32x2*)(vrow + (((16 * kk + 2 * quad) ^ (4 * dt)) << 2)), hi = *(LAS const u32x2*)(vrow + (((16 * kk + 8 + 2 * quad) ^ (4 * dt)) << 2));
                u32x4 w; w.x = lo.x; w.y = lo.y; w.z = hi.x; w.w = hi.y; const bf16x8 vf = __builtin_bit_cast(bf16x8, w);
                o[dt][0] = __builtin_amdgcn_mfma_f32_16x16x32_bf16(vf, pbp[0][kk], o[dt][0], 0, 0, 0);
                o[dt][1] = __builtin_amdgcn_mfma_f32_16x16x32_bf16(vf, pbp[1][kk], o[dt][1], 0, 0, 0); } }
    };
    gload(0);
    for (int tile = 0; tile < ntiles; ++tile) {
        const int vb = tile & 1;
        __syncthreads();
        { LAS unsigned char* kd = lds + (k_map ? LK1 : LK0) + k_row * KSTR + k_d * 2;
          *(LAS u32x4*)kd = kreg[0]; if (TWO) *(LAS u32x4*)(kd + 16) = kreg[1];
          if (v_on) {
#pragma unroll
              for (int e = 0; e < 8; ++e) { const unsigned a = vreg[0][e >> 1], b = vreg[1][e >> 1];
                  const unsigned w = (e & 1) ? ((a >> 16) | (b & 0xffff0000u)) : ((a & 0xffffu) | (b << 16));
                  *(LAS unsigned*)(lds + LVT + vb * LVTSZ + (v_dg * 8 + e) * VSTR + ((v_kp ^ ((v_dg >> 1) << 2)) << 2)) = w; } } }
        __syncthreads();
        const bool active = !(skip_last && tile == ntiles - 1);
        if (!active) { if (prev) { pv_half(vb ^ 1, 0); pv_half(vb ^ 1, 1); prev = false; } continue; }
        f32x4 s[4][2];
#pragma unroll
        for (int kt = 0; kt < 4; ++kt) { s[kt][0] = (f32x4){0.f, 0.f, 0.f, 0.f}; s[kt][1] = (f32x4){0.f, 0.f, 0.f, 0.f};
#pragma unroll
            for (int ks = 0; ks < 2; ++ks) { const bf16x8 kf = *(const LAS bf16x8*)(lds + (kmap ? LK1 : LK0) + (kt * 16 + r) * KSTR + (ks * 32 + quad * 8) * 2);
                s[kt][0] = __builtin_amdgcn_mfma_f32_16x16x32_bf16(kf, qf[0][ks], s[kt][0], 0, 0, 0);
                s[kt][1] = __builtin_amdgcn_mfma_f32_16x16x32_bf16(kf, qf[1][ks], s[kt][1], 0, 0, 0); } }
        float alpha[2];
        auto softmax_q = [&](int qt, bf16x8 (&dst)[2]) {
            float mx = s[0][qt][0];
#pragma unroll
            for (int kt = 0; kt < 4; ++kt)
#pragma unroll
                for (int j = 0; j < 4; ++j) mx = fmaxf(mx, s[kt][qt][j]);
            mx = xquad_max(mx);
            const float mn = fmaxf(mrow[qt], mx * SC_LOG2E);
            alpha[qt] = __builtin_amdgcn_exp2f(mrow[qt] - mn); mrow[qt] = mn;
            float ps = 0.f; float p[4][4];
#pragma unroll
            for (int kt = 0; kt < 4; ++kt)
#pragma unroll
                for (int j = 0; j < 4; ++j) { p[kt][j] = __builtin_amdgcn_exp2f(s[kt][qt][j] * SC_LOG2E - mn); ps += p[kt][j]; }
            lrow[qt] = lrow[qt] * alpha[qt] + ps;
#pragma unroll
            for (int kk = 0; kk < 2; ++kk) { u32x4 w; w.x = cvt_pk_bf16(p[2 * kk][0], p[2 * kk][1]); w.y = cvt_pk_bf16(p[2 * kk][2], p[2 * kk][3]);
                w.z = cvt_pk_bf16(p[2 * kk + 1][0], p[2 * kk + 1][1]); w.w = cvt_pk_bf16(p[2 * kk + 1][2], p[2 * kk + 1][3]);
                dst[kk] = __builtin_bit_cast(bf16x8, w); }
        };
        bf16x8 pb0[2];
        if (prev) pv_half(vb ^ 1, 0);
        softmax_q(0, pb0);
        if (prev) pv_half(vb ^ 1, 1);
        if (tile + 1 < ntiles) gload(tile + 1);
        softmax_q(1, pbp[1]);
        pbp[0][0] = pb0[0]; pbp[0][1] = pb0[1];
#pragma unroll
        for (int qt = 0; qt < 2; ++qt) {
            if (__builtin_amdgcn_ballot_w64(alpha[qt] != 1.0f) != 0ull) {
#pragma unroll
                for (int dt = 0; dt < DV / 16; ++dt) o[dt][qt] *= alpha[qt]; } }
        prev = true;
    }
    if (prev) { const int vb = (ntiles - 1) & 1; pv_half(vb, 0); pv_half(vb, 1); }
#pragma unroll
    for (int qt = 0; qt < 2; ++qt) { float l = lrow[qt]; l = xquad_sum(l); const float inv = 1.0f / l;
#pragma unroll
        for (int dt = 0; dt < DV / 16; ++dt) o[dt][qt] *= inv; }
}

__device__ __forceinline__ void attention_phase(KP P, LAS unsigned char* lds) {
    const int tid = opaque_tid(), wave = tid >> 6, lane = tid & 63, r = lane & 15, quad = lane >> 4;
    const bf16_t* proj = (const bf16_t*)(P->ws + WS_ACT);
    const bf16_t* kvm = (const bf16_t*)(P->ws + WS_KVM);
    unsigned* qctr = (unsigned*)(P->ws + WS_QCTR);
    LAS unsigned* qslot = (LAS unsigned*)(lds + 120000);
    for (;;) {
        __syncthreads();
        if (tid == 0) {
            const unsigned x0 = ((unsigned)__builtin_amdgcn_s_getreg((3 << 11) | 20)) & 7u  ; unsigned got = 0xffffffffu;
            for (unsigned k = 0; k < 8u; ++k) { const unsigned q = (x0 + k) & 7u; const unsigned idx = __hip_atomic_fetch_add(qctr + q * 64u, 1u, __ATOMIC_RELAXED, __HIP_MEMORY_SCOPE_AGENT);
                if (idx < 384u) { got = q * 384u + idx; break; } }
            *qslot = got; }
        __syncthreads();
        const unsigned gotv = *qslot;
        if (gotv == 0xffffffffu) break;
        const int qx = (int)(gotv / 384u), qi = (int)(gotv % 384u);
        if (qi < 256) {
        const int qb = 31 - (qi & 31), bh = (qi >> 5) * 8 + qx, b = bh >> 2, h = bh & 3, map = wave >> 2, wq = wave & 3;
        const size_t tok0 = (size_t)b * SEQ;
        const int q0 = qb * 128 + wq * 32;
        f32x4 o[8][2];
        attn_core<128, true>(lds, proj + (tok0 + q0) * PLO + (2 * h + map) * 64, PLO, proj + tok0 * PLO + 512 + (2 * h) * 64, proj + tok0 * PLO + 512 + (2 * h + 1) * 64, PLO,
                             proj + tok0 * PLO + 1024 + h * 128, PLO, 2 * qb + 2, wq < 2, o);
        LAS float* ex = (LAS float*)(lds + LEX) + (size_t)wq * 4096 + lane;
        if (map == 1) {
            const float s1 = wave_sum(P->lq1[lane] * P->lk1[lane]), s2 = wave_sum(P->lq2[lane] * P->lk2[lane]); const float lam = expf(s1) - expf(s2) + 0.2f;
#pragma unroll
            for (int dt = 0; dt < 8; ++dt)
#pragma unroll
                for (int qt = 0; qt < 2; ++qt)
#pragma unroll
                    for (int j = 0; j < 4; ++j) ex[((dt * 2 + qt) * 4 + j) * 64] = o[dt][qt][j] * lam;
        }
        __syncthreads();
        if (map == 0) {
#pragma unroll
            for (int qt = 0; qt < 2; ++qt) { float ss = 0.f;
#pragma unroll
                for (int dt = 0; dt < 8; ++dt)
#pragma unroll
                    for (int j = 0; j < 4; ++j) { const float v = o[dt][qt][j] - ex[((dt * 2 + qt) * 4 + j) * 64]; o[dt][qt][j] = v; ss += v * v; }
                ss = xquad_sum(ss);
                const float rs = rsqrtf(ss * (1.0f / 128.0f) + 1e-6f) * 0.8f;
                int ro = r * 1024 + quad * 4; asm volatile("" : "+v"(ro));
                bf16_t* op = (bf16_t*)(P->ws + WS_OA) + (tok0 + q0 + qt * 16) * 1024 + h * 128 + ro;
#pragma unroll
                for (int dt = 0; dt < 8; ++dt) { const f32x4 g = *(const f32x4*)(P->subln + dt * 16 + quad * 4); const f32x4 v = o[dt][qt] * g * rs;
                    u32x2 w; w.x = cvt_pk_bf16(v[0], v[1]); w.y = cvt_pk_bf16(v[2], v[3]); *(u32x2*)(op + dt * 16) = w; } }
        }
    }
        else { const int j = qi - 256;
        const int b = (j >> 6) * 8 + qx, qblk = b * 16 + ((j & 63) >> 2), hx = j & 3;
        const size_t tokq = (size_t)qblk * 256 + wave * 32;
        f32x4 o[4][2];
        attn_core<64, false>(lds, proj + tokq * PLO + 2560 + hx * 64, PLO, kvm + (size_t)b * 256 * 512 + hx * 64, nullptr, 512,
                             kvm + (size_t)b * 256 * 512 + 256 + hx * 64, 512, 4, false, o);
#pragma unroll
        for (int qt = 0; qt < 2; ++qt) { int ro = r * 1024 + quad * 4; asm volatile("" : "+v"(ro)); bf16_t* op = (bf16_t*)(P->ws + WS_OA) + 768 + (tokq + qt * 16) * 1024 + hx * 64 + ro;
#pragma unroll
            for (int dt = 0; dt < 4; ++dt) { const f32x4 v = o[dt][qt]; u32x2 w; w.x = cvt_pk_bf16(v[0], v[1]); w.y = cvt_pk_bf16(v[2], v[3]); *(u32x2*)(op + dt * 16) = w; } }
    }
    }
}

__device__ __forceinline__ float red16(float v) { v += DPP_F(v, 0xB1); v += DPP_F(v, 0x4E); v += DPP_F(v, 0x141); v += DPP_F(v, 0x140); return v; }
constexpr int SB = 64;
__device__ __forceinline__ void rwkv_scan(KP P, LAS unsigned char* lds, int wg) {
    const int bh = wg >> 1, half = wg & 1, b = bh >> 2, h = bh & 3, tid = opaque_tid();
    LAS float* __restrict__ vec = (LAS float*)lds;
    LAS float* __restrict__ ybuf = (LAS float*)lds + SB * 384;
    const bf16_t* proj = (const bf16_t*)(P->ws + WS_ACT);
    const float* dec = (const float*)(P->ws + WS_DEC);
    const bf16_t* asg = (const bf16_t*)(P->ws + WS_ASG);
    float* yraw = (float*)(P->ws + WS_YRAW);
    const int tl = tid >> 4, l4 = (tid & 15) * 4, c4 = h * 64 + l4;
    const f32x4 mu_r = *(const f32x4*)(P->rw_mu + c4), mu_k = *(const f32x4*)(P->rw_mu + 256 + c4), mu_v = *(const f32x4*)(P->rw_mu + 512 + c4);
    const f32x4 kkp = *(const f32x4*)(P->rw_k_k + c4), kap = *(const f32x4*)(P->rw_k_a + c4);
    const int il = tid >> 4, irow = half * 32 + il;
    f32x4 st = {0.f, 0.f, 0.f, 0.f};
    constexpr int NP = SB / 32;
    u32x2 ur[NP], uk[NP], uv[NP], urp[NP], ukp[NP], uvp[NP], as2[NP]; f32x4 dc[NP];
    const size_t tokb = (size_t)b * SEQ;
    auto load_raw = [&](int blk) {
#pragma unroll
        for (int q = 0; q < NP; ++q) {
        const int tt = blk * SB + tl + 32 * q; const size_t tok = tokb + tt;
        const bf16_t* base = proj + tok * PLO + 1536 + c4;
        ur[q] = *(const u32x2*)base; uk[q] = *(const u32x2*)(base + 256); uv[q] = *(const u32x2*)(base + 512);
        if (tt > 0) { urp[q] = *(const u32x2*)(base - PLO); ukp[q] = *(const u32x2*)(base - PLO + 256); uvp[q] = *(const u32x2*)(base - PLO + 512); }
        else { urp[q] = (u32x2){0u, 0u}; ukp[q] = urp[q]; uvp[q] = urp[q]; }
        dc[q] = *(const f32x4*)(dec + tok * 256 + c4); as2[q] = *(const u32x2*)(asg + tok * 256 + c4); }
    };
    auto prep = [&]() {
#pragma unroll
        for (int q = 0; q < NP; ++q) {
        const f32x4 r0 = unpk4(ur[q]), rp = unpk4(urp[q]), k0 = unpk4(uk[q]), kp = unpk4(ukp[q]), v0 = unpk4(uv[q]), vp = unpk4(uvp[q]), a = unpk4(as2[q]);
        const f32x4 rr = r0 + (rp - r0) * mu_r, kx = k0 + (kp - k0) * mu_k, vv = v0 + (vp - v0) * mu_v;
        f32x4 kk = kx * kkp;
        const float nrm = sqrtf(red16(kk[0] * kk[0] + kk[1] * kk[1] + kk[2] * kk[2] + kk[3] * kk[3]));
        kk = kk * fast_rcp(fmaxf(nrm, 1e-12f));
        const f32x4 kmod = kx * (1.0f + (a - 1.0f) * kap);
        LAS float* vt = vec + (tl + 32 * q) * 384 + l4;
        *(LAS f32x4*)(vt) = rr; *(LAS f32x4*)(vt + 64) = dc[q]; *(LAS f32x4*)(vt + 128) = kmod; *(LAS f32x4*)(vt + 192) = -kk; *(LAS f32x4*)(vt + 256) = kk * a; *(LAS f32x4*)(vt + 320) = vv; }
    };
    load_raw(0); prep(); __syncthreads();
    for (int blk = 0; blk < SEQ / SB; ++blk) {
        if (blk + 1 < SEQ / SB) load_raw(blk + 1);
        {
            LAS const float* vt = vec;
            f32x4 a4 = *(LAS const f32x4*)(vt + 192 + l4), w4 = *(LAS const f32x4*)(vt + 64 + l4), b4 = *(LAS const f32x4*)(vt + 256 + l4), k4 = *(LAS const f32x4*)(vt + 128 + l4), r4 = *(LAS const f32x4*)(vt + l4);
            float vi = vt[320 + irow], yprev = 0.f;
#pragma unroll 4
            for (int t = 0; t < SB; ++t) {
                const int tn = (t + 1 < SB) ? t + 1 : t; LAS const float* vn = vec + tn * 384;
                const f32x4 a4n = *(LAS const f32x4*)(vn + 192 + l4), w4n = *(LAS const f32x4*)(vn + 64 + l4), b4n = *(LAS const f32x4*)(vn + 256 + l4), k4n = *(LAS const f32x4*)(vn + 128 + l4), r4n = *(LAS const f32x4*)(vn + l4);
                const float vin = vn[320 + irow];
                float sa = st[0] * a4[0] + st[1] * a4[1] + st[2] * a4[2] + st[3] * a4[3];
                sa += DPP_F(sa, 0xB1); yprev += DPP_F(yprev, 0xB1);
                sa += DPP_F(sa, 0x4E); yprev += DPP_F(yprev, 0x4E);
                sa += DPP_F(sa, 0x141); yprev += DPP_F(yprev, 0x141);
                sa += DPP_F(sa, 0x140); yprev += DPP_F(yprev, 0x140);
                if (t > 0 && (tid & 15) == 0) ybuf[(t - 1) * 32 + il] = yprev;
                st = st * w4 + (b4 * sa + k4 * vi);
                yprev = st[0] * r4[0] + st[1] * r4[1] + st[2] * r4[2] + st[3] * r4[3];
                a4 = a4n; w4 = w4n; b4 = b4n; k4 = k4n; r4 = r4n; vi = vin; }
            yprev = red16(yprev);
            if ((tid & 15) == 0) ybuf[(SB - 1) * 32 + il] = yprev; }
        __syncthreads();
#pragma unroll
        for (int q = 0; q < NP; ++q) { const size_t tok = tokb + blk * SB + tl + 32 * q; const int p2 = (tid & 15) * 2;
          const float y0 = ybuf[(tl + 32 * q) * 32 + p2], y1 = ybuf[(tl + 32 * q) * 32 + p2 + 1];
          float2 yy; yy.x = y0; yy.y = y1;
          *(float2*)(yraw + tok * 256 + h * 64 + half * 32 + p2) = yy; }
        if (blk + 1 < SEQ / SB) prep();
        __syncthreads();
    }
}
__device__ __forceinline__ void rwkv_post(KP P) {
    const bf16_t* proj = (const bf16_t*)(P->ws + WS_ACT);
    const bf16_t* asg = (const bf16_t*)(P->ws + WS_ASG);
    const bf16_t* ggp = (const bf16_t*)(P->ws + WS_GG);
    const float* yraw = (const float*)(P->ws + WS_YRAW);
    bf16_t* ob = (bf16_t*)(P->ws + WS_OA) + 512;
    const int idx0 = (int)blockIdx.x * 512 + opaque_tid(), stride = (int)gridDim.x * 512, c4 = (idx0 & 63) * 4;
    const f32x4 mu_r = *(const f32x4*)(P->rw_mu + c4), mu_k = *(const f32x4*)(P->rw_mu + 256 + c4), mu_v = *(const f32x4*)(P->rw_mu + 512 + c4);
    const f32x4 kap = *(const f32x4*)(P->rw_k_a + c4), rkp = *(const f32x4*)(P->rw_r_k + c4), lnw = *(const f32x4*)(P->rw_ln_w + c4), lnb = *(const f32x4*)(P->rw_ln_b + c4);
    struct Raw { u32x2 r0, k0, v0, rp, kp, vp, a, g; f32x4 y; };
    auto ld = [&](int idx, Raw& R) {
        const int tok = idx >> 6; const bf16_t* base = proj + (size_t)tok * PLO + 1536 + c4;
        R.r0 = *(const u32x2*)base; R.k0 = *(const u32x2*)(base + 256); R.v0 = *(const u32x2*)(base + 512);
        R.rp = (u32x2){0u, 0u}; R.kp = R.rp; R.vp = R.rp;
        if ((tok & (SEQ - 1)) != 0) { R.rp = *(const u32x2*)(base - PLO); R.kp = *(const u32x2*)(base - PLO + 256); R.vp = *(const u32x2*)(base - PLO + 512); }
        R.a = *(const u32x2*)(asg + (size_t)tok * 256 + c4); R.g = *(const u32x2*)(ggp + (size_t)tok * 256 + c4);
        R.y = *(const f32x4*)(yraw + (size_t)tok * 256 + c4);
    };
    auto cp = [&](int idx, const Raw& R) {
        const int tok = idx >> 6;
        const f32x4 r0 = unpk4(R.r0), k0 = unpk4(R.k0), v0 = unpk4(R.v0), rp = unpk4(R.rp), kp = unpk4(R.kp), vp = unpk4(R.vp), a = unpk4(R.a), g = unpk4(R.g), y = R.y;
        const f32x4 rr = r0 + (rp - r0) * mu_r, kx = k0 + (kp - k0) * mu_k, vv = v0 + (vp - v0) * mu_v;
        const f32x4 kmod = kx * (1.0f + (a - 1.0f) * kap), tb = rr * kmod * rkp;
        const float bon = red16(tb[0] + tb[1] + tb[2] + tb[3]);
        const float mean = red16(y[0] + y[1] + y[2] + y[3]) * (1.0f / 64.0f); const f32x4 d = y - mean;
        const float var = red16(d[0] * d[0] + d[1] * d[1] + d[2] * d[2] + d[3] * d[3]) * (1.0f / 64.0f);
        f32x4 yn = d * rsqrtf(var + 64e-5f) * lnw + lnb; yn = (yn + vv * bon) * g;
        u32x2 w; w.x = cvt_pk_bf16(yn[0], yn[1]); w.y = cvt_pk_bf16(yn[2], yn[3]);
        *(u32x2*)(ob + (size_t)tok * 1024 + c4) = w;
    };
    for (int idx = idx0; idx < T * 64; idx += 2 * stride) {
        Raw A, B; ld(idx, A); const bool hb = idx + stride < T * 64; if (hb) ld(idx + stride, B);
        cp(idx, A); if (hb) cp(idx + stride, B);
    }
}

#define XB_TMO      128
#define XB_XCNT(j)  (256  + 64 * (j))
#define XB_XSUB(j)  (1280 + 64 * (j))
#define XB_XGEN(j)  (2304 + 64 * (j))
#define XB_TOP      3328
#define XB_TOPGEN   3392
#define XCD_BAR_WORDS 3456
#define XB_SPIN_CAP (1u << 18)

__device__ __forceinline__ unsigned xb_ld(unsigned* p)              { return __hip_atomic_load(p, __ATOMIC_RELAXED, __HIP_MEMORY_SCOPE_AGENT); }
__device__ __forceinline__ unsigned xb_add(unsigned* p, unsigned v) { return __hip_atomic_fetch_add(p, v, __ATOMIC_RELAXED, __HIP_MEMORY_SCOPE_AGENT); }
__device__ __forceinline__ unsigned xb_xcc_id() { return (unsigned)__builtin_amdgcn_s_getreg((3 << 11) | 20) & 0xFu; }
#define XB_SPIN(cond, bar) do { unsigned _sp = 0; while (cond) { __builtin_amdgcn_s_sleep(1); \
    if ((++_sp & 255u) == 0u) { if (xb_ld(&(bar)[XB_TMO])) break; if (_sp > XB_SPIN_CAP) { atomicAdd(&(bar)[XB_TMO], 1u); break; } } } } while (0)

struct XcdBarrier {
    unsigned* bar; unsigned x;
    volatile PG8_LAS unsigned* st;
};

__device__ __forceinline__ XcdBarrier xcd_barrier_post(unsigned* bar, volatile PG8_LAS unsigned* st) {
    XcdBarrier b; b.bar = bar; b.x = xb_xcc_id(); b.st = st;
    if (threadIdx.x == 0) (void)xb_add(&bar[XB_XCNT(b.x)], 1u);
    return b;
}
__device__ __forceinline__ void xcd_barrier_complete(unsigned* bar, unsigned x, unsigned& nloc, unsigned& nx) {
    const unsigned G = gridDim.x * gridDim.y * gridDim.z;
    unsigned sum, cnt, mine, sp = 0u;
    for (;;) {
        sum = 0u; cnt = 0u; mine = 0u;
#pragma unroll
        for (unsigned j = 0; j < 16; ++j) { const unsigned c = xb_ld(&bar[XB_XCNT(j)]); sum += c; cnt += (c > 0u) ? 1u : 0u; mine = (j == x) ? c : mine; }
        if (sum == G) break;
        __builtin_amdgcn_s_sleep(1);
        if ((++sp & 255u) == 0u) { if (xb_ld(&bar[XB_TMO])) break; if (sp > XB_SPIN_CAP) { atomicAdd(&bar[XB_TMO], 1u); break; } }
    }
    nloc = mine > 0u ? mine : 1u; nx = cnt > 0u ? cnt : 1u;
}

__device__ __forceinline__ void xcd_barrier(const XcdBarrier& b) {
    asm volatile("s_waitcnt vmcnt(0)" ::: "memory");
    __syncthreads();
    if (threadIdx.x == 0) {
        unsigned* bar = b.bar;
        __builtin_amdgcn_s_waitcnt(0);
        unsigned nloc = b.st[0], nx = b.st[1];
        if (nloc == 0u) { xcd_barrier_complete(bar, b.x, nloc, nx); b.st[0] = nloc; b.st[1] = nx; }
        const unsigned old = xb_add(&bar[XB_XSUB(b.x)], 1u);
        const unsigned gen = old / nloc;
        if (old + 1u == (gen + 1u) * nloc) {
            __builtin_amdgcn_fence(__ATOMIC_RELEASE, "agent");
            asm volatile("s_waitcnt vmcnt(0)" ::: "memory");
            const unsigned og = xb_add(&bar[XB_TOP], 1u);
            const unsigned tg = og / nx;
            if (og + 1u == (tg + 1u) * nx) xb_add(&bar[XB_TOPGEN], 1u);
            else XB_SPIN(xb_ld(&bar[XB_TOPGEN]) == tg, bar);
            __builtin_amdgcn_fence(__ATOMIC_ACQUIRE, "agent");
            xb_add(&bar[XB_XGEN(b.x)], 1u);
            asm volatile("s_waitcnt vmcnt(0)" ::: "memory");
        } else {
            XB_SPIN(xb_ld(&bar[XB_XGEN(b.x)]) == gen, bar);
            __builtin_amdgcn_fence(__ATOMIC_ACQUIRE, "agent");
            asm volatile("s_waitcnt vmcnt(0)" ::: "memory");
        }
    }
    __syncthreads();
}
#define GRID_SYNC() do { XcdBarrier xb_; xb_.bar = (unsigned*)(ws + WS_BAR); xb_.x = xb_xcc_id(); xb_.st = (volatile PG8_LAS unsigned*)(lds + 131072); xcd_barrier(xb_); } while (0)
__global__ void __launch_bounds__(512, 2) fwd_megakernel(Params Pk_unused) {
#define P kp_fresh()
    extern __shared__ __attribute__((aligned(16))) unsigned char shm[];
    LAS unsigned char* lds = (LAS unsigned char*)shm;
    cg::grid_group grid = cg::this_grid();
#define ws (P->ws)
    const int nth = gridDim.x * 512;
#define GTID ((int)blockIdx.x * 512 + opaque_tid())
#define H ((bf16_t*)(ws + WS_H))
#define ACT ((bf16_t*)(ws + WS_ACT))
#define X (P->out)
#define CS ((float*)(ws + WS_CS))
    grid.sync();
    { volatile PG8_LAS unsigned* st = (volatile PG8_LAS unsigned*)(lds + 131072); if (threadIdx.x == 0) { st[0] = 0u; st[1] = 0u; } __syncthreads();
      (void)xcd_barrier_post((unsigned*)(ws + WS_BAR), st); }

    {
    { const float *w1 = P->ffn1_w1, *w3 = P->ffn1_w3, *w2 = P->ffn1_w2;
      conv_w((bf16_t*)(ws + W_UP1), 5632, 1024, [=](int R, int k) { return ((R & 128) ? w3 : w1)[(size_t)k * DFF + swiglu_col(R)]; }, lds);
      conv_w((bf16_t*)(ws + W_DN1), 1024, 2816, [=](int R, int k) { return w2[(size_t)k * 1024 + perm_col(R, false)]; }, lds); }
    { const float *w1 = P->ffn2_w1, *w3 = P->ffn2_w3, *w2 = P->ffn2_w2, *gn = P->ffn2_norm;
      conv_w((bf16_t*)(ws + W_UP2), 5632, 1024, [=](int R, int k) { return gn[k] * ((R & 128) ? w3 : w1)[(size_t)k * DFF + swiglu_col(R)]; }, lds);
      conv_w((bf16_t*)(ws + W_DN2), 1024, 2816, [=](int R, int k) { return w2[(size_t)k * 1024 + perm_col(R, false)]; }, lds); }
    { const float *wi = P->w_in, *gn = P->mix_norm;
      conv_w((bf16_t*)(ws + W_INLO), 2816, 1024, [=](int R, int k) { return gn[k] * wi[(size_t)k * PCOLS + perm_col(R, R < 1024)]; }, lds);
      conv_w((bf16_t*)(ws + W_GATE), 3072, 1024, [=](int R, int k) { return gn[k] * wi[(size_t)k * PCOLS + 2816 + perm_col(R, false)]; }, lds); }
    { const float *ua = P->w_up_a, *ub = P->w_up_b, *uc = P->w_up_c, *wo = P->w_out, *mk = P->w_mem_kv;
      conv_w((bf16_t*)(ws + W_UPA), 1024, 1024, [=](int R0, int k) { const int R = perm_col(R0, false); return k < 512 ? ua[(size_t)k * 1024 + R] : (k < 768 ? ub[(size_t)(k - 512) * 1024 + R] : uc[(size_t)(k - 768) * 1024 + R]); }, lds);
      conv_w((bf16_t*)(ws + W_OUT), 1024, 1024, [=](int R, int k) { return wo[(size_t)k * 1024 + perm_col(R, false)]; }, lds);
      conv_w((bf16_t*)(ws + W_MKV), 512, 1024, [=](int R, int k) { return mk[(size_t)k * 512 + perm_col(R, false)]; }, lds); }
    { const float *w2 = P->rw_w2, *a2 = P->rw_a2, *g2 = P->rw_g2;
      conv_w((bf16_t*)(ws + W_LR), 768, 256, [=](int R, int k) { float v = 0.f;
          if (R < 256) { if (k < 64) v = w2[k * 256 + R]; }
          else if (R < 512) { if (k >= 64 && k < 128) v = a2[(k - 64) * 256 + (R - 256)]; }
          else { if (k >= 128) v = g2[(k - 128) * 256 + (R - 512)]; }
          return v; }, lds); }
    for (int idx = GTID; idx < 2 * T; idx += nth) ((float*)(ws + WS_SS1))[idx] = 0.f;
    norm_rows(P->x, P->ffn1_norm, H, nullptr, T);
    norm_rows(P->mem, P->mem_norm, (bf16_t*)(ws + WS_HM), nullptr, MEMT);
    for (int idx = GTID; idx < T * 8; idx += nth) {
        const int t = idx >> 3, i = idx & 7;
        const float ang = (float)P->pos[t] * INVF[i];
        const double rev = (double)ang * 0.15915494309189535; const double fr = rev - rint(rev); const double rr = fr * 6.283185307179586, r2 = rr * rr;
        double cterm = 1.0, sterm = rr, cc = 1.0, sn = rr;
#pragma unroll
        for (int k = 1; k <= 14; ++k) { cterm *= -r2 * (1.0 / ((2.0 * k - 1.0) * (2.0 * k))); sterm *= -r2 * (1.0 / ((2.0 * k) * (2.0 * k + 1.0))); cc += cterm; sn += sterm; }
        CS[idx * 2] = (float)cc; CS[idx * 2 + 1] = (float)sn;
    }
    GRID_SYNC();
    { EpiSwiglu e; e.act = ACT; e.rowss = nullptr; e.tlast = 14; run_gemm(lds, H, (const bf16_t*)(ws + W_UP1), T, 5632, 1024, e); }
    GRID_SYNC();
    { EpiRes<true, false, false, true> e; e.resf = P->x; e.resb = nullptr; e.outf = nullptr; e.outb = H; e.rowss = (float*)(ws + WS_SS1); run_gemm(lds, ACT, (const bf16_t*)(ws + W_DN1), T, 1024, 2816, e); }
    GRID_SYNC();
    { EpiPerm e; e.O = ACT; e.ld = PLO; e.cs = CS; e.rowss = (const float*)(ws + WS_SS1); e.tlast = 14; run_gemm(lds, H, (const bf16_t*)(ws + W_INLO), T, 2816, 1024, e); }
    GRID_SYNC();
    { EpiPerm e; e.O = (bf16_t*)(ws + WS_KVM); e.ld = 512; e.cs = nullptr; e.rowss = nullptr; e.tlast = 14; run_gemm(lds, (const bf16_t*)(ws + WS_HM), (const bf16_t*)(ws + W_MKV), MEMT, 512, 1024, e); }
    { bf16_t* alr = (bf16_t*)(ws + WS_ALR);
      if (blockIdx.x >= 32) for (int idx = ((int)blockIdx.x - 32) * 512 + opaque_tid(); idx < T * 32; idx += ((int)gridDim.x - 32) * 512) {
          const int t = idx >> 5, col = (idx & 31) * 8;
          const bf16_t* up = ACT + (size_t)t * PLO + 1536 + 768 + col;
          const u32x4 cur = *(const u32x4*)up; u32x4 prv = {0u, 0u, 0u, 0u}; if ((t & (SEQ - 1)) != 0) prv = *(const u32x4*)(up - PLO);
          const f32x4 m0 = *(const f32x4*)(P->rw_mu + 768 + col), m1 = *(const f32x4*)(P->rw_mu + 768 + col + 4);
          float v[8];
#pragma unroll
          for (int e = 0; e < 8; ++e) { const float cu = (e & 1) ? bfhi(cur[e >> 1]) : bflo(cur[e >> 1]), pv = (e & 1) ? bfhi(prv[e >> 1]) : bflo(prv[e >> 1]);
              const float mu = e < 4 ? m0[e & 3] : m1[e & 3]; const float xs = cu + (pv - cu) * mu;
              v[e] = col < 64 ? (1.0f - 2.0f * fast_rcp(__expf(2.0f * xs) + 1.0f)) : (col < 128 ? xs : sigmoidf_(xs)); }
          u32x4 w; w.x = cvt_pk_bf16(v[0], v[1]); w.y = cvt_pk_bf16(v[2], v[3]); w.z = cvt_pk_bf16(v[4], v[5]); w.w = cvt_pk_bf16(v[6], v[7]);
          *(u32x4*)(alr + (size_t)t * 256 + col) = w; } }
    GRID_SYNC();
    { EpiLR e; e.dec = (float*)(ws + WS_DEC); e.asg = (bf16_t*)(ws + WS_ASG); e.gg = (bf16_t*)(ws + WS_GG); e.w0 = P->rw_w0; e.a0 = P->rw_a0;
      run_gemm(lds, (const bf16_t*)(ws + WS_ALR), (const bf16_t*)(ws + W_LR), T, 768, 256, e); }
    GRID_SYNC();
    if ((int)blockIdx.x < NSCAN) rwkv_scan(P, lds, blockIdx.x);
    attention_phase(P, lds);
    GRID_SYNC();
    rwkv_post(P);
    GRID_SYNC();
    { EpiSig e; e.G = (bf16_t*)(ws + WS_ACT); e.bias = P->gate_bias; e.rowss = (const float*)(ws + WS_SS1); e.tlast = 14; run_gemm(lds, H, (const bf16_t*)(ws + W_GATE), T, 3072, 1024, e); }
    GRID_SYNC();
    { EpiMix e; e.G = (const bf16_t*)(ws + WS_ACT); e.merged = (bf16_t*)(ws + WS_DEC); run_gemm(lds, (const bf16_t*)(ws + WS_OA), (const bf16_t*)(ws + W_UPA), T, 1024, 1024, e); }
    GRID_SYNC();
    { EpiRes<false, true, false, true> e; e.resf = nullptr; e.resb = H; e.outf = nullptr; e.outb = H; e.rowss = (float*)(ws + WS_SS2); run_gemm(lds, (const bf16_t*)(ws + WS_DEC), (const bf16_t*)(ws + W_OUT), T, 1024, 1024, e); }
    GRID_SYNC();
    { EpiSwiglu e; e.act = ACT; e.rowss = (const float*)(ws + WS_SS2); e.tlast = 14; run_gemm(lds, H, (const bf16_t*)(ws + W_UP2), T, 5632, 1024, e); }
    GRID_SYNC();
    { EpiRes<true, true, false, false> e; e.resf = nullptr; e.resb = H; e.outf = nullptr; e.outb = H; e.rowss = nullptr; run_gemm(lds, ACT, (const bf16_t*)(ws + W_DN2), T, 1024, 2816, e); }
    GRID_SYNC();
    norm_rows_b(H, P->final_norm, X, T);
    }
}

#undef P
#undef ws
#undef H
#undef ACT
#undef X
#undef CS
#undef GTID
extern "C" void kernel_launch(void* const* d_in, const int* in_sizes, int n_in, void* d_out, int out_size, void* d_ws, size_t ws_size, hipStream_t stream) {
    constexpr int LDS_BYTES = 131072 + 256;
    static int grid_blocks = 0;
    if (grid_blocks == 0) {
        if (n_in != 37 || ws_size < WS_END) { fprintf(stderr, "kernel_launch: unexpected inputs (n_in %d, ws %zu, need %zu)\n", n_in, ws_size, (size_t)WS_END); grid_blocks = -1; return; }
        int dev = 0, cus = 0, per_cu = 0;
        hipGetDevice(&dev);
        hipDeviceGetAttribute(&cus, hipDeviceAttributeMultiprocessorCount, dev);
        hipFuncSetAttribute((const void*)fwd_megakernel, hipFuncAttributeMaxDynamicSharedMemorySize, LDS_BYTES);
        hipOccupancyMaxActiveBlocksPerMultiprocessor(&per_cu, (const void*)fwd_megakernel, 512, LDS_BYTES);
        if (per_cu < 1) per_cu = 1;
        grid_blocks = cus * per_cu;
        (void)hipGetLastError();
    }
    if (grid_blocks < 0) return;
    hipMemsetAsync((unsigned char*)d_ws + WS_BAR, 0, 16384 + 2048, stream);
    Params p{};
    p.x = (const float*)d_in[0]; p.mem = (const float*)d_in[1]; p.pos = (const int*)d_in[2];
    p.ffn1_norm = (const float*)d_in[3]; p.ffn1_w1 = (const float*)d_in[4]; p.ffn1_w3 = (const float*)d_in[5]; p.ffn1_w2 = (const float*)d_in[6];
    p.mix_norm = (const float*)d_in[7]; p.w_in = (const float*)d_in[8]; p.gate_bias = (const float*)d_in[9];
    p.lq1 = (const float*)d_in[10]; p.lk1 = (const float*)d_in[11]; p.lq2 = (const float*)d_in[12]; p.lk2 = (const float*)d_in[13]; p.subln = (const float*)d_in[14];
    p.rw_mu = (const float*)d_in[15]; p.rw_w0 = (const float*)d_in[16]; p.rw_w2 = (const float*)d_in[17]; p.rw_a0 = (const float*)d_in[18]; p.rw_a2 = (const float*)d_in[19];
    p.rw_g2 = (const float*)d_in[20]; p.rw_k_k = (const float*)d_in[21]; p.rw_k_a = (const float*)d_in[22]; p.rw_r_k = (const float*)d_in[23];
    p.rw_ln_w = (const float*)d_in[24]; p.rw_ln_b = (const float*)d_in[25];
    p.mem_norm = (const float*)d_in[26]; p.w_mem_kv = (const float*)d_in[27]; p.w_up_a = (const float*)d_in[28]; p.w_up_b = (const float*)d_in[29]; p.w_up_c = (const float*)d_in[30];
    p.w_out = (const float*)d_in[31]; p.ffn2_norm = (const float*)d_in[32]; p.ffn2_w1 = (const float*)d_in[33]; p.ffn2_w3 = (const float*)d_in[34]; p.ffn2_w2 = (const float*)d_in[35];
    p.final_norm = (const float*)d_in[36];
    p.out = (float*)d_out; p.ws = (unsigned char*)d_ws;
    void* args[] = {&p};
    hipError_t e = hipLaunchCooperativeKernel((const void*)fwd_megakernel, dim3(grid_blocks), dim3(512), args, LDS_BYTES, stream);
    if (e != hipSuccess) fprintf(stderr, "cooperative launch failed: %s (grid %d)\n", hipGetErrorString(e), grid_blocks);
}
```

```cpp
#include <hip/hip_runtime.h>
#include <hip/hip_cooperative_groups.h>
#include <cstdio>
namespace pg8 {
#define PG8_LAS __attribute__((address_space(3)))
typedef unsigned short bf16_t;
typedef short bf16x8 __attribute__((ext_vector_type(8)));
typedef float f32x4 __attribute__((ext_vector_type(4)));
typedef unsigned u32x4 __attribute__((ext_vector_type(4)));
constexpr int BM = 256, BK = 64, HALF = 128, HTB = HALF * BK * 2  , STAGE_BYTES = 8 * HTB, NXCD = 8, WGM = 8;

__host__ __device__ __forceinline__ int lds_byte(int r, int c) { const int st = (r >> 4) * 2 + (c >> 5), rr = r & 15, cc = c & 31, ob = rr * 64 + cc * 2; return st * 1024 + (ob ^ (((ob >> 9) & 1) << 5)); }
__host__ __device__ __forceinline__ void stage_rc(int b, int& R, int& C) { const int st = b / 1024, sb = b % 1024, swz = sb ^ (((sb >> 9) & 1) << 5); R = (st >> 1) * 16 + swz / 64; C = (st & 1) * 32 + (swz % 64) / 2; }
__host__ __device__ __forceinline__ int perm32(int rho) { const int n = rho >> 4, i = rho & 15; return 8 * (i >> 2) + 4 * n + (i & 3); }

struct Unit { int pm, pn; };
struct Gemm { const bf16_t* A; const bf16_t* Bt; int M, N, K; };

struct StaticOrder {
    int nM, nN, nwg, G, c;
    __host__ __device__ void init(int M, int N, int G_, int c_) { nM = M / BM; nN = N / BM; nwg = nM * nN; G = G_; c = c_; }
    __host__ __device__ bool next(int i, Unit& u) const {
        const long L = (long)i * G + c; if (L >= nwg) return false;
        int wgid = (int)L; { const int q = nwg / NXCD, r = nwg % NXCD, xcd = wgid % NXCD, off = wgid / NXCD; wgid = (xcd < r ? xcd * (q + 1) : r * (q + 1) + (xcd - r) * q) + off; }
        const int nig = WGM * nN, gid = wgid / nig, fm = gid * WGM, gsz = (nM - fm) < WGM ? (nM - fm) : WGM;
        u.pm = fm + ((wgid % nig) % gsz); u.pn = (wgid % nig) / gsz; return true;
    }
    __device__ __forceinline__ void a_ready(const Unit&) const {}
    __device__ __forceinline__ void done(const Unit&) const {}
};
typedef float f32x2_c __attribute__((ext_vector_type(2))); typedef __bf16 bf16x2_c __attribute__((ext_vector_type(2)));
__device__ __forceinline__ unsigned cvt_pk_bf16(float lo, float hi) { const f32x2_c v = {lo, hi}; const bf16x2_c b = __builtin_convertvector(v, bf16x2_c); return __builtin_bit_cast(unsigned, b); }
template <class Epi, class Sched, bool STAMP = false>
__device__ __forceinline__ void gemm_phase(PG8_LAS unsigned char* lds, const Gemm g, const Sched& S, const Epi& E, unsigned long long* stamps) {
    int tid_l = threadIdx.x; asm volatile("" : "+v"(tid_l)); const int tid = tid_l, wid = __builtin_amdgcn_readfirstlane(tid >> 6), lane = tid & 63, wr = wid >> 2, wc = wid & 3, fr = lane & 15, fq = lane >> 4;
    const int K = g.K, nt = K / BK;
    int ts_lo = 0, ts_hi = 0, nts = 0; const unsigned long long rt_entry = STAMP ? (unsigned long long)wall_clock64() : 0ull;
#define PG8_STAMP() do { if (STAMP && wid == 0 && nts < 64) { const unsigned long long _c = (unsigned long long)clock64(); \
        ts_lo = (lane == nts) ? (int)(unsigned)_c : ts_lo; ts_hi = (lane == nts) ? (int)(unsigned)(_c >> 32) : ts_hi; ++nts; } } while (0)
    PG8_STAMP();
    unsigned voffA[2], voffB[2];
#pragma unroll
    for (int i = 0; i < 2; ++i) { int R, C; stage_rc(tid * 16 + i * 8192, R, C); const int Rb = Epi::PERM ? ((R & ~31) + perm32(R & 31)) : R;
        voffA[i] = (unsigned)(R * K + C) * 2u; voffB[i] = (unsigned)(Rb * K + C) * 2u; }
    const size_t kstep = (size_t)(BK * 2);
    const size_t hstep = (size_t)HALF * K * 2;
    const size_t tstep = 2 * hstep;
    const unsigned ldsw = (unsigned)wid * 1024u;
    const int aoff = lds_byte(wr * 64 + fr, fq * 8), boff = lds_byte(wc * 32 + fr, fq * 8);
#define PG8_SA(b, h) (((b) * 2 + (h)) * HTB)
#define PG8_SB(b, h) ((4 + (b) * 2 + (h)) * HTB)
#define PG8_STAGE(bufoff, gbase, voff) do { _Pragma("unroll") for (int _i = 0; _i < 2; ++_i) \
        __builtin_amdgcn_global_load_lds((const unsigned*)((const char*)(gbase) + (voff)[_i]), (PG8_LAS unsigned*)(lds + (bufoff) + ldsw + _i * 8192), 16, 0, 0); } while (0)
#define PG8_LDA(dst, b, h) do { _Pragma("unroll") for (int m = 0; m < 4; ++m) _Pragma("unroll") for (int k = 0; k < 2; ++k) dst[m][k] = *(const PG8_LAS bf16x8*)(lds + PG8_SA(b, h) + aoff + m * 2048 + k * 1024); } while (0)
#define PG8_LDB(dst, b, h) do { _Pragma("unroll") for (int n = 0; n < 2; ++n) _Pragma("unroll") for (int k = 0; k < 2; ++k) dst[n][k] = *(const PG8_LAS bf16x8*)(lds + PG8_SB(b, h) + boff + n * 2048 + k * 1024); } while (0)
#define PG8_MMA(ai, bj, At, Bt) do { __builtin_amdgcn_s_setprio(1); _Pragma("unroll") for (int m = 0; m < 4; ++m) _Pragma("unroll") for (int n = 0; n < 2; ++n) _Pragma("unroll") for (int k = 0; k < 2; ++k) \
        acc[ai][bj][m][n] = __builtin_amdgcn_mfma_f32_16x16x32_bf16(Bt[n][k], At[m][k], acc[ai][bj][m][n], 0, 0, 0); __builtin_amdgcn_s_setprio(0); } while (0)
#define PG8_WAIT_V(n) asm volatile("s_waitcnt vmcnt(" #n ")" ::: "memory")
#define PG8_WAIT_L(n) asm volatile("s_waitcnt lgkmcnt(" #n ")" ::: "memory")
#define PG8_BAR __builtin_amdgcn_s_barrier()
#define PG8_SCHED __builtin_amdgcn_sched_barrier(0)
    Unit cur, nxt; int ui = 0;
    if (!S.next(0, cur)) return;
    f32x4 acc[2][2][4][2];
#pragma unroll
    for (int a = 0; a < 2; ++a)
#pragma unroll
        for (int b = 0; b < 2; ++b)
#pragma unroll
            for (int m = 0; m < 4; ++m)
#pragma unroll
                for (int n = 0; n < 2; ++n) acc[a][b][m][n] = (f32x4){0.f, 0.f, 0.f, 0.f};
    bf16x8 At[4][2], B0[2][2], B1[2][2];
    const char* cA = (const char*)g.A + (size_t)cur.pm * tstep; const char* cB = (const char*)g.Bt + (size_t)cur.pn * tstep;
    S.a_ready(cur);
    PG8_STAGE(PG8_SB(0, 0), cB, voffB); PG8_STAGE(PG8_SA(0, 0), cA, voffA); PG8_STAGE(PG8_SB(0, 1), cB + hstep, voffB); PG8_STAGE(PG8_SA(0, 1), cA + hstep, voffA);
    if (wr == 1) PG8_BAR;
    PG8_WAIT_V(4); PG8_BAR;
    PG8_STAGE(PG8_SB(1, 0), cB + kstep, voffB); PG8_STAGE(PG8_SA(1, 0), cA + kstep, voffA); PG8_STAGE(PG8_SB(1, 1), cB + hstep + kstep, voffB);
    PG8_WAIT_V(6); PG8_BAR;
    PG8_STAMP();
    for (;;) {
        const bool has_next = S.next(ui + 1, nxt);
        const char* nA = has_next ? (const char*)g.A + (size_t)nxt.pm * tstep : cA; const char* nB = has_next ? (const char*)g.Bt + (size_t)nxt.pn * tstep : cB;
        for (int t = 0; t < nt; t += 2) {
            const bool last = (t == nt - 2);
            const char* a1 = cA + (size_t)(t + 1) * kstep;
            const char* a2 = last ? nA : cA + (size_t)(t + 2) * kstep; const char* b2 = last ? nB : cB + (size_t)(t + 2) * kstep;
            const char* a3 = a2 + kstep; const char* b3 = b2 + kstep;
            if (last && has_next) S.a_ready(nxt);
            if constexpr (Epi::MID) E.mid(acc, cur, t, wr, wc, fr, fq);
            PG8_LDB(B0, 0, 0); PG8_SCHED; PG8_LDA(At, 0, 0); PG8_STAGE(PG8_SA(1, 1), a1 + hstep, voffA);
            PG8_WAIT_L(8); PG8_BAR; PG8_WAIT_L(0); PG8_MMA(0, 0, At, B0); PG8_BAR; PG8_SCHED;
            PG8_LDB(B1, 0, 1); PG8_STAGE(PG8_SB(0, 0), b2, voffB);
            PG8_BAR; PG8_WAIT_L(0); PG8_MMA(0, 1, At, B1); PG8_BAR;
            PG8_LDA(At, 0, 1); PG8_STAGE(PG8_SA(0, 0), a2, voffA);
            PG8_BAR; PG8_WAIT_L(0); PG8_MMA(1, 0, At, B0); PG8_BAR; PG8_SCHED;
            PG8_STAGE(PG8_SB(0, 1), b2 + hstep, voffB);
            PG8_WAIT_V(6); PG8_BAR; PG8_MMA(1, 1, At, B1); PG8_BAR;
            PG8_LDB(B0, 1, 0); PG8_SCHED; PG8_LDA(At, 1, 0); PG8_STAGE(PG8_SA(0, 1), a2 + hstep, voffA);
            PG8_WAIT_L(8); PG8_BAR; PG8_WAIT_L(0); PG8_MMA(0, 0, At, B0); PG8_BAR; PG8_SCHED;
            PG8_LDB(B1, 1, 1); PG8_STAGE(PG8_SB(1, 0), b3, voffB);
            PG8_BAR; PG8_WAIT_L(0); PG8_MMA(0, 1, At, B1); PG8_BAR;
            PG8_LDA(At, 1, 1); PG8_STAGE(PG8_SA(1, 0), a3, voffA);
            PG8_BAR; PG8_WAIT_L(0); PG8_MMA(1, 0, At, B0); PG8_BAR; PG8_SCHED;
            PG8_STAGE(PG8_SB(1, 1), b3 + hstep, voffB);
            PG8_WAIT_V(6); PG8_BAR; PG8_MMA(1, 1, At, B1); PG8_BAR;
        }
        PG8_STAMP();
        if constexpr (!Epi::AFTER_DRAIN) { E(acc, cur, wr, wc, fr, fq); S.done(cur); }
        PG8_STAMP();
        if (!has_next) break;
#pragma unroll
        for (int a = 0; a < 2; ++a)
#pragma unroll
            for (int b = 0; b < 2; ++b)
#pragma unroll
                for (int m = 0; m < 4; ++m)
#pragma unroll
                    for (int n = 0; n < 2; ++n) acc[a][b][m][n] = (f32x4){0.f, 0.f, 0.f, 0.f};
        cur = nxt; cA = nA; cB = nB; ++ui;
    }
    PG8_WAIT_V(0);
    if (wr == 0) PG8_BAR;
    PG8_BAR;
    if constexpr (Epi::AFTER_DRAIN) { E.fused(acc, cur, wr, wc, fr, fq, lds, wid, lane); S.done(cur); }
    PG8_STAMP();
    if (STAMP && wid == 0) { stamps[lane] = lane < nts ? (((unsigned long long)(unsigned)ts_hi << 32) | (unsigned)ts_lo) : 0ull;
        if (lane == 62) stamps[62] = rt_entry; if (lane == 63) stamps[63] = (unsigned long long)wall_clock64(); }
#undef PG8_STAMP
#undef PG8_SA
#undef PG8_SB
#undef PG8_STAGE
#undef PG8_LDA
#undef PG8_LDB
#undef PG8_MMA
#undef PG8_WAIT_V
#undef PG8_WAIT_L
#undef PG8_BAR
#undef PG8_SCHED
}
}
namespace cg = cooperative_groups;
using pg8::bf16_t; using pg8::bf16x8; using pg8::f32x4; using pg8::cvt_pk_bf16; using pg8::Unit; using pg8::Gemm; using pg8::StaticOrder;
typedef unsigned u32x2 __attribute__((ext_vector_type(2)));
typedef unsigned u32x4 __attribute__((ext_vector_type(4)));
#define LAS PG8_LAS

constexpr int T = 65536, SEQ = 4096, DM = 1024, DFF = 2816, PCOLS = 5888, PLO = 2816, MEMT = 4096;
constexpr int NSCAN = 128;

constexpr size_t W_UP1 = 0;
constexpr size_t W_DN1 = W_UP1 + (size_t)5632 * 1024 * 2;
constexpr size_t W_UP2 = W_DN1 + (size_t)1024 * 2816 * 2;
constexpr size_t W_DN2 = W_UP2 + (size_t)5632 * 1024 * 2;
constexpr size_t W_INLO = W_DN2 + (size_t)1024 * 2816 * 2;
constexpr size_t W_GATE = W_INLO + (size_t)2816 * 1024 * 2;
constexpr size_t W_UPA = W_GATE + (size_t)3072 * 1024 * 2;
constexpr size_t W_UPB = W_UPA + (size_t)1024 * 512 * 2;
constexpr size_t W_UPC = W_UPB + (size_t)1024 * 256 * 2;
constexpr size_t W_OUT = W_UPC + (size_t)1024 * 256 * 2;
constexpr size_t W_MKV = W_OUT + (size_t)1024 * 1024 * 2;
constexpr size_t W_LR = W_MKV + (size_t)512 * 1024 * 2;
constexpr size_t WS_ACT = W_LR + (size_t)768 * 256 * 2;
constexpr size_t WS_ALR = WS_ACT + (size_t)T * 2816 * 2;
constexpr size_t WS_H = WS_ALR + (size_t)T * 256 * 2;
constexpr size_t WS_DEC = WS_H + (size_t)T * 1024 * 2;
constexpr size_t WS_ASG = WS_DEC + (size_t)T * 256 * 4;
constexpr size_t WS_GG = WS_ASG + (size_t)T * 256 * 2;
constexpr size_t WS_OA = WS_GG + (size_t)T * 256 * 2;
constexpr size_t WS_OB = WS_OA + (size_t)T * 512 * 2;
constexpr size_t WS_OC = WS_OB + (size_t)T * 256 * 2;
constexpr size_t WS_CS = WS_OC + (size_t)T * 256 * 2;
constexpr size_t WS_HM = WS_CS + (size_t)T * 16 * 4;
constexpr size_t WS_KVM = WS_HM + (size_t)MEMT * 1024 * 2;
constexpr size_t WS_BAR = WS_KVM + (size_t)MEMT * 512 * 2;
constexpr size_t WS_QCTR = WS_BAR + 16384;
constexpr size_t WS_SS1 = WS_BAR + 16384 + 2048;
constexpr size_t WS_SS2 = WS_SS1 + (size_t)T * 4;
constexpr size_t WS_YRAW = WS_SS2 + (size_t)T * 4;
constexpr size_t WS_END = WS_YRAW + (size_t)T * 256 * 4;

struct Params {
    const float* x; const float* mem; const int* pos;
    const float *ffn1_norm, *ffn1_w1, *ffn1_w3, *ffn1_w2, *mix_norm, *w_in, *gate_bias;
    const float *lq1, *lk1, *lq2, *lk2, *subln;
    const float *rw_mu, *rw_w0, *rw_w2, *rw_a0, *rw_a2, *rw_g2, *rw_k_k, *rw_k_a, *rw_r_k, *rw_ln_w, *rw_ln_b;
    const float *mem_norm, *w_mem_kv, *w_up_a, *w_up_b, *w_up_c, *w_out;
    const float *ffn2_norm, *ffn2_w1, *ffn2_w3, *ffn2_w2, *final_norm;
    float* out; unsigned char* ws;
};

typedef const __attribute__((address_space(4))) Params* KP;
__device__ __forceinline__ KP kp_fresh() { KP p = (KP)__builtin_amdgcn_kernarg_segment_ptr(); asm volatile("" : "+s"(p)); return p; }

__constant__ float INVF[8] = {1.0f, 0.1939227432012558f, 0.03760603070259094f, 0.007292664609849453f, 0.0014142135623842478f,
                              0.00027424818836152554f, 5.3182957344688475e-05f, 1.0313385246263351e-05f};

__device__ __forceinline__ float bf2f(bf16_t b) { return __uint_as_float(((unsigned)b) << 16); }
__device__ __forceinline__ float bflo(unsigned w) { return __uint_as_float(w << 16); }
__device__ __forceinline__ float bfhi(unsigned w) { return __uint_as_float(w & 0xffff0000u); }
__device__ __forceinline__ bf16_t f2bf(float f) { return (bf16_t)(cvt_pk_bf16(f, 0.f) & 0xffffu); }
__device__ __forceinline__ f32x4 unpk4(u32x2 w) { f32x4 r; r[0] = bflo(w.x); r[1] = bfhi(w.x); r[2] = bflo(w.y); r[3] = bfhi(w.y); return r; }
__device__ __forceinline__ float xquad_max(float x) {
    auto a = __builtin_amdgcn_permlane32_swap(__float_as_uint(x), __float_as_uint(x), false, false);
    const float m = fmaxf(__uint_as_float(a[0]), __uint_as_float(a[1]));
    auto b = __builtin_amdgcn_permlane16_swap(__float_as_uint(m), __float_as_uint(m), false, false);
    return fmaxf(__uint_as_float(b[0]), __uint_as_float(b[1]));
}
__device__ __forceinline__ float xquad_sum(float x) {
    auto a = __builtin_amdgcn_permlane32_swap(__float_as_uint(x), __float_as_uint(x), false, false);
    const float m = __uint_as_float(a[0]) + __uint_as_float(a[1]);
    auto b = __builtin_amdgcn_permlane16_swap(__float_as_uint(m), __float_as_uint(m), false, false);
    return __uint_as_float(b[0]) + __uint_as_float(b[1]);
}
__device__ __forceinline__ float fast_rcp(float x) { return __builtin_amdgcn_rcpf(x); }
__device__ __forceinline__ float sigmoidf_(float x) { return fast_rcp(1.0f + __expf(-x)); }
__device__ __forceinline__ int opaque_tid() { int t = threadIdx.x; asm volatile("" : "+v"(t)); return t; }
#define DPP_F(v, ctrl) __int_as_float(__builtin_amdgcn_update_dpp(0, __float_as_int(v), ctrl, 0xF, 0xF, true))
__device__ __forceinline__ float wave_sum(float v) { v += DPP_F(v, 0xB1); v += DPP_F(v, 0x4E); v += DPP_F(v, 0x141); v += DPP_F(v, 0x140); return xquad_sum(v); }
__device__ __forceinline__ float red8(float v) { v += DPP_F(v, 0xB1); v += DPP_F(v, 0x4E); v += DPP_F(v, 0x141); return v; }

template <class F>
__device__ __forceinline__ void conv_w(bf16_t* dst, int N, int K, F src, LAS unsigned char* lds) {
    LAS float* tl = (LAS float*)lds;
    const int tid = opaque_tid(), kt = K >> 6, ntiles = (N >> 6) * kt;
    float cur[8];
    int tile = blockIdx.x;
    if (tile < ntiles) { const int R0 = (tile / kt) * 64, k0 = (tile % kt) * 64;
#pragma unroll
        for (int j = 0; j < 8; ++j) { const int e = tid + 512 * j; cur[j] = src(R0 + (e & 63), k0 + (e >> 6)); } }
    for (; tile < ntiles; tile += gridDim.x) {
        const int R0 = (tile / kt) * 64, k0 = (tile % kt) * 64;
#pragma unroll
        for (int j = 0; j < 8; ++j) { const int e = tid + 512 * j; tl[(e & 63) * 65 + (e >> 6)] = cur[j]; }
        const int nt2 = tile + gridDim.x;
        if (nt2 < ntiles) { const int R1 = (nt2 / kt) * 64, k1 = (nt2 % kt) * 64;
#pragma unroll
            for (int j = 0; j < 8; ++j) { const int e = tid + 512 * j; cur[j] = src(R1 + (e & 63), k1 + (e >> 6)); } }
        __syncthreads();
        { const int r = tid >> 3, k8 = (tid & 7) * 8; LAS const float* p = tl + r * 65 + k8;
          u32x4 w; w.x = cvt_pk_bf16(p[0], p[1]); w.y = cvt_pk_bf16(p[2], p[3]); w.z = cvt_pk_bf16(p[4], p[5]); w.w = cvt_pk_bf16(p[6], p[7]);
          *(u32x4*)(dst + (size_t)(R0 + r) * K + k0 + k8) = w; }
        __syncthreads();
    }
}
__device__ __forceinline__ int perm_col(int R, bool rope) {
    const int Gb = R & ~31, rho = R & 31, n = rho >> 4, fq = (rho >> 2) & 3, e = rho & 3;
    int d;
    if (rope && (Gb & 32) == 0) d = fq < 2 ? 4 * fq + 8 * n + e : 16 + (fq - 2) * 8 + 4 * n + e;
    else d = 8 * fq + 4 * n + e;
    return Gb + d;
}

__device__ __forceinline__ int swiglu_col(int R) { const int pn = R >> 8, wcg = (R >> 5) & 3, rho = R & 31; return pn * 128 + wcg * 32 + 8 * ((rho >> 2) & 3) + 4 * (rho >> 4) + (rho & 3); }

__device__ __forceinline__ void norm_rows(const float* in, const float* gain, bf16_t* outb, float* outf, int rows) {
    const int tid = opaque_tid(), wave = tid >> 6, lane = tid & 63, stride = gridDim.x * 8;
    int row = blockIdx.x * 8 + wave;
    float4 nx[4];
    if (row < rows) { const float4* p = (const float4*)(in + (size_t)row * 1024);
#pragma unroll
        for (int j = 0; j < 4; ++j) nx[j] = p[j * 64 + lane]; }
    for (; row < rows; row += stride) {
        float4 v[4]; float ss = 0.f;
#pragma unroll
        for (int j = 0; j < 4; ++j) { v[j] = nx[j]; ss += v[j].x * v[j].x + v[j].y * v[j].y + v[j].z * v[j].z + v[j].w * v[j].w; }
        if (row + stride < rows) { const float4* p = (const float4*)(in + (size_t)(row + stride) * 1024);
#pragma unroll
            for (int j = 0; j < 4; ++j) nx[j] = p[j * 64 + lane]; }
        ss = wave_sum(ss);
        const float r = rsqrtf(ss * (1.0f / 1024.0f) + 1e-6f);
#pragma unroll
        for (int j = 0; j < 4; ++j) {
            const float4 g = ((const float4*)gain)[j * 64 + lane];
            float4 y; y.x = v[j].x * r * g.x; y.y = v[j].y * r * g.y; y.z = v[j].z * r * g.z; y.w = v[j].w * r * g.w;
            if (outf) ((float4*)(outf + (size_t)row * 1024))[j * 64 + lane] = y;
            else { u32x2 w; w.x = cvt_pk_bf16(y.x, y.y); w.y = cvt_pk_bf16(y.z, y.w); *(u32x2*)(outb + (size_t)row * 1024 + (j * 64 + lane) * 4) = w; }
        }
    }
}

__device__ __forceinline__ void unpk8(u32x4 w, f32x4& lo, f32x4& hi) { lo[0] = bflo(w.x); lo[1] = bfhi(w.x); lo[2] = bflo(w.y); lo[3] = bfhi(w.y); hi[0] = bflo(w.z); hi[1] = bfhi(w.z); hi[2] = bflo(w.w); hi[3] = bfhi(w.w); }
__device__ __forceinline__ void norm_rows_b(const bf16_t* in, const float* gain, float* outf, int rows) {
    const int tid = opaque_tid(), wave = tid >> 6, lane = tid & 63, stride = gridDim.x * 8;
    int row = blockIdx.x * 8 + wave;
    u32x4 nx[2];
    if (row < rows) { const u32x4* p = (const u32x4*)(in + (size_t)row * 1024); nx[0] = p[lane]; nx[1] = p[64 + lane]; }
    for (; row < rows; row += stride) {
        f32x4 v[4]; float ss = 0.f;
        unpk8(nx[0], v[0], v[1]); unpk8(nx[1], v[2], v[3]);
#pragma unroll
        for (int j = 0; j < 4; ++j) ss += v[j][0] * v[j][0] + v[j][1] * v[j][1] + v[j][2] * v[j][2] + v[j][3] * v[j][3];
        if (row + stride < rows) { const u32x4* p = (const u32x4*)(in + (size_t)(row + stride) * 1024); nx[0] = p[lane]; nx[1] = p[64 + lane]; }
        ss = wave_sum(ss);
        const float r = rsqrtf(ss * (1.0f / 1024.0f) + 1e-6f);
#pragma unroll
        for (int j = 0; j < 2; ++j) { const int c = (j * 64 + lane) * 8;
            const f32x4 g0 = *(const f32x4*)(gain + c), g1 = *(const f32x4*)(gain + c + 4);
            *(f32x4*)(outf + (size_t)row * 1024 + c) = v[2 * j] * r * g0; *(f32x4*)(outf + (size_t)row * 1024 + c + 4) = v[2 * j + 1] * r * g1; }
    }
}

struct EpiSwiglu {
    static constexpr bool PERM = false, AFTER_DRAIN = false, MID = true;
    bf16_t* act; const float* rowss; int tlast; mutable float rsv[8];
    __device__ __forceinline__ void mid(f32x4 (&)[2][2][4][2], const Unit& u, int t, int wr, int wc, int fr, int fq) const {
        if (rowss == nullptr || t != tlast) return;
        const float* rp = rowss + u.pm * 256 + wr * 64 + fr;
#pragma unroll
        for (int i = 0; i < 8; ++i) rsv[i] = rp[(i >> 2) * 128 + (i & 3) * 16];
    }
    __device__ __forceinline__ void operator()(const f32x4 (&acc)[2][2][4][2], const Unit& u, int wr, int wc, int fr, int fq) const {
        const int row0 = u.pm * 256 + wr * 64 + fr;
#pragma unroll
        for (int ai = 0; ai < 2; ++ai)
#pragma unroll
            for (int m = 0; m < 4; ++m) { const int row = row0 + ai * 128 + m * 16; bf16_t* rowp = act + (size_t)row * DFF + u.pn * 128 + wc * 32 + 8 * fq;
                const float rs = rowss ? rsqrtf(rsv[ai * 4 + m] * (1.0f / 1024.0f) + 1e-6f) : 1.0f;
                float o[8];
#pragma unroll
                for (int n = 0; n < 2; ++n) { const f32x4 g = acc[ai][0][m][n] * rs, v = acc[ai][1][m][n] * rs;
#pragma unroll
                    for (int e = 0; e < 4; ++e) o[4 * n + e] = g[e] * fast_rcp(1.0f + __expf(-g[e])) * v[e]; }
                u32x4 w; w.x = cvt_pk_bf16(o[0], o[1]); w.y = cvt_pk_bf16(o[2], o[3]); w.z = cvt_pk_bf16(o[4], o[5]); w.w = cvt_pk_bf16(o[6], o[7]);
                *(u32x4*)rowp = w; }
    }
};
template <bool HALF, bool RESB, bool OUTF, bool STATS> struct EpiRes {
    static constexpr bool PERM = false, AFTER_DRAIN = false, MID = false;
    const float* resf; const bf16_t* resb; float* outf; bf16_t* outb; float* rowss;
    __device__ __forceinline__ void ldres(size_t off, f32x4 (&r)[4]) const {
        if (RESB) { r[0] = __builtin_bit_cast(f32x4, *(const u32x4*)(resb + off)); r[1] = __builtin_bit_cast(f32x4, *(const u32x4*)(resb + off + 128)); }
        else { r[0] = *(const f32x4*)(resf + off); r[1] = *(const f32x4*)(resf + off + 4); r[2] = *(const f32x4*)(resf + off + 128); r[3] = *(const f32x4*)(resf + off + 132); }
    }
    __device__ __forceinline__ void operator()(const f32x4 (&acc)[2][2][4][2], const Unit& u, int wr, int wc, int fr, int fq) const {
        const int row0 = u.pm * 256 + wr * 64 + fr, col0 = u.pn * 256 + wc * 32 + 8 * fq;
        size_t off = (size_t)row0 * 1024 + col0; int row = row0;
        f32x4 cur[4]; ldres(off, cur);
#pragma unroll
        for (int g = 0; g < 8; ++g) {
            const int ai = g >> 2, m = g & 3;
            size_t offn = off + ((m == 3) ? (size_t)80 * 1024 : (size_t)16 * 1024);
            asm volatile("" : "+v"(offn));
            f32x4 nxt[4]; if (g < 7) ldres(offn, nxt);
            float ss = 0.f;
#pragma unroll
            for (int bj = 0; bj < 2; ++bj) { f32x4 r0, r1;
                if (RESB) unpk8(__builtin_bit_cast(u32x4, cur[bj]), r0, r1); else { r0 = cur[2 * bj]; r1 = cur[2 * bj + 1]; }
                const f32x4 v0 = r0 + acc[ai][bj][m][0] * (HALF ? 0.5f : 1.0f), v1 = r1 + acc[ai][bj][m][1] * (HALF ? 0.5f : 1.0f);
                if (OUTF) { *(f32x4*)(outf + off + bj * 128) = v0; *(f32x4*)(outf + off + bj * 128 + 4) = v1; }
                else { u32x4 w; w.x = cvt_pk_bf16(v0[0], v0[1]); w.y = cvt_pk_bf16(v0[2], v0[3]); w.z = cvt_pk_bf16(v1[0], v1[1]); w.w = cvt_pk_bf16(v1[2], v1[3]); *(u32x4*)(outb + off + bj * 128) = w; }
                if (STATS) ss += v0[0] * v0[0] + v0[1] * v0[1] + v0[2] * v0[2] + v0[3] * v0[3] + v1[0] * v1[0] + v1[1] * v1[1] + v1[2] * v1[2] + v1[3] * v1[3]; }
            if (STATS) { ss = xquad_sum(ss); if (fq == 0) atomicAdd(rowss + row, ss); }
            asm volatile("" ::: "memory");
            off = offn; row += (m == 3) ? 80 : 16;
#pragma unroll
            for (int k = 0; k < 4; ++k) cur[k] = nxt[k];
        }
    }
};
struct EpiPerm {
    static constexpr bool PERM = false, AFTER_DRAIN = false, MID = true;
    bf16_t* O; int ld; const float* cs; const float* rowss; int tlast; mutable float rsv[8];
    __device__ __forceinline__ void mid(f32x4 (&)[2][2][4][2], const Unit& u, int t, int wr, int wc, int fr, int fq) const {
        if (rowss == nullptr || t != tlast) return;
        const float* rp = rowss + u.pm * 256 + wr * 64 + fr;
#pragma unroll
        for (int i = 0; i < 8; ++i) rsv[i] = rp[(i >> 2) * 128 + (i & 3) * 16];
    }
    __device__ __forceinline__ void operator()(const f32x4 (&acc)[2][2][4][2], const Unit& u, int wr, int wc, int fr, int fq) const {
        const int row0 = u.pm * 256 + wr * 64 + fr;
        const bool rope = cs != nullptr && u.pn < 4 && (wc & 1) == 0 && fq < 2;
#pragma unroll
        for (int ai = 0; ai < 2; ++ai)
#pragma unroll
            for (int m = 0; m < 4; ++m) { const int row = row0 + ai * 128 + m * 16; bf16_t* rowp = O + (size_t)row * ld;
                f32x4 c4 = {1.f, 1.f, 1.f, 1.f}, s4 = {0.f, 0.f, 0.f, 0.f};
                if (rope) { const float* t = cs + (size_t)row * 16 + fq * 8; const f32x4 a = *(const f32x4*)t, b = *(const f32x4*)(t + 4);
                    c4[0] = a[0]; s4[0] = a[1]; c4[1] = a[2]; s4[1] = a[3]; c4[2] = b[0]; s4[2] = b[1]; c4[3] = b[2]; s4[3] = b[3]; }
                const float rs = rowss ? rsqrtf(rsv[ai * 4 + m] * (1.0f / 1024.0f) + 1e-6f) : 1.0f;
#pragma unroll
                for (int bj = 0; bj < 2; ++bj) { const f32x4 x1 = acc[ai][bj][m][0] * rs, x2 = acc[ai][bj][m][1] * rs;
                    const f32x4 y1 = x1 * c4 - x2 * s4, y2 = x2 * c4 + x1 * s4;
                    u32x4 w; w.x = cvt_pk_bf16(y1[0], y1[1]); w.y = cvt_pk_bf16(y1[2], y1[3]); w.z = cvt_pk_bf16(y2[0], y2[1]); w.w = cvt_pk_bf16(y2[2], y2[3]);
                    *(u32x4*)(rowp + u.pn * 256 + bj * 128 + wc * 32 + 8 * fq) = w; } }
    }
};
struct EpiLR {
    static constexpr bool PERM = false, AFTER_DRAIN = false, MID = false;
    float* dec; bf16_t* asg; bf16_t* gg; const float* w0; const float* a0;
    __device__ __forceinline__ void operator()(const f32x4 (&acc)[2][2][4][2], const Unit& u, int wr, int wc, int fr, int fq) const {
        const int row0 = u.pm * 256 + wr * 64 + fr, col0 = wc * 32 + 4 * fq;
#pragma unroll
        for (int ai = 0; ai < 2; ++ai)
#pragma unroll
            for (int m = 0; m < 4; ++m) { const size_t off = (size_t)(row0 + ai * 128 + m * 16) * 256 + col0;
#pragma unroll
                for (int bj = 0; bj < 2; ++bj)
#pragma unroll
                    for (int n = 0; n < 2; ++n) { const int c = col0 + bj * 128 + n * 16; const size_t o = off + bj * 128 + n * 16; const f32x4 a = acc[ai][bj][m][n];
                        if (u.pn == 0) { const f32x4 b = *(const f32x4*)(w0 + c); f32x4 d;
#pragma unroll
                            for (int e = 0; e < 4; ++e) { const float z = -(b[e] + a[e]);
                                const float sp = fmaxf(z, 0.f) + __logf(1.0f + __expf(-fabsf(z)));
                                d[e] = __expf(-__expf(-sp - 0.5f)); }
                            *(f32x4*)(dec + o) = d; }
                        else if (u.pn == 1) { const f32x4 b = *(const f32x4*)(a0 + c); u32x2 w;
                            w.x = cvt_pk_bf16(sigmoidf_(b[0] + a[0]), sigmoidf_(b[1] + a[1])); w.y = cvt_pk_bf16(sigmoidf_(b[2] + a[2]), sigmoidf_(b[3] + a[3]));
                            *(u32x2*)(asg + o) = w; }
                        else { u32x2 w; w.x = cvt_pk_bf16(a[0], a[1]); w.y = cvt_pk_bf16(a[2], a[3]); *(u32x2*)(gg + o) = w; } } }
    }
};
struct EpiTmp {
    static constexpr bool PERM = false, AFTER_DRAIN = false, MID = false;
    float* tmp;
    __device__ __forceinline__ void operator()(const f32x4 (&acc)[2][2][4][2], const Unit& u, int wr, int wc, int fr, int fq) const {
        const int row0 = u.pm * 256 + wr * 64 + fr, col0 = u.pn * 256 + wc * 32 + 4 * fq;
#pragma unroll
        for (int ai = 0; ai < 2; ++ai)
#pragma unroll
            for (int m = 0; m < 4; ++m) { const size_t off = (size_t)(row0 + ai * 128 + m * 16) * 1024 + col0;
#pragma unroll
                for (int bj = 0; bj < 2; ++bj)
#pragma unroll
                    for (int n = 0; n < 2; ++n) *(f32x4*)(tmp + off + bj * 128 + n * 16) = acc[ai][bj][m][n]; }
    }
};
struct EpiGate {
    static constexpr bool PERM = false, AFTER_DRAIN = false, MID = false;
    const float* tmp; const float* bias; bf16_t* merged; int first;
    __device__ __forceinline__ void operator()(const f32x4 (&acc)[2][2][4][2], const Unit& u, int wr, int wc, int fr, int fq) const {
        const int row0 = u.pm * 256 + wr * 64 + fr, col0 = u.pn * 256 + wc * 32 + 4 * fq;
#pragma unroll
        for (int ai = 0; ai < 2; ++ai)
#pragma unroll
            for (int m = 0; m < 4; ++m) { const size_t off = (size_t)(row0 + ai * 128 + m * 16) * 1024 + col0;
#pragma unroll
                for (int bj = 0; bj < 2; ++bj)
#pragma unroll
                    for (int n = 0; n < 2; ++n) { const size_t o = off + bj * 128 + n * 16; const f32x4 tv = *(const f32x4*)(tmp + o), b = *(const f32x4*)(bias + col0 + bj * 128 + n * 16), a = acc[ai][bj][m][n];
                        f32x4 v;
#pragma unroll
                        for (int e = 0; e < 4; ++e) v[e] = sigmoidf_(a[e] + b[e]) * tv[e];
                        if (!first) { const u32x2 old = *(const u32x2*)(merged + o); v[0] += bflo(old.x); v[1] += bfhi(old.x); v[2] += bflo(old.y); v[3] += bfhi(old.y); }
                        u32x2 w; w.x = cvt_pk_bf16(v[0], v[1]); w.y = cvt_pk_bf16(v[2], v[3]); *(u32x2*)(merged + o) = w; } }
    }
};

struct EpiSig {
    static constexpr bool PERM = false, AFTER_DRAIN = false, MID = true;
    bf16_t* G; const float* bias; const float* rowss; int tlast; mutable float rsv[8];
    __device__ __forceinline__ void mid(f32x4 (&)[2][2][4][2], const Unit& u, int t, int wr, int wc, int fr, int fq) const {
        if (rowss == nullptr || t != tlast) return;
        const float* rp = rowss + u.pm * 256 + wr * 64 + fr;
#pragma unroll
        for (int i = 0; i < 8; ++i) rsv[i] = rp[(i >> 2) * 128 + (i & 3) * 16];
    }
    __device__ __forceinline__ void operator()(const f32x4 (&acc)[2][2][4][2], const Unit& u, int wr, int wc, int fr, int fq) const {
        const int row0 = u.pm * 256 + wr * 64 + fr, col0 = u.pn * 256 + wc * 32 + 8 * fq;
#pragma unroll
        for (int ai = 0; ai < 2; ++ai)
#pragma unroll
            for (int m = 0; m < 4; ++m) { const int row = row0 + ai * 128 + m * 16; const size_t off = (size_t)row * 3072 + col0; const float rs = rsqrtf(rsv[ai * 4 + m] * (1.0f / 1024.0f) + 1e-6f);
#pragma unroll
                for (int bj = 0; bj < 2; ++bj) { const f32x4 b0 = *(const f32x4*)(bias + col0 + bj * 128), b1 = *(const f32x4*)(bias + col0 + bj * 128 + 4), a0 = acc[ai][bj][m][0], a1 = acc[ai][bj][m][1];
                    u32x4 w; w.x = cvt_pk_bf16(sigmoidf_(a0[0] * rs + b0[0]), sigmoidf_(a0[1] * rs + b0[1])); w.y = cvt_pk_bf16(sigmoidf_(a0[2] * rs + b0[2]), sigmoidf_(a0[3] * rs + b0[3]));
                    w.z = cvt_pk_bf16(sigmoidf_(a1[0] * rs + b1[0]), sigmoidf_(a1[1] * rs + b1[1])); w.w = cvt_pk_bf16(sigmoidf_(a1[2] * rs + b1[2]), sigmoidf_(a1[3] * rs + b1[3]));
                    *(u32x4*)(G + off + bj * 128) = w; } }
    }
};
struct EpiMix {
    static constexpr bool PERM = false, AFTER_DRAIN = false, MID = true;
    const bf16_t* G; bf16_t* merged;
    __device__ __forceinline__ void mid(f32x4 (&acc)[2][2][4][2], const Unit& u, int t, int wr, int wc, int fr, int fq) const {
        if (t != 8 && t != 12) return;
        const bf16_t* gp = G + (size_t)(u.pm * 256 + wr * 64 + fr) * 3072 + ((t == 8) ? 0 : 1024) + u.pn * 256 + wc * 32 + 8 * fq;
#pragma unroll
        for (int ai = 0; ai < 2; ++ai) {
#pragma unroll
            for (int m = 0; m < 4; ++m) {
#pragma unroll
                for (int bj = 0; bj < 2; ++bj) { f32x4 n0, n1, d0, d1; unpk8(*(const u32x4*)(gp + bj * 128), n0, n1); unpk8(*(const u32x4*)(gp + 1024 + bj * 128), d0, d1);
                    f32x4 r0, r1;
#pragma unroll
                    for (int e = 0; e < 4; ++e) { r0[e] = n0[e] * fast_rcp(d0[e]); r1[e] = n1[e] * fast_rcp(d1[e]); }
                    acc[ai][bj][m][0] *= r0; acc[ai][bj][m][1] *= r1; }
                gp += 16 * 3072; asm volatile("" : "+v"(gp) :: "memory"); }
            gp += 64 * 3072; asm volatile("" : "+v"(gp)); }
    }
    __device__ __forceinline__ void operator()(const f32x4 (&acc)[2][2][4][2], const Unit& u, int wr, int wc, int fr, int fq) const {
        const int row0 = u.pm * 256 + wr * 64 + fr, col0 = u.pn * 256 + wc * 32 + 8 * fq;
        const bf16_t* gp = G + (size_t)row0 * 3072 + 2048 + col0; bf16_t* mp = merged + (size_t)row0 * 1024 + col0;
        u32x4 c0 = *(const u32x4*)gp, c1 = *(const u32x4*)(gp + 128);
#pragma unroll
        for (int g = 0; g < 8; ++g) {
            const int ai = g >> 2, m = g & 3;
            const bf16_t* gn = gp + ((m == 3) ? 80 * 3072 : 16 * 3072);
            asm volatile("" : "+v"(gn));
            u32x4 n0 = c0, n1 = c1; if (g < 7) { n0 = *(const u32x4*)gn; n1 = *(const u32x4*)(gn + 128); }
#pragma unroll
            for (int bj = 0; bj < 2; ++bj) { f32x4 g0, g1; unpk8(bj ? c1 : c0, g0, g1); const f32x4 v0 = acc[ai][bj][m][0] * g0, v1 = acc[ai][bj][m][1] * g1;
                u32x4 w; w.x = cvt_pk_bf16(v0[0], v0[1]); w.y = cvt_pk_bf16(v0[2], v0[3]); w.z = cvt_pk_bf16(v1[0], v1[1]); w.w = cvt_pk_bf16(v1[2], v1[3]); *(u32x4*)(mp + bj * 128) = w; }
            asm volatile("" ::: "memory");
            gp = gn; mp += (m == 3) ? 80 * 1024 : 16 * 1024; c0 = n0; c1 = n1;
        }
    }
};

template <class Epi>
__device__ __forceinline__ void run_gemm(LAS unsigned char* lds, const bf16_t* A, const bf16_t* Bt, int M, int N, int K, const Epi& E) {
    Gemm g; g.A = A; g.Bt = Bt; g.M = M; g.N = N; g.K = K;
    StaticOrder S; S.init(M, N, (int)gridDim.x, (int)blockIdx.x);
    pg8::gemm_phase<Epi, StaticOrder, false>(lds, g, S, E, nullptr);
    __syncthreads();
}

constexpr int KSTR = 144, VSTR = 136;
constexpr int LK0 = 0, LK1 = 64 * KSTR, LVT = 2 * 64 * KSTR, LVTSZ = 128 * VSTR, LEX = LVT + 2 * LVTSZ;
constexpr float SC_LOG2E = 0.125f * 1.4426950408889634f;

template <int DV, bool TWO>
__device__ __forceinline__ void attn_core(LAS unsigned char* lds, const bf16_t* Qw, int ldq, const bf16_t* K0p, const bf16_t* K1p, int ldk,
                                          const bf16_t* Vp, int ldv, int ntiles, bool skip_last, f32x4 (&o)[DV / 16][2]) {
    const int tid = opaque_tid(), wave = tid >> 6, lane = tid & 63, r = lane & 15, quad = lane >> 4;
    const int kmap = TWO ? (wave >> 2) : 0;
    bf16x8 qf[2][2];
#pragma unroll
    for (int qt = 0; qt < 2; ++qt)
#pragma unroll
        for (int ks = 0; ks < 2; ++ks) qf[qt][ks] = *(const bf16x8*)(Qw + (size_t)(qt * 16 + r) * ldq + ks * 32 + quad * 8);
    float mrow[2] = {-INFINITY, -INFINITY}, lrow[2] = {0.f, 0.f};
#pragma unroll
    for (int dt = 0; dt < DV / 16; ++dt) { o[dt][0] = (f32x4){0.f, 0.f, 0.f, 0.f}; o[dt][1] = (f32x4){0.f, 0.f, 0.f, 0.f}; }
    u32x4 kreg[2], vreg[2];
    const int k_map = TWO ? (tid >> 8) : 0, k_row = TWO ? ((tid >> 2) & 63) : (tid >> 3), k_d = TWO ? (tid & 3) * 16 : (tid & 7) * 8;
    const bf16_t* kbase = (k_map ? K1p : K0p) + (size_t)k_row * ldk + k_d;
    const bool v_on = (DV == 128) || tid < 256;
    const int v_kp = (DV == 128) ? (tid >> 4) : (tid >> 3), v_dg = (DV == 128) ? (tid & 15) : (tid & 7);
    const bf16_t* vbase = Vp + (size_t)(2 * v_kp) * ldv + v_dg * 8;
    auto gload = [&](int tile) {
        const bf16_t* kp = kbase + (size_t)tile * 64 * ldk;
        kreg[0] = *(const u32x4*)kp; if (TWO) kreg[1] = *(const u32x4*)(kp + 8);
        if (v_on) { const bf16_t* vp = vbase + (size_t)tile * 64 * ldv; vreg[0] = *(const u32x4*)vp; vreg[1] = *(const u32x4*)(vp + ldv); }
    };
    bf16x8 pbp[2][2];
    bool prev = false;
    auto pv_half = [&](int vbuf, int h) {
#pragma unroll
        for (int d2 = 0; d2 < DV / 32; ++d2) { const int dt = h * (DV / 32) + d2;
#pragma unroll
            for (int kk = 0; kk < 2; ++kk) { LAS const unsigned char* vrow = lds + LVT + vbuf * LVTSZ + (dt * 16 + r) * VSTR;
                const u32x2 lo = *(LAS const u32x2*)(vrow + (((16 * kk + 2 * quad) ^ (4 * dt)) << 2)), hi = *(LAS const u32x2*)(vrow + (((16 * kk + 8 + 2 * quad) ^ (4 * dt)) << 2));
                u32x4 w; w.x = lo.x; w.y = lo.y; w.z = hi.x; w.w = hi.y; const bf16x8 vf = __builtin_bit_cast(bf16x8, w);
                o[dt][0] = __builtin_amdgcn_mfma_f32_16x16x32_bf16(vf, pbp[0][kk], o[dt][0], 0, 0, 0);
                o[dt][1] = __builtin_amdgcn_mfma_f32_16x16x32_bf16(vf, pbp[1][kk], o[dt][1], 0, 0, 0); } }
    };
    gload(0);
    for (int tile = 0; tile < ntiles; ++tile) {
        const int vb = tile & 1;
        __syncthreads();
        { LAS unsigned char* kd = lds + (k_map ? LK1 : LK0) + k_row * KSTR + k_d * 2;
          *(LAS u32x4*)kd = kreg[0]; if (TWO) *(LAS u32x4*)(kd + 16) = kreg[1];
          if (v_on) {
#pragma unroll
              for (int e = 0; e < 8; ++e) { const unsigned a = vreg[0][e >> 1], b = vreg[1][e >> 1];
                  const unsigned w = (e & 1) ? ((a >> 16) | (b & 0xffff0000u)) : ((a & 0xffffu) | (b << 16));
                  *(LAS unsigned*)(lds + LVT + vb * LVTSZ + (v_dg * 8 + e) * VSTR + ((v_kp ^ ((v_dg >> 1) << 2)) << 2)) = w; } } }
        __syncthreads();
        const bool active = !(skip_last && tile == ntiles - 1);
        if (!active) { if (prev) { pv_half(vb ^ 1, 0); pv_half(vb ^ 1, 1); prev = false; } continue; }
        f32x4 s[4][2];
#pragma unroll
        for (int kt = 0; kt < 4; ++kt) { s[kt][0] = (f32x4){0.f, 0.f, 0.f, 0.f}; s[kt][1] = (f32x4){0.f, 0.f, 0.f, 0.f};
#pragma unroll
            for (int ks = 0; ks < 2; ++ks) { const bf16x8 kf = *(const LAS bf16x8*)(lds + (kmap ? LK1 : LK0) + (kt * 16 + r) * KSTR + (ks * 32 + quad * 8) * 2);
                s[kt][0] = __builtin_amdgcn_mfma_f32_16x16x32_bf16(kf, qf[0][ks], s[kt][0], 0, 0, 0);
                s[kt][1] = __builtin_amdgcn_mfma_f32_16x16x32_bf16(kf, qf[1][ks], s[kt][1], 0, 0, 0); } }
        float alpha[2];
        auto softmax_q = [&](int qt, bf16x8 (&dst)[2]) {
            float mx = s[0][qt][0];
#pragma unroll
            for (int kt = 0; kt < 4; ++kt)
#pragma unroll
                for (int j = 0; j < 4; ++j) mx = fmaxf(mx, s[kt][qt][j]);
            mx = xquad_max(mx);
            const float mn = fmaxf(mrow[qt], mx * SC_LOG2E);
            alpha[qt] = __builtin_amdgcn_exp2f(mrow[qt] - mn); mrow[qt] = mn;
            float ps = 0.f; float p[4][4];
#pragma unroll
            for (int kt = 0; kt < 4; ++kt)
#pragma unroll
                for (int j = 0; j < 4; ++j) { p[kt][j] = __builtin_amdgcn_exp2f(s[kt][qt][j] * SC_LOG2E - mn); ps += p[kt][j]; }
            lrow[qt] = lrow[qt] * alpha[qt] + ps;
#pragma unroll
            for (int kk = 0; kk < 2; ++kk) { u32x4 w; w.x = cvt_pk_bf16(p[2 * kk][0], p[2 * kk][1]); w.y = cvt_pk_bf16(p[2 * kk][2], p[2 * kk][3]);
                w.z = cvt_pk_bf16(p[2 * kk + 1][0], p[2 * kk + 1][1]); w.w = cvt_pk_bf16(p[2 * kk + 1][2], p[2 * kk + 1][3]);
                dst[kk] = __builtin_bit_cast(bf16x8, w); }
        };
        bf16x8 pb0[2];
        if (prev) pv_half(vb ^ 1, 0);
        softmax_q(0, pb0);
        if (prev) pv_half(vb ^ 1, 1);
        if (tile + 1 < ntiles) gload(tile + 1);
        softmax_q(1, pbp[1]);
        pbp[0][0] = pb0[0]; pbp[0][1] = pb0[1];
#pragma unroll
        for (int qt = 0; qt < 2; ++qt) {
            if (__builtin_amdgcn_ballot_w64(alpha[qt] != 1.0f) != 0ull) {
#pragma unroll
                for (int dt = 0; dt < DV / 16; ++dt) o[dt][qt] *= alpha[qt]; } }
        prev = true;
    }
    if (prev) { const int vb = (ntiles - 1) & 1; pv_half(vb, 0); pv_half(vb, 1); }
#pragma unroll
    for (int qt = 0; qt < 2; ++qt) { float l = lrow[qt]; l = xquad_sum(l); const float inv = 1.0f / l;
#pragma unroll
        for (int dt = 0; dt < DV / 16; ++dt) o[dt][qt] *= inv; }
}

__device__ __forceinline__ void attention_phase(KP P, LAS unsigned char* lds) {
    const int tid = opaque_tid(), wave = tid >> 6, lane = tid & 63, r = lane & 15, quad = lane >> 4;
    const bf16_t* proj = (const bf16_t*)(P->ws + WS_ACT);
    const bf16_t* kvm = (const bf16_t*)(P->ws + WS_KVM);
    unsigned* qctr = (unsigned*)(P->ws + WS_QCTR);
    LAS unsigned* qslot = (LAS unsigned*)(lds + 120000);
    for (;;) {
        __syncthreads();
        if (tid == 0) {
            const unsigned x0 = ((unsigned)__builtin_amdgcn_s_getreg((3 << 11) | 20)) & 7u  ; unsigned got = 0xffffffffu;
            for (unsigned k = 0; k < 8u; ++k) { const unsigned q = (x0 + k) & 7u; const unsigned idx = __hip_atomic_fetch_add(qctr + q * 64u, 1u, __ATOMIC_RELAXED, __HIP_MEMORY_SCOPE_AGENT);
                if (idx < 384u) { got = q * 384u + idx; break; } }
            *qslot = got; }
        __syncthreads();
        const unsigned gotv = *qslot;
        if (gotv == 0xffffffffu) break;
        const int qx = (int)(gotv / 384u), qi = (int)(gotv % 384u);
        if (qi < 256) {
        const int qb = 31 - (qi & 31), bh = (qi >> 5) * 8 + qx, b = bh >> 2, h = bh & 3, map = wave >> 2, wq = wave & 3;
        const size_t tok0 = (size_t)b * SEQ;
        const int q0 = qb * 128 + wq * 32;
        f32x4 o[8][2];
        attn_core<128, true>(lds, proj + (tok0 + q0) * PLO + (2 * h + map) * 64, PLO, proj + tok0 * PLO + 512 + (2 * h) * 64, proj + tok0 * PLO + 512 + (2 * h + 1) * 64, PLO,
                             proj + tok0 * PLO + 1024 + h * 128, PLO, 2 * qb + 2, wq < 2, o);
        LAS float* ex = (LAS float*)(lds + LEX) + (size_t)wq * 4096 + lane;
        if (map == 1) {
            const float s1 = wave_sum(P->lq1[lane] * P->lk1[lane]), s2 = wave_sum(P->lq2[lane] * P->lk2[lane]); const float lam = expf(s1) - expf(s2) + 0.2f;
#pragma unroll
            for (int dt = 0; dt < 8; ++dt)
#pragma unroll
                for (int qt = 0; qt < 2; ++qt)
#pragma unroll
                    for (int j = 0; j < 4; ++j) ex[((dt * 2 + qt) * 4 + j) * 64] = o[dt][qt][j] * lam;
        }
        __syncthreads();
        if (map == 0) {
#pragma unroll
            for (int qt = 0; qt < 2; ++qt) { float ss = 0.f;
#pragma unroll
                for (int dt = 0; dt < 8; ++dt)
#pragma unroll
                    for (int j = 0; j < 4; ++j) { const float v = o[dt][qt][j] - ex[((dt * 2 + qt) * 4 + j) * 64]; o[dt][qt][j] = v; ss += v * v; }
                ss = xquad_sum(ss);
                const float rs = rsqrtf(ss * (1.0f / 128.0f) + 1e-6f) * 0.8f;
                int ro = r * 1024 + quad * 4; asm volatile("" : "+v"(ro));
                bf16_t* op = (bf16_t*)(P->ws + WS_OA) + (tok0 + q0 + qt * 16) * 1024 + h * 128 + ro;
#pragma unroll
                for (int dt = 0; dt < 8; ++dt) { const f32x4 g = *(const f32x4*)(P->subln + dt * 16 + quad * 4); const f32x4 v = o[dt][qt] * g * rs;
                    u32x2 w; w.x = cvt_pk_bf16(v[0], v[1]); w.y = cvt_pk_bf16(v[2], v[3]); *(u32x2*)(op + dt * 16) = w; } }
        }
    }
        else { const int j = qi - 256;
        const int b = (j >> 6) * 8 + qx, qblk = b * 16 + ((j & 63) >> 2), hx = j & 3;
        const size_t tokq = (size_t)qblk * 256 + wave * 32;
        f32x4 o[4][2];
        attn_core<64, false>(lds, proj + tokq * PLO + 2560 + hx * 64, PLO, kvm + (size_t)b * 256 * 512 + hx * 64, nullptr, 512,
                             kvm + (size_t)b * 256 * 512 + 256 + hx * 64, 512, 4, false, o);
#pragma unroll
        for (int qt = 0; qt < 2; ++qt) { int ro = r * 1024 + quad * 4; asm volatile("" : "+v"(ro)); bf16_t* op = (bf16_t*)(P->ws + WS_OA) + 768 + (tokq + qt * 16) * 1024 + hx * 64 + ro;
#pragma unroll
            for (int dt = 0; dt < 4; ++dt) { const f32x4 v = o[dt][qt]; u32x2 w; w.x = cvt_pk_bf16(v[0], v[1]); w.y = cvt_pk_bf16(v[2], v[3]); *(u32x2*)(op + dt * 16) = w; } }
    }
    }
}

__device__ __forceinline__ float red16(float v) { v += DPP_F(v, 0xB1); v += DPP_F(v, 0x4E); v += DPP_F(v, 0x141); v += DPP_F(v, 0x140); return v; }
constexpr int SB = 64;
__device__ __forceinline__ void rwkv_scan(KP P, LAS unsigned char* lds, int wg) {
    const int bh = wg >> 1, half = wg & 1, b = bh >> 2, h = bh & 3, tid = opaque_tid();
    LAS float* __restrict__ vec = (LAS float*)lds;
    LAS float* __restrict__ ybuf = (LAS float*)lds + SB * 384;
    const bf16_t* proj = (const bf16_t*)(P->ws + WS_ACT);
    const float* dec = (const float*)(P->ws + WS_DEC);
    const bf16_t* asg = (const bf16_t*)(P->ws + WS_ASG);
    float* yraw = (float*)(P->ws + WS_YRAW);
    const int tl = tid >> 4, l4 = (tid & 15) * 4, c4 = h * 64 + l4;
    const f32x4 mu_r = *(const f32x4*)(P->rw_mu + c4), mu_k = *(const f32x4*)(P->rw_mu + 256 + c4), mu_v = *(const f32x4*)(P->rw_mu + 512 + c4);
    const f32x4 kkp = *(const f32x4*)(P->rw_k_k + c4), kap = *(const f32x4*)(P->rw_k_a + c4);
    const int il = tid >> 4, irow = half * 32 + il;
    f32x4 st = {0.f, 0.f, 0.f, 0.f};
    constexpr int NP = SB / 32;
    u32x2 ur[NP], uk[NP], uv[NP], urp[NP], ukp[NP], uvp[NP], as2[NP]; f32x4 dc[NP];
    const size_t tokb = (size_t)b * SEQ;
    auto load_raw = [&](int blk) {
#pragma unroll
        for (int q = 0; q < NP; ++q) {
        const int tt = blk * SB + tl + 32 * q; const size_t tok = tokb + tt;
        const bf16_t* base = proj + tok * PLO + 1536 + c4;
        ur[q] = *(const u32x2*)base; uk[q] = *(const u32x2*)(base + 256); uv[q] = *(const u32x2*)(base + 512);
        if (tt > 0) { urp[q] = *(const u32x2*)(base - PLO); ukp[q] = *(const u32x2*)(base - PLO + 256); uvp[q] = *(const u32x2*)(base - PLO + 512); }
        else { urp[q] = (u32x2){0u, 0u}; ukp[q] = urp[q]; uvp[q] = urp[q]; }
        dc[q] = *(const f32x4*)(dec + tok * 256 + c4); as2[q] = *(const u32x2*)(asg + tok * 256 + c4); }
    };
    auto prep = [&]() {
#pragma unroll
        for (int q = 0; q < NP; ++q) {
        const f32x4 r0 = unpk4(ur[q]), rp = unpk4(urp[q]), k0 = unpk4(uk[q]), kp = unpk4(ukp[q]), v0 = unpk4(uv[q]), vp = unpk4(uvp[q]), a = unpk4(as2[q]);
        const f32x4 rr = r0 + (rp - r0) * mu_r, kx = k0 + (kp - k0) * mu_k, vv = v0 + (vp - v0) * mu_v;
        f32x4 kk = kx * kkp;
        const float nrm = sqrtf(red16(kk[0] * kk[0] + kk[1] * kk[1] + kk[2] * kk[2] + kk[3] * kk[3]));
        kk = kk * fast_rcp(fmaxf(nrm, 1e-12f));
        const f32x4 kmod = kx * (1.0f + (a - 1.0f) * kap);
        LAS float* vt = vec + (tl + 32 * q) * 384 + l4;
        *(LAS f32x4*)(vt) = rr; *(LAS f32x4*)(vt + 64) = dc[q]; *(LAS f32x4*)(vt + 128) = kmod; *(LAS f32x4*)(vt + 192) = -kk; *(LAS f32x4*)(vt + 256) = kk * a; *(LAS f32x4*)(vt + 320) = vv; }
    };
    load_raw(0); prep(); __syncthreads();
    for (int blk = 0; blk < SEQ / SB; ++blk) {
        if (blk + 1 < SEQ / SB) load_raw(blk + 1);
        {
            LAS const float* vt = vec;
            f32x4 a4 = *(LAS const f32x4*)(vt + 192 + l4), w4 = *(LAS const f32x4*)(vt + 64 + l4), b4 = *(LAS const f32x4*)(vt + 256 + l4), k4 = *(LAS const f32x4*)(vt + 128 + l4), r4 = *(LAS const f32x4*)(vt + l4);
            float vi = vt[320 + irow], yprev = 0.f;
#pragma unroll 4
            for (int t = 0; t < SB; ++t) {
                const int tn = (t + 1 < SB) ? t + 1 : t; LAS const float* vn = vec + tn * 384;
                const f32x4 a4n = *(LAS const f32x4*)(vn + 192 + l4), w4n = *(LAS const f32x4*)(vn + 64 + l4), b4n = *(LAS const f32x4*)(vn + 256 + l4), k4n = *(LAS const f32x4*)(vn + 128 + l4), r4n = *(LAS const f32x4*)(vn + l4);
                const float vin = vn[320 + irow];
                float sa = st[0] * a4[0] + st[1] * a4[1] + st[2] * a4[2] + st[3] * a4[3];
                sa += DPP_F(sa, 0xB1); yprev += DPP_F(yprev, 0xB1);
                sa += DPP_F(sa, 0x4E); yprev += DPP_F(yprev, 0x4E);
                sa += DPP_F(sa, 0x141); yprev += DPP_F(yprev, 0x141);
                sa += DPP_F(sa, 0x140); yprev += DPP_F(yprev, 0x140);
                if (t > 0 && (tid & 15) == 0) ybuf[(t - 1) * 32 + il] = yprev;
                st = st * w4 + (b4 * sa + k4 * vi);
                yprev = st[0] * r4[0] + st[1] * r4[1] + st[2] * r4[2] + st[3] * r4[3];
                a4 = a4n; w4 = w4n; b4 = b4n; k4 = k4n; r4 = r4n; vi = vin; }
            yprev = red16(yprev);
            if ((tid & 15) == 0) ybuf[(SB - 1) * 32 + il] = yprev; }
        __syncthreads();
#pragma unroll
        for (int q = 0; q < NP; ++q) { const size_t tok = tokb + blk * SB + tl + 32 * q; const int p2 = (tid & 15) * 2;
          const float y0 = ybuf[(tl + 32 * q) * 32 + p2], y1 = ybuf[(tl + 32 * q) * 32 + p2 + 1];
          float2 yy; yy.x = y0; yy.y = y1;
          *(float2*)(yraw + tok * 256 + h * 64 + half * 32 + p2) = yy; }
        if (blk + 1 < SEQ / SB) prep();
        __syncthreads();
    }
}
__device__ __forceinline__ void rwkv_post(KP P) {
    const bf16_t* proj = (const bf16_t*)(P->ws + WS_ACT);
    const bf16_t* asg = (const bf16_t*)(P->ws + WS_ASG);
    const bf16_t* ggp = (const bf16_t*)(P->ws + WS_GG);
    const float* yraw = (const float*)(P->ws + WS_YRAW);
    bf16_t* ob = (bf16_t*)(P->ws + WS_OA) + 512;
    for (int idx = (int)blockIdx.x * 512 + opaque_tid(); idx < T * 64; idx += (int)gridDim.x * 512) {
        const int tok = idx >> 6, c4 = (idx & 63) * 4;
        const bf16_t* base = proj + (size_t)tok * PLO + 1536 + c4;
        const f32x4 r0 = unpk4(*(const u32x2*)base), k0 = unpk4(*(const u32x2*)(base + 256)), v0 = unpk4(*(const u32x2*)(base + 512));
        f32x4 rp = {0.f, 0.f, 0.f, 0.f}, kp = rp, vp = rp;
        if ((tok & (SEQ - 1)) != 0) { rp = unpk4(*(const u32x2*)(base - PLO)); kp = unpk4(*(const u32x2*)(base - PLO + 256)); vp = unpk4(*(const u32x2*)(base - PLO + 512)); }
        const f32x4 a = unpk4(*(const u32x2*)(asg + (size_t)tok * 256 + c4)), g = unpk4(*(const u32x2*)(ggp + (size_t)tok * 256 + c4));
        const f32x4 y = *(const f32x4*)(yraw + (size_t)tok * 256 + c4);
        const f32x4 mu_r = *(const f32x4*)(P->rw_mu + c4), mu_k = *(const f32x4*)(P->rw_mu + 256 + c4), mu_v = *(const f32x4*)(P->rw_mu + 512 + c4);
        const f32x4 kap = *(const f32x4*)(P->rw_k_a + c4), rkp = *(const f32x4*)(P->rw_r_k + c4), lnw = *(const f32x4*)(P->rw_ln_w + c4), lnb = *(const f32x4*)(P->rw_ln_b + c4);
        const f32x4 rr = r0 + (rp - r0) * mu_r, kx = k0 + (kp - k0) * mu_k, vv = v0 + (vp - v0) * mu_v;
        const f32x4 kmod = kx * (1.0f + (a - 1.0f) * kap), tb = rr * kmod * rkp;
        const float bon = red16(tb[0] + tb[1] + tb[2] + tb[3]);
        const float mean = red16(y[0] + y[1] + y[2] + y[3]) * (1.0f / 64.0f); const f32x4 d = y - mean;
        const float var = red16(d[0] * d[0] + d[1] * d[1] + d[2] * d[2] + d[3] * d[3]) * (1.0f / 64.0f);
        f32x4 yn = d * rsqrtf(var + 64e-5f) * lnw + lnb; yn = (yn + vv * bon) * g;
        u32x2 w; w.x = cvt_pk_bf16(yn[0], yn[1]); w.y = cvt_pk_bf16(yn[2], yn[3]);
        *(u32x2*)(ob + (size_t)tok * 1024 + c4) = w;
    }
}

#define XB_TMO      128
#define XB_XCNT(j)  (256  + 64 * (j))
#define XB_XSUB(j)  (1280 + 64 * (j))
#define XB_XGEN(j)  (2304 + 64 * (j))
#define XB_TOP      3328
#define XB_TOPGEN   3392
#define XCD_BAR_WORDS 3456
#define XB_SPIN_CAP (1u << 18)

__device__ __forceinline__ unsigned xb_ld(unsigned* p)              { return __hip_atomic_load(p, __ATOMIC_RELAXED, __HIP_MEMORY_SCOPE_AGENT); }
__device__ __forceinline__ unsigned xb_add(unsigned* p, unsigned v) { return __hip_atomic_fetch_add(p, v, __ATOMIC_RELAXED, __HIP_MEMORY_SCOPE_AGENT); }
__device__ __forceinline__ unsigned xb_xcc_id() { return (unsigned)__builtin_amdgcn_s_getreg((3 << 11) | 20) & 0xFu; }
#define XB_SPIN(cond, bar) do { unsigned _sp = 0; while (cond) { __builtin_amdgcn_s_sleep(1); \
    if ((++_sp & 255u) == 0u) { if (xb_ld(&(bar)[XB_TMO])) break; if (_sp > XB_SPIN_CAP) { atomicAdd(&(bar)[XB_TMO], 1u); break; } } } } while (0)

struct XcdBarrier {
    unsigned* bar; unsigned x;
    volatile PG8_LAS unsigned* st;
};

__device__ __forceinline__ XcdBarrier xcd_barrier_post(unsigned* bar, volatile PG8_LAS unsigned* st) {
    XcdBarrier b; b.bar = bar; b.x = xb_xcc_id(); b.st = st;
    if (threadIdx.x == 0) (void)xb_add(&bar[XB_XCNT(b.x)], 1u);
    return b;
}
__device__ __forceinline__ void xcd_barrier_complete(unsigned* bar, unsigned x, unsigned& nloc, unsigned& nx) {
    const unsigned G = gridDim.x * gridDim.y * gridDim.z;
    unsigned sum, cnt, mine, sp = 0u;
    for (;;) {
        sum = 0u; cnt = 0u; mine = 0u;
#pragma unroll
        for (unsigned j = 0; j < 16; ++j) { const unsigned c = xb_ld(&bar[XB_XCNT(j)]); sum += c; cnt += (c > 0u) ? 1u : 0u; mine = (j == x) ? c : mine; }
        if (sum == G) break;
        __builtin_amdgcn_s_sleep(1);
        if ((++sp & 255u) == 0u) { if (xb_ld(&bar[XB_TMO])) break; if (sp > XB_SPIN_CAP) { atomicAdd(&bar[XB_TMO], 1u); break; } }
    }
    nloc = mine > 0u ? mine : 1u; nx = cnt > 0u ? cnt : 1u;
}

__device__ __forceinline__ void xcd_barrier(const XcdBarrier& b) {
    asm volatile("s_waitcnt vmcnt(0)" ::: "memory");
    __syncthreads();
    if (threadIdx.x == 0) {
        unsigned* bar = b.bar;
        __builtin_amdgcn_s_waitcnt(0);
        unsigned nloc = b.st[0], nx = b.st[1];
        if (nloc == 0u) { xcd_barrier_complete(bar, b.x, nloc, nx); b.st[0] = nloc; b.st[1] = nx; }
        const unsigned old = xb_add(&bar[XB_XSUB(b.x)], 1u);
        const unsigned gen = old / nloc;
        if (old + 1u == (gen + 1u) * nloc) {
            __builtin_amdgcn_fence(__ATOMIC_RELEASE, "agent");
            asm volatile("s_waitcnt vmcnt(0)" ::: "memory");
            const unsigned og = xb_add(&bar[XB_TOP], 1u);
            const unsigned tg = og / nx;
            if (og + 1u == (tg + 1u) * nx) xb_add(&bar[XB_TOPGEN], 1u);
            else XB_SPIN(xb_ld(&bar[XB_TOPGEN]) == tg, bar);
            __builtin_amdgcn_fence(__ATOMIC_ACQUIRE, "agent");
            xb_add(&bar[XB_XGEN(b.x)], 1u);
            asm volatile("s_waitcnt vmcnt(0)" ::: "memory");
        } else {
            XB_SPIN(xb_ld(&bar[XB_XGEN(b.x)]) == gen, bar);
            __builtin_amdgcn_fence(__ATOMIC_ACQUIRE, "agent");
            asm volatile("s_waitcnt vmcnt(0)" ::: "memory");
        }
    }
    __syncthreads();
}
#define GRID_SYNC() do { XcdBarrier xb_; xb_.bar = (unsigned*)(ws + WS_BAR); xb_.x = xb_xcc_id(); xb_.st = (volatile PG8_LAS unsigned*)(lds + 131072); xcd_barrier(xb_); } while (0)
__global__ void __launch_bounds__(512, 2) fwd_megakernel(Params Pk_unused) {
#define P kp_fresh()
    extern __shared__ __attribute__((aligned(16))) unsigned char shm[];
    LAS unsigned char* lds = (LAS unsigned char*)shm;
    cg::grid_group grid = cg::this_grid();
#define ws (P->ws)
    const int nth = gridDim.x * 512;
#define GTID ((int)blockIdx.x * 512 + opaque_tid())
#define H ((bf16_t*)(ws + WS_H))
#define ACT ((bf16_t*)(ws + WS_ACT))
#define X (P->out)
#define CS ((float*)(ws + WS_CS))
    grid.sync();
    { volatile PG8_LAS unsigned* st = (volatile PG8_LAS unsigned*)(lds + 131072); if (threadIdx.x == 0) { st[0] = 0u; st[1] = 0u; } __syncthreads();
      (void)xcd_barrier_post((unsigned*)(ws + WS_BAR), st); }

    {
    { const float *w1 = P->ffn1_w1, *w3 = P->ffn1_w3, *w2 = P->ffn1_w2;
      conv_w((bf16_t*)(ws + W_UP1), 5632, 1024, [=](int R, int k) { return ((R & 128) ? w3 : w1)[(size_t)k * DFF + swiglu_col(R)]; }, lds);
      conv_w((bf16_t*)(ws + W_DN1), 1024, 2816, [=](int R, int k) { return w2[(size_t)k * 1024 + perm_col(R, false)]; }, lds); }
    { const float *w1 = P->ffn2_w1, *w3 = P->ffn2_w3, *w2 = P->ffn2_w2, *gn = P->ffn2_norm;
      conv_w((bf16_t*)(ws + W_UP2), 5632, 1024, [=](int R, int k) { return gn[k] * ((R & 128) ? w3 : w1)[(size_t)k * DFF + swiglu_col(R)]; }, lds);
      conv_w((bf16_t*)(ws + W_DN2), 1024, 2816, [=](int R, int k) { return w2[(size_t)k * 1024 + perm_col(R, false)]; }, lds); }
    { const float *wi = P->w_in, *gn = P->mix_norm;
      conv_w((bf16_t*)(ws + W_INLO), 2816, 1024, [=](int R, int k) { return gn[k] * wi[(size_t)k * PCOLS + perm_col(R, R < 1024)]; }, lds);
      conv_w((bf16_t*)(ws + W_GATE), 3072, 1024, [=](int R, int k) { return gn[k] * wi[(size_t)k * PCOLS + 2816 + perm_col(R, false)]; }, lds); }
    { const float *ua = P->w_up_a, *ub = P->w_up_b, *uc = P->w_up_c, *wo = P->w_out, *mk = P->w_mem_kv;
      conv_w((bf16_t*)(ws + W_UPA), 1024, 1024, [=](int R0, int k) { const int R = perm_col(R0, false); return k < 512 ? ua[(size_t)k * 1024 + R] : (k < 768 ? ub[(size_t)(k - 512) * 1024 + R] : uc[(size_t)(k - 768) * 1024 + R]); }, lds);
      conv_w((bf16_t*)(ws + W_OUT), 1024, 1024, [=](int R, int k) { return wo[(size_t)k * 1024 + perm_col(R, false)]; }, lds);
      conv_w((bf16_t*)(ws + W_MKV), 512, 1024, [=](int R, int k) { return mk[(size_t)k * 512 + perm_col(R, false)]; }, lds); }
    { const float *w2 = P->rw_w2, *a2 = P->rw_a2, *g2 = P->rw_g2;
      conv_w((bf16_t*)(ws + W_LR), 768, 256, [=](int R, int k) { float v = 0.f;
          if (R < 256) { if (k < 64) v = w2[k * 256 + R]; }
          else if (R < 512) { if (k >= 64 && k < 128) v = a2[(k - 64) * 256 + (R - 256)]; }
          else { if (k >= 128) v = g2[(k - 128) * 256 + (R - 512)]; }
          return v; }, lds); }
    for (int idx = GTID; idx < 2 * T; idx += nth) ((float*)(ws + WS_SS1))[idx] = 0.f;
    norm_rows(P->x, P->ffn1_norm, H, nullptr, T);
    norm_rows(P->mem, P->mem_norm, (bf16_t*)(ws + WS_HM), nullptr, MEMT);
    for (int idx = GTID; idx < T * 8; idx += nth) {
        const int t = idx >> 3, i = idx & 7;
        const float ang = (float)P->pos[t] * INVF[i];
        const double rev = (double)ang * 0.15915494309189535; const double fr = rev - rint(rev); const double rr = fr * 6.283185307179586, r2 = rr * rr;
        double cterm = 1.0, sterm = rr, cc = 1.0, sn = rr;
#pragma unroll
        for (int k = 1; k <= 14; ++k) { cterm *= -r2 * (1.0 / ((2.0 * k - 1.0) * (2.0 * k))); sterm *= -r2 * (1.0 / ((2.0 * k) * (2.0 * k + 1.0))); cc += cterm; sn += sterm; }
        CS[idx * 2] = (float)cc; CS[idx * 2 + 1] = (float)sn;
    }
    GRID_SYNC();
    { EpiSwiglu e; e.act = ACT; e.rowss = nullptr; e.tlast = 14; run_gemm(lds, H, (const bf16_t*)(ws + W_UP1), T, 5632, 1024, e); }
    GRID_SYNC();
    { EpiRes<true, false, false, true> e; e.resf = P->x; e.resb = nullptr; e.outf = nullptr; e.outb = H; e.rowss = (float*)(ws + WS_SS1); run_gemm(lds, ACT, (const bf16_t*)(ws + W_DN1), T, 1024, 2816, e); }
    GRID_SYNC();
    { EpiPerm e; e.O = ACT; e.ld = PLO; e.cs = CS; e.rowss = (const float*)(ws + WS_SS1); e.tlast = 14; run_gemm(lds, H, (const bf16_t*)(ws + W_INLO), T, 2816, 1024, e); }
    GRID_SYNC();
    { EpiPerm e; e.O = (bf16_t*)(ws + WS_KVM); e.ld = 512; e.cs = nullptr; e.rowss = nullptr; e.tlast = 14; run_gemm(lds, (const bf16_t*)(ws + WS_HM), (const bf16_t*)(ws + W_MKV), MEMT, 512, 1024, e); }
    { bf16_t* alr = (bf16_t*)(ws + WS_ALR);
      if (blockIdx.x >= 32) {
          const int idx0 = ((int)blockIdx.x - 32) * 512 + opaque_tid(), stride = ((int)gridDim.x - 32) * 512, col = (idx0 & 31) * 8;
          const f32x4 m0 = *(const f32x4*)(P->rw_mu + 768 + col), m1 = *(const f32x4*)(P->rw_mu + 768 + col + 4);
          auto ldp = [&](int idx, u32x4& cur, u32x4& prv) { const int t = idx >> 5; const bf16_t* up = ACT + (size_t)t * PLO + 1536 + 768 + col;
              cur = *(const u32x4*)up; prv = (u32x4){0u, 0u, 0u, 0u}; if ((t & (SEQ - 1)) != 0) prv = *(const u32x4*)(up - PLO); };
          auto cpp = [&](int idx, const u32x4& cur, const u32x4& prv) { const int t = idx >> 5; float v[8];
#pragma unroll
              for (int e2 = 0; e2 < 8; ++e2) { const float cu = (e2 & 1) ? bfhi(cur[e2 >> 1]) : bflo(cur[e2 >> 1]), pv = (e2 & 1) ? bfhi(prv[e2 >> 1]) : bflo(prv[e2 >> 1]);
                  const float mu = e2 < 4 ? m0[e2 & 3] : m1[e2 & 3]; const float xs = cu + (pv - cu) * mu;
                  v[e2] = col < 64 ? (1.0f - 2.0f * fast_rcp(__expf(2.0f * xs) + 1.0f)) : (col < 128 ? xs : sigmoidf_(xs)); }
              u32x4 w; w.x = cvt_pk_bf16(v[0], v[1]); w.y = cvt_pk_bf16(v[2], v[3]); w.z = cvt_pk_bf16(v[4], v[5]); w.w = cvt_pk_bf16(v[6], v[7]);
              *(u32x4*)(alr + (size_t)t * 256 + col) = w; };
          for (int idx = idx0; idx < T * 32; idx += 2 * stride) {
              u32x4 c0, p0, c1, p1; ldp(idx, c0, p0); const bool hb = idx + stride < T * 32; if (hb) ldp(idx + stride, c1, p1);
              cpp(idx, c0, p0); if (hb) cpp(idx + stride, c1, p1); } } }
    GRID_SYNC();
    { EpiLR e; e.dec = (float*)(ws + WS_DEC); e.asg = (bf16_t*)(ws + WS_ASG); e.gg = (bf16_t*)(ws + WS_GG); e.w0 = P->rw_w0; e.a0 = P->rw_a0;
      run_gemm(lds, (const bf16_t*)(ws + WS_ALR), (const bf16_t*)(ws + W_LR), T, 768, 256, e); }
    GRID_SYNC();
    if ((int)blockIdx.x < NSCAN) rwkv_scan(P, lds, blockIdx.x);
    attention_phase(P, lds);
    GRID_SYNC();
    rwkv_post(P);
    GRID_SYNC();
    { EpiSig e; e.G = (bf16_t*)(ws + WS_ACT); e.bias = P->gate_bias; e.rowss = (const float*)(ws + WS_SS1); e.tlast = 14; run_gemm(lds, H, (const bf16_t*)(ws + W_GATE), T, 3072, 1024, e); }
    GRID_SYNC();
    { EpiMix e; e.G = (const bf16_t*)(ws + WS_ACT); e.merged = (bf16_t*)(ws + WS_DEC); run_gemm(lds, (const bf16_t*)(ws + WS_OA), (const bf16_t*)(ws + W_UPA), T, 1024, 1024, e); }
    GRID_SYNC();
    { EpiRes<false, true, false, true> e; e.resf = nullptr; e.resb = H; e.outf = nullptr; e.outb = H; e.rowss = (float*)(ws + WS_SS2); run_gemm(lds, (const bf16_t*)(ws + WS_DEC), (const bf16_t*)(ws + W_OUT), T, 1024, 1024, e); }
    GRID_SYNC();
    { EpiSwiglu e; e.act = ACT; e.rowss = (const float*)(ws + WS_SS2); e.tlast = 14; run_gemm(lds, H, (const bf16_t*)(ws + W_UP2), T, 5632, 1024, e); }
    GRID_SYNC();
    { EpiRes<true, true, false, false> e; e.resf = nullptr; e.resb = H; e.outf = nullptr; e.outb = H; e.rowss = nullptr; run_gemm(lds, ACT, (const bf16_t*)(ws + W_DN2), T, 1024, 2816, e); }
    GRID_SYNC();
    norm_rows_b(H, P->final_norm, X, T);
    }
}

#undef P
#undef ws
#undef H
#undef ACT
#undef X
#undef CS
#undef GTID
extern "C" void kernel_launch(void* const* d_in, const int* in_sizes, int n_in, void* d_out, int out_size, void* d_ws, size_t ws_size, hipStream_t stream) {
    constexpr int LDS_BYTES = 131072 + 256;
    static int grid_blocks = 0;
    if (grid_blocks == 0) {
        if (n_in != 37 || ws_size < WS_END) { fprintf(stderr, "kernel_launch: unexpected inputs (n_in %d, ws %zu, need %zu)\n", n_in, ws_size, (size_t)WS_END); grid_blocks = -1; return; }
        int dev = 0, cus = 0, per_cu = 0;
        hipGetDevice(&dev);
        hipDeviceGetAttribute(&cus, hipDeviceAttributeMultiprocessorCount, dev);
        hipFuncSetAttribute((const void*)fwd_megakernel, hipFuncAttributeMaxDynamicSharedMemorySize, LDS_BYTES);
        hipOccupancyMaxActiveBlocksPerMultiprocessor(&per_cu, (const void*)fwd_megakernel, 512, LDS_BYTES);
        if (per_cu < 1) per_cu = 1;
        grid_blocks = cus * per_cu;
        (void)hipGetLastError();
    }
    if (grid_blocks < 0) return;
    hipMemsetAsync((unsigned char*)d_ws + WS_BAR, 0, 16384 + 2048, stream);
    Params p{};
    p.x = (const float*)d_in[0]; p.mem = (const float*)d_in[1]; p.pos = (const int*)d_in[2];
    p.ffn1_norm = (const float*)d_in[3]; p.ffn1_w1 = (const float*)d_in[4]; p.ffn1_w3 = (const float*)d_in[5]; p.ffn1_w2 = (const float*)d_in[6];
    p.mix_norm = (const float*)d_in[7]; p.w_in = (const float*)d_in[8]; p.gate_bias = (const float*)d_in[9];
    p.lq1 = (const float*)d_in[10]; p.lk1 = (const float*)d_in[11]; p.lq2 = (const float*)d_in[12]; p.lk2 = (const float*)d_in[13]; p.subln = (const float*)d_in[14];
    p.rw_mu = (const float*)d_in[15]; p.rw_w0 = (const float*)d_in[16]; p.rw_w2 = (const float*)d_in[17]; p.rw_a0 = (const float*)d_in[18]; p.rw_a2 = (const float*)d_in[19];
    p.rw_g2 = (const float*)d_in[20]; p.rw_k_k = (const float*)d_in[21]; p.rw_k_a = (const float*)d_in[22]; p.rw_r_k = (const float*)d_in[23];
    p.rw_ln_w = (const float*)d_in[24]; p.rw_ln_b = (const float*)d_in[25];
    p.mem_norm = (const float*)d_in[26]; p.w_mem_kv = (const float*)d_in[27]; p.w_up_a = (const float*)d_in[28]; p.w_up_b = (const float*)d_in[29]; p.w_up_c = (const float*)d_in[30];
    p.w_out = (const float*)d_in[31]; p.ffn2_norm = (const float*)d_in[32]; p.ffn2_w1 = (const float*)d_in[33]; p.ffn2_w3 = (const float*)d_in[34]; p.ffn2_w2 = (const float*)d_in[35];
    p.final_norm = (const float*)d_in[36];
    p.out = (float*)d_out; p.ws = (unsigned char*)d_ws;
    void* args[] = {&p};
    hipError_t e = hipLaunchCooperativeKernel((const void*)fwd_megakernel, dim3(grid_blocks), dim3(512), args, LDS_BYTES, stream);
    if (e != hipSuccess) fprintf(stderr, "cooperative launch failed: %s (grid %d)\n", hipGetErrorString(e), grid_blocks);
}
```

```cpp
#include <hip/hip_runtime.h>
#include <hip/hip_cooperative_groups.h>
#include <cstdio>
namespace pg8 {
#define PG8_LAS __attribute__((address_space(3)))
typedef unsigned short bf16_t;
typedef short bf16x8 __attribute__((ext_vector_type(8)));
typedef float f32x4 __attribute__((ext_vector_type(4)));
typedef unsigned u32x4 __attribute__((ext_vector_type(4)));
constexpr int BM = 256, BK = 64, HALF = 128, HTB = HALF * BK * 2  , STAGE_BYTES = 8 * HTB, NXCD = 8, WGM = 8;

__host__ __device__ __forceinline__ int lds_byte(int r, int c) { const int st = (r >> 4) * 2 + (c >> 5), rr = r & 15, cc = c & 31, ob = rr * 64 + cc * 2; return st * 1024 + (ob ^ (((ob >> 9) & 1) << 5)); }
__host__ __device__ __forceinline__ void stage_rc(int b, int& R, int& C) { const int st = b / 1024, sb = b % 1024, swz = sb ^ (((sb >> 9) & 1) << 5); R = (st >> 1) * 16 + swz / 64; C = (st & 1) * 32 + (swz % 64) / 2; }
__host__ __device__ __forceinline__ int perm32(int rho) { const int n = rho >> 4, i = rho & 15; return 8 * (i >> 2) + 4 * n + (i & 3); }

struct Unit { int pm, pn; };
struct Gemm { const bf16_t* A; const bf16_t* Bt; int M, N, K; };

struct StaticOrder {
    int nM, nN, nwg, G, c;
    __host__ __device__ void init(int M, int N, int G_, int c_) { nM = M / BM; nN = N / BM; nwg = nM * nN; G = G_; c = c_; }
    __host__ __device__ bool next(int i, Unit& u) const {
        const long L = (long)i * G + c; if (L >= nwg) return false;
        int wgid = (int)L; { const int q = nwg / NXCD, r = nwg % NXCD, xcd = wgid % NXCD, off = wgid / NXCD; wgid = (xcd < r ? xcd * (q + 1) : r * (q + 1) + (xcd - r) * q) + off; }
        const int nig = WGM * nN, gid = wgid / nig, fm = gid * WGM, gsz = (nM - fm) < WGM ? (nM - fm) : WGM;
        u.pm = fm + ((wgid % nig) % gsz); u.pn = (wgid % nig) / gsz; return true;
    }
    __device__ __forceinline__ void a_ready(const Unit&) const {}
    __device__ __forceinline__ void done(const Unit&) const {}
};
typedef float f32x2_c __attribute__((ext_vector_type(2))); typedef __bf16 bf16x2_c __attribute__((ext_vector_type(2)));
__device__ __forceinline__ unsigned cvt_pk_bf16(float lo, float hi) { const f32x2_c v = {lo, hi}; const bf16x2_c b = __builtin_convertvector(v, bf16x2_c); return __builtin_bit_cast(unsigned, b); }
template <class Epi, class Sched, bool STAMP = false>
__device__ __forceinline__ void gemm_phase(PG8_LAS unsigned char* lds, const Gemm g, const Sched& S, const Epi& E, unsigned long long* stamps) {
    int tid_l = threadIdx.x; asm volatile("" : "+v"(tid_l)); const int tid = tid_l, wid = __builtin_amdgcn_readfirstlane(tid >> 6), lane = tid & 63, wr = wid >> 2, wc = wid & 3, fr = lane & 15, fq = lane >> 4;
    const int K = g.K, nt = K / BK;
    int ts_lo = 0, ts_hi = 0, nts = 0; const unsigned long long rt_entry = STAMP ? (unsigned long long)wall_clock64() : 0ull;
#define PG8_STAMP() do { if (STAMP && wid == 0 && nts < 64) { const unsigned long long _c = (unsigned long long)clock64(); \
        ts_lo = (lane == nts) ? (int)(unsigned)_c : ts_lo; ts_hi = (lane == nts) ? (int)(unsigned)(_c >> 32) : ts_hi; ++nts; } } while (0)
    PG8_STAMP();
    unsigned voffA[2], voffB[2];
#pragma unroll
    for (int i = 0; i < 2; ++i) { int R, C; stage_rc(tid * 16 + i * 8192, R, C); const int Rb = Epi::PERM ? ((R & ~31) + perm32(R & 31)) : R;
        voffA[i] = (unsigned)(R * K + C) * 2u; voffB[i] = (unsigned)(Rb * K + C) * 2u; }
    const size_t kstep = (size_t)(BK * 2);
    const size_t hstep = (size_t)HALF * K * 2;
    const size_t tstep = 2 * hstep;
    const unsigned ldsw = (unsigned)wid * 1024u;
    const int aoff = lds_byte(wr * 64 + fr, fq * 8), boff = lds_byte(wc * 32 + fr, fq * 8);
#define PG8_SA(b, h) (((b) * 2 + (h)) * HTB)
#define PG8_SB(b, h) ((4 + (b) * 2 + (h)) * HTB)
#define PG8_STAGE(bufoff, gbase, voff) do { _Pragma("unroll") for (int _i = 0; _i < 2; ++_i) \
        __builtin_amdgcn_global_load_lds((const unsigned*)((const char*)(gbase) + (voff)[_i]), (PG8_LAS unsigned*)(lds + (bufoff) + ldsw + _i * 8192), 16, 0, 0); } while (0)
#define PG8_LDA(dst, b, h) do { _Pragma("unroll") for (int m = 0; m < 4; ++m) _Pragma("unroll") for (int k = 0; k < 2; ++k) dst[m][k] = *(const PG8_LAS bf16x8*)(lds + PG8_SA(b, h) + aoff + m * 2048 + k * 1024); } while (0)
#define PG8_LDB(dst, b, h) do { _Pragma("unroll") for (int n = 0; n < 2; ++n) _Pragma("unroll") for (int k = 0; k < 2; ++k) dst[n][k] = *(const PG8_LAS bf16x8*)(lds + PG8_SB(b, h) + boff + n * 2048 + k * 1024); } while (0)
#define PG8_MMA(ai, bj, At, Bt) do { __builtin_amdgcn_s_setprio(1); _Pragma("unroll") for (int m = 0; m < 4; ++m) _Pragma("unroll") for (int n = 0; n < 2; ++n) _Pragma("unroll") for (int k = 0; k < 2; ++k) \
        acc[ai][bj][m][n] = __builtin_amdgcn_mfma_f32_16x16x32_bf16(Bt[n][k], At[m][k], acc[ai][bj][m][n], 0, 0, 0); __builtin_amdgcn_s_setprio(0); } while (0)
#define PG8_WAIT_V(n) asm volatile("s_waitcnt vmcnt(" #n ")" ::: "memory")
#define PG8_WAIT_L(n) asm volatile("s_waitcnt lgkmcnt(" #n ")" ::: "memory")
#define PG8_BAR __builtin_amdgcn_s_barrier()
#define PG8_SCHED __builtin_amdgcn_sched_barrier(0)
    Unit cur, nxt; int ui = 0;
    if (!S.next(0, cur)) return;
    f32x4 acc[2][2][4][2];
#pragma unroll
    for (int a = 0; a < 2; ++a)
#pragma unroll
        for (int b = 0; b < 2; ++b)
#pragma unroll
            for (int m = 0; m < 4; ++m)
#pragma unroll
                for (int n = 0; n < 2; ++n) acc[a][b][m][n] = (f32x4){0.f, 0.f, 0.f, 0.f};
    bf16x8 At[4][2], B0[2][2], B1[2][2];
    const char* cA = (const char*)g.A + (size_t)cur.pm * tstep; const char* cB = (const char*)g.Bt + (size_t)cur.pn * tstep;
    S.a_ready(cur);
    PG8_STAGE(PG8_SB(0, 0), cB, voffB); PG8_STAGE(PG8_SA(0, 0), cA, voffA); PG8_STAGE(PG8_SB(0, 1), cB + hstep, voffB); PG8_STAGE(PG8_SA(0, 1), cA + hstep, voffA);
    if (wr == 1) PG8_BAR;
    PG8_WAIT_V(4); PG8_BAR;
    PG8_STAGE(PG8_SB(1, 0), cB + kstep, voffB); PG8_STAGE(PG8_SA(1, 0), cA + kstep, voffA); PG8_STAGE(PG8_SB(1, 1), cB + hstep + kstep, voffB);
    PG8_WAIT_V(6); PG8_BAR;
    PG8_STAMP();
    for (;;) {
        const bool has_next = S.next(ui + 1, nxt);
        const char* nA = has_next ? (const char*)g.A + (size_t)nxt.pm * tstep : cA; const char* nB = has_next ? (const char*)g.Bt + (size_t)nxt.pn * tstep : cB;
        for (int t = 0; t < nt; t += 2) {
            const bool last = (t == nt - 2);
            const char* a1 = cA + (size_t)(t + 1) * kstep;
            const char* a2 = last ? nA : cA + (size_t)(t + 2) * kstep; const char* b2 = last ? nB : cB + (size_t)(t + 2) * kstep;
            const char* a3 = a2 + kstep; const char* b3 = b2 + kstep;
            if (last && has_next) S.a_ready(nxt);
            if constexpr (Epi::MID) E.mid(acc, cur, t, wr, wc, fr, fq);
            PG8_LDB(B0, 0, 0); PG8_SCHED; PG8_LDA(At, 0, 0); PG8_STAGE(PG8_SA(1, 1), a1 + hstep, voffA);
            PG8_WAIT_L(8); PG8_BAR; PG8_WAIT_L(0); PG8_MMA(0, 0, At, B0); PG8_BAR; PG8_SCHED;
            PG8_LDB(B1, 0, 1); PG8_STAGE(PG8_SB(0, 0), b2, voffB);
            PG8_BAR; PG8_WAIT_L(0); PG8_MMA(0, 1, At, B1); PG8_BAR;
            PG8_LDA(At, 0, 1); PG8_STAGE(PG8_SA(0, 0), a2, voffA);
            PG8_BAR; PG8_WAIT_L(0); PG8_MMA(1, 0, At, B0); PG8_BAR; PG8_SCHED;
            PG8_STAGE(PG8_SB(0, 1), b2 + hstep, voffB);
            PG8_WAIT_V(6); PG8_BAR; PG8_MMA(1, 1, At, B1); PG8_BAR;
            PG8_LDB(B0, 1, 0); PG8_SCHED; PG8_LDA(At, 1, 0); PG8_STAGE(PG8_SA(0, 1), a2 + hstep, voffA);
            PG8_WAIT_L(8); PG8_BAR; PG8_WAIT_L(0); PG8_MMA(0, 0, At, B0); PG8_BAR; PG8_SCHED;
            PG8_LDB(B1, 1, 1); PG8_STAGE(PG8_SB(1, 0), b3, voffB);
            PG8_BAR; PG8_WAIT_L(0); PG8_MMA(0, 1, At, B1); PG8_BAR;
            PG8_LDA(At, 1, 1); PG8_STAGE(PG8_SA(1, 0), a3, voffA);
            PG8_BAR; PG8_WAIT_L(0); PG8_MMA(1, 0, At, B0); PG8_BAR; PG8_SCHED;
            PG8_STAGE(PG8_SB(1, 1), b3 + hstep, voffB);
            PG8_WAIT_V(6); PG8_BAR; PG8_MMA(1, 1, At, B1); PG8_BAR;
        }
        PG8_STAMP();
        if constexpr (!Epi::AFTER_DRAIN) { E(acc, cur, wr, wc, fr, fq); S.done(cur); }
        PG8_STAMP();
        if (!has_next) break;
#pragma unroll
        for (int a = 0; a < 2; ++a)
#pragma unroll
            for (int b = 0; b < 2; ++b)
#pragma unroll
                for (int m = 0; m < 4; ++m)
#pragma unroll
                    for (int n = 0; n < 2; ++n) acc[a][b][m][n] = (f32x4){0.f, 0.f, 0.f, 0.f};
        cur = nxt; cA = nA; cB = nB; ++ui;
    }
    PG8_WAIT_V(0);
    if (wr == 0) PG8_BAR;
    PG8_BAR;
    if constexpr (Epi::AFTER_DRAIN) { E.fused(acc, cur, wr, wc, fr, fq, lds, wid, lane); S.done(cur); }
    PG8_STAMP();
    if (STAMP && wid == 0) { stamps[lane] = lane < nts ? (((unsigned long long)(unsigned)ts_hi << 32) | (unsigned)ts_lo) : 0ull;
        if (lane == 62) stamps[62] = rt_entry; if (lane == 63) stamps[63] = (unsigned long long)wall_clock64(); }
#undef PG8_STAMP
#undef PG8_SA
#undef PG8_SB
#undef PG8_STAGE
#undef PG8_LDA
#undef PG8_LDB
#undef PG8_MMA
#undef PG8_WAIT_V
#undef PG8_WAIT_L
#undef PG8_BAR
#undef PG8_SCHED
}
}
namespace cg = cooperative_groups;
using pg8::bf16_t; using pg8::bf16x8; using pg8::f32x4; using pg8::cvt_pk_bf16; using pg8::Unit; using pg8::Gemm; using pg8::StaticOrder;
typedef unsigned u32x2 __attribute__((ext_vector_type(2)));
typedef unsigned u32x4 __attribute__((ext_vector_type(4)));
#define LAS PG8_LAS

constexpr int T = 65536, SEQ = 4096, DM = 1024, DFF = 2816, PCOLS = 5888, PLO = 2816, MEMT = 4096;
constexpr int NSCAN = 128;

constexpr size_t W_UP1 = 0;
constexpr size_t W_DN1 = W_UP1 + (size_t)5632 * 1024 * 2;
constexpr size_t W_UP2 = W_DN1 + (size_t)1024 * 2816 * 2;
constexpr size_t W_DN2 = W_UP2 + (size_t)5632 * 1024 * 2;
constexpr size_t W_INLO = W_DN2 + (size_t)1024 * 2816 * 2;
constexpr size_t W_GATE = W_INLO + (size_t)2816 * 1024 * 2;
constexpr size_t W_UPA = W_GATE + (size_t)3072 * 1024 * 2;
constexpr size_t W_UPB = W_UPA + (size_t)1024 * 512 * 2;
constexpr size_t W_UPC = W_UPB + (size_t)1024 * 256 * 2;
constexpr size_t W_OUT = W_UPC + (size_t)1024 * 256 * 2;
constexpr size_t W_MKV = W_OUT + (size_t)1024 * 1024 * 2;
constexpr size_t W_LR = W_MKV + (size_t)512 * 1024 * 2;
constexpr size_t WS_ACT = W_LR + (size_t)768 * 256 * 2;
constexpr size_t WS_ALR = WS_ACT + (size_t)T * 2816 * 2;
constexpr size_t WS_H = WS_ALR + (size_t)T * 256 * 2;
constexpr size_t WS_DEC = WS_H + (size_t)T * 1024 * 2;
constexpr size_t WS_ASG = WS_DEC + (size_t)T * 256 * 4;
constexpr size_t WS_GG = WS_ASG + (size_t)T * 256 * 2;
constexpr size_t WS_OA = WS_GG + (size_t)T * 256 * 2;
constexpr size_t WS_OB = WS_OA + (size_t)T * 512 * 2;
constexpr size_t WS_OC = WS_OB + (size_t)T * 256 * 2;
constexpr size_t WS_CS = WS_OC + (size_t)T * 256 * 2;
constexpr size_t WS_HM = WS_CS + (size_t)T * 16 * 4;
constexpr size_t WS_KVM = WS_HM + (size_t)MEMT * 1024 * 2;
constexpr size_t WS_BAR = WS_KVM + (size_t)MEMT * 512 * 2;
constexpr size_t WS_QCTR = WS_BAR + 16384;
constexpr size_t WS_SS1 = WS_BAR + 16384 + 2048;
constexpr size_t WS_SS2 = WS_SS1 + (size_t)T * 4;
constexpr size_t WS_YRAW = WS_SS2 + (size_t)T * 4;
constexpr size_t WS_END = WS_YRAW + (size_t)T * 256 * 4;

struct Params {
    const float* x; const float* mem; const int* pos;
    const float *ffn1_norm, *ffn1_w1, *ffn1_w3, *ffn1_w2, *mix_norm, *w_in, *gate_bias;
    const float *lq1, *lk1, *lq2, *lk2, *subln;
    const float *rw_mu, *rw_w0, *rw_w2, *rw_a0, *rw_a2, *rw_g2, *rw_k_k, *rw_k_a, *rw_r_k, *rw_ln_w, *rw_ln_b;
    const float *mem_norm, *w_mem_kv, *w_up_a, *w_up_b, *w_up_c, *w_out;
    const float *ffn2_norm, *ffn2_w1, *ffn2_w3, *ffn2_w2, *final_norm;
    float* out; unsigned char* ws;
};

typedef const __attribute__((address_space(4))) Params* KP;
__device__ __forceinline__ KP kp_fresh() { KP p = (KP)__builtin_amdgcn_kernarg_segment_ptr(); asm volatile("" : "+s"(p)); return p; }

__constant__ float INVF[8] = {1.0f, 0.1939227432012558f, 0.03760603070259094f, 0.007292664609849453f, 0.0014142135623842478f,
                              0.00027424818836152554f, 5.3182957344688475e-05f, 1.0313385246263351e-05f};

__device__ __forceinline__ float bf2f(bf16_t b) { return __uint_as_float(((unsigned)b) << 16); }
__device__ __forceinline__ float bflo(unsigned w) { return __uint_as_float(w << 16); }
__device__ __forceinline__ float bfhi(unsigned w) { return __uint_as_float(w & 0xffff0000u); }
__device__ __forceinline__ bf16_t f2bf(float f) { return (bf16_t)(cvt_pk_bf16(f, 0.f) & 0xffffu); }
__device__ __forceinline__ f32x4 unpk4(u32x2 w) { f32x4 r; r[0] = bflo(w.x); r[1] = bfhi(w.x); r[2] = bflo(w.y); r[3] = bfhi(w.y); return r; }
__device__ __forceinline__ float xquad_max(float x) {
    auto a = __builtin_amdgcn_permlane32_swap(__float_as_uint(x), __float_as_uint(x), false, false);
    const float m = fmaxf(__uint_as_float(a[0]), __uint_as_float(a[1]));
    auto b = __builtin_amdgcn_permlane16_swap(__float_as_uint(m), __float_as_uint(m), false, false);
    return fmaxf(__uint_as_float(b[0]), __uint_as_float(b[1]));
}
__device__ __forceinline__ float xquad_sum(float x) {
    auto a = __builtin_amdgcn_permlane32_swap(__float_as_uint(x), __float_as_uint(x), false, false);
    const float m = __uint_as_float(a[0]) + __uint_as_float(a[1]);
    auto b = __builtin_amdgcn_permlane16_swap(__float_as_uint(m), __float_as_uint(m), false, false);
    return __uint_as_float(b[0]) + __uint_as_float(b[1]);
}
__device__ __forceinline__ float fast_rcp(float x) { return __builtin_amdgcn_rcpf(x); }
__device__ __forceinline__ float sigmoidf_(float x) { return fast_rcp(1.0f + __expf(-x)); }
__device__ __forceinline__ int opaque_tid() { int t = threadIdx.x; asm volatile("" : "+v"(t)); return t; }
#define DPP_F(v, ctrl) __int_as_float(__builtin_amdgcn_update_dpp(0, __float_as_int(v), ctrl, 0xF, 0xF, true))
__device__ __forceinline__ float wave_sum(float v) { v += DPP_F(v, 0xB1); v += DPP_F(v, 0x4E); v += DPP_F(v, 0x141); v += DPP_F(v, 0x140); return xquad_sum(v); }
__device__ __forceinline__ float red8(float v) { v += DPP_F(v, 0xB1); v += DPP_F(v, 0x4E); v += DPP_F(v, 0x141); return v; }

template <class F>
__device__ __forceinline__ void conv_w(bf16_t* dst, int N, int K, F src, LAS unsigned char* lds) {
    LAS float* tl = (LAS float*)lds;
    const int tid = opaque_tid(), kt = K >> 6, ntiles = (N >> 6) * kt;
    float cur[8];
    int tile = blockIdx.x;
    if (tile < ntiles) { const int R0 = (tile / kt) * 64, k0 = (tile % kt) * 64;
#pragma unroll
        for (int j = 0; j < 8; ++j) { const int e = tid + 512 * j; cur[j] = src(R0 + (e & 63), k0 + (e >> 6)); } }
    for (; tile < ntiles; tile += gridDim.x) {
        const int R0 = (tile / kt) * 64, k0 = (tile % kt) * 64;
#pragma unroll
        for (int j = 0; j < 8; ++j) { const int e = tid + 512 * j; tl[(e & 63) * 65 + (e >> 6)] = cur[j]; }
        const int nt2 = tile + gridDim.x;
        if (nt2 < ntiles) { const int R1 = (nt2 / kt) * 64, k1 = (nt2 % kt) * 64;
#pragma unroll
            for (int j = 0; j < 8; ++j) { const int e = tid + 512 * j; cur[j] = src(R1 + (e & 63), k1 + (e >> 6)); } }
        __syncthreads();
        { const int r = tid >> 3, k8 = (tid & 7) * 8; LAS const float* p = tl + r * 65 + k8;
          u32x4 w; w.x = cvt_pk_bf16(p[0], p[1]); w.y = cvt_pk_bf16(p[2], p[3]); w.z = cvt_pk_bf16(p[4], p[5]); w.w = cvt_pk_bf16(p[6], p[7]);
          *(u32x4*)(dst + (size_t)(R0 + r) * K + k0 + k8) = w; }
        __syncthreads();
    }
}
__device__ __forceinline__ int perm_col(int R, bool rope) {
    const int Gb = R & ~31, rho = R & 31, n = rho >> 4, fq = (rho >> 2) & 3, e = rho & 3;
    int d;
    if (rope && (Gb & 32) == 0) d = fq < 2 ? 4 * fq + 8 * n + e : 16 + (fq - 2) * 8 + 4 * n + e;
    else d = 8 * fq + 4 * n + e;
    return Gb + d;
}

__device__ __forceinline__ int swiglu_col(int R) { const int pn = R >> 8, wcg = (R >> 5) & 3, rho = R & 31; return pn * 128 + wcg * 32 + 8 * ((rho >> 2) & 3) + 4 * (rho >> 4) + (rho & 3); }

__device__ __forceinline__ void norm_rows(const float* in, const float* gain, bf16_t* outb, float* outf, int rows) {
    const int tid = opaque_tid(), wave = tid >> 6, lane = tid & 63, stride = gridDim.x * 8;
    int row = blockIdx.x * 8 + wave;
    float4 nx[4];
    if (row < rows) { const float4* p = (const float4*)(in + (size_t)row * 1024);
#pragma unroll
        for (int j = 0; j < 4; ++j) nx[j] = p[j * 64 + lane]; }
    for (; row < rows; row += stride) {
        float4 v[4]; float ss = 0.f;
#pragma unroll
        for (int j = 0; j < 4; ++j) { v[j] = nx[j]; ss += v[j].x * v[j].x + v[j].y * v[j].y + v[j].z * v[j].z + v[j].w * v[j].w; }
        if (row + stride < rows) { const float4* p = (const float4*)(in + (size_t)(row + stride) * 1024);
#pragma unroll
            for (int j = 0; j < 4; ++j) nx[j] = p[j * 64 + lane]; }
        ss = wave_sum(ss);
        const float r = rsqrtf(ss * (1.0f / 1024.0f) + 1e-6f);
#pragma unroll
        for (int j = 0; j < 4; ++j) {
            const float4 g = ((const float4*)gain)[j * 64 + lane];
            float4 y; y.x = v[j].x * r * g.x; y.y = v[j].y * r * g.y; y.z = v[j].z * r * g.z; y.w = v[j].w * r * g.w;
            if (outf) ((float4*)(outf + (size_t)row * 1024))[j * 64 + lane] = y;
            else { u32x2 w; w.x = cvt_pk_bf16(y.x, y.y); w.y = cvt_pk_bf16(y.z, y.w); *(u32x2*)(outb + (size_t)row * 1024 + (j * 64 + lane) * 4) = w; }
        }
    }
}

__device__ __forceinline__ void unpk8(u32x4 w, f32x4& lo, f32x4& hi) { lo[0] = bflo(w.x); lo[1] = bfhi(w.x); lo[2] = bflo(w.y); lo[3] = bfhi(w.y); hi[0] = bflo(w.z); hi[1] = bfhi(w.z); hi[2] = bflo(w.w); hi[3] = bfhi(w.w); }
__device__ __forceinline__ void norm_rows_b(const bf16_t* in, const float* gain, float* outf, int rows) {
    const int tid = opaque_tid(), wave = tid >> 6, lane = tid & 63, stride = gridDim.x * 8;
    int row = blockIdx.x * 8 + wave;
    u32x4 nx[2];
    if (row < rows) { const u32x4* p = (const u32x4*)(in + (size_t)row * 1024); nx[0] = p[lane]; nx[1] = p[64 + lane]; }
    for (; row < rows; row += stride) {
        f32x4 v[4]; float ss = 0.f;
        unpk8(nx[0], v[0], v[1]); unpk8(nx[1], v[2], v[3]);
#pragma unroll
        for (int j = 0; j < 4; ++j) ss += v[j][0] * v[j][0] + v[j][1] * v[j][1] + v[j][2] * v[j][2] + v[j][3] * v[j][3];
        if (row + stride < rows) { const u32x4* p = (const u32x4*)(in + (size_t)(row + stride) * 1024); nx[0] = p[lane]; nx[1] = p[64 + lane]; }
        ss = wave_sum(ss);
        const float r = rsqrtf(ss * (1.0f / 1024.0f) + 1e-6f);
#pragma unroll
        for (int j = 0; j < 2; ++j) { const int c = (j * 64 + lane) * 8;
            const f32x4 g0 = *(const f32x4*)(gain + c), g1 = *(const f32x4*)(gain + c + 4);
            *(f32x4*)(outf + (size_t)row * 1024 + c) = v[2 * j] * r * g0; *(f32x4*)(outf + (size_t)row * 1024 + c + 4) = v[2 * j + 1] * r * g1; }
    }
}

struct EpiSwiglu {
    static constexpr bool PERM = false, AFTER_DRAIN = false, MID = true;
    bf16_t* act; const float* rowss; int tlast; mutable float rsv[8];
    __device__ __forceinline__ void mid(f32x4 (&)[2][2][4][2], const Unit& u, int t, int wr, int wc, int fr, int fq) const {
        if (rowss == nullptr || t != tlast) return;
        const float* rp = rowss + u.pm * 256 + wr * 64 + fr;
#pragma unroll
        for (int i = 0; i < 8; ++i) rsv[i] = rp[(i >> 2) * 128 + (i & 3) * 16];
    }
    __device__ __forceinline__ void operator()(const f32x4 (&acc)[2][2][4][2], const Unit& u, int wr, int wc, int fr, int fq) const {
        const int row0 = u.pm * 256 + wr * 64 + fr;
#pragma unroll
        for (int ai = 0; ai < 2; ++ai)
#pragma unroll
            for (int m = 0; m < 4; ++m) { const int row = row0 + ai * 128 + m * 16; bf16_t* rowp = act + (size_t)row * DFF + u.pn * 128 + wc * 32 + 8 * fq;
                const float rs = rowss ? rsqrtf(rsv[ai * 4 + m] * (1.0f / 1024.0f) + 1e-6f) : 1.0f;
                float o[8];
#pragma unroll
                for (int n = 0; n < 2; ++n) { const f32x4 g = acc[ai][0][m][n] * rs, v = acc[ai][1][m][n] * rs;
#pragma unroll
                    for (int e = 0; e < 4; ++e) o[4 * n + e] = g[e] * fast_rcp(1.0f + __expf(-g[e])) * v[e]; }
                u32x4 w; w.x = cvt_pk_bf16(o[0], o[1]); w.y = cvt_pk_bf16(o[2], o[3]); w.z = cvt_pk_bf16(o[4], o[5]); w.w = cvt_pk_bf16(o[6], o[7]);
                *(u32x4*)rowp = w; }
    }
};
template <bool HALF, bool RESB, bool OUTF, bool STATS> struct EpiRes {
    static constexpr bool PERM = false, AFTER_DRAIN = false, MID = false;
    const float* resf; const bf16_t* resb; float* outf; bf16_t* outb; float* rowss;
    __device__ __forceinline__ void ldres(size_t off, f32x4 (&r)[4]) const {
        if (RESB) { r[0] = __builtin_bit_cast(f32x4, *(const u32x4*)(resb + off)); r[1] = __builtin_bit_cast(f32x4, *(const u32x4*)(resb + off + 128)); }
        else { r[0] = *(const f32x4*)(resf + off); r[1] = *(const f32x4*)(resf + off + 4); r[2] = *(const f32x4*)(resf + off + 128); r[3] = *(const f32x4*)(resf + off + 132); }
    }
    __device__ __forceinline__ void operator()(const f32x4 (&acc)[2][2][4][2], const Unit& u, int wr, int wc, int fr, int fq) const {
        const int row0 = u.pm * 256 + wr * 64 + fr, col0 = u.pn * 256 + wc * 32 + 8 * fq;
        size_t off = (size_t)row0 * 1024 + col0; int row = row0;
        f32x4 cur[4]; ldres(off, cur);
#pragma unroll
        for (int g = 0; g < 8; ++g) {
            const int ai = g >> 2, m = g & 3;
            size_t offn = off + ((m == 3) ? (size_t)80 * 1024 : (size_t)16 * 1024);
            asm volatile("" : "+v"(offn));
            f32x4 nxt[4]; if (g < 7) ldres(offn, nxt);
            float ss = 0.f;
#pragma unroll
            for (int bj = 0; bj < 2; ++bj) { f32x4 r0, r1;
                if (RESB) unpk8(__builtin_bit_cast(u32x4, cur[bj]), r0, r1); else { r0 = cur[2 * bj]; r1 = cur[2 * bj + 1]; }
                const f32x4 v0 = r0 + acc[ai][bj][m][0] * (HALF ? 0.5f : 1.0f), v1 = r1 + acc[ai][bj][m][1] * (HALF ? 0.5f : 1.0f);
                if (OUTF) { *(f32x4*)(outf + off + bj * 128) = v0; *(f32x4*)(outf + off + bj * 128 + 4) = v1; }
                else { u32x4 w; w.x = cvt_pk_bf16(v0[0], v0[1]); w.y = cvt_pk_bf16(v0[2], v0[3]); w.z = cvt_pk_bf16(v1[0], v1[1]); w.w = cvt_pk_bf16(v1[2], v1[3]); *(u32x4*)(outb + off + bj * 128) = w; }
                if (STATS) ss += v0[0] * v0[0] + v0[1] * v0[1] + v0[2] * v0[2] + v0[3] * v0[3] + v1[0] * v1[0] + v1[1] * v1[1] + v1[2] * v1[2] + v1[3] * v1[3]; }
            if (STATS) { ss = xquad_sum(ss); if (fq == 0) atomicAdd(rowss + row, ss); }
            asm volatile("" ::: "memory");
            off = offn; row += (m == 3) ? 80 : 16;
#pragma unroll
            for (int k = 0; k < 4; ++k) cur[k] = nxt[k];
        }
    }
};
struct EpiPerm {
    static constexpr bool PERM = false, AFTER_DRAIN = false, MID = true;
    bf16_t* O; int ld; const float* cs; const float* rowss; int tlast; mutable float rsv[8];
    __device__ __forceinline__ void mid(f32x4 (&)[2][2][4][2], const Unit& u, int t, int wr, int wc, int fr, int fq) const {
        if (rowss == nullptr || t != tlast) return;
        const float* rp = rowss + u.pm * 256 + wr * 64 + fr;
#pragma unroll
        for (int i = 0; i < 8; ++i) rsv[i] = rp[(i >> 2) * 128 + (i & 3) * 16];
    }
    __device__ __forceinline__ void operator()(const f32x4 (&acc)[2][2][4][2], const Unit& u, int wr, int wc, int fr, int fq) const {
        const int row0 = u.pm * 256 + wr * 64 + fr;
        const bool rope = cs != nullptr && u.pn < 4 && (wc & 1) == 0 && fq < 2;
#pragma unroll
        for (int ai = 0; ai < 2; ++ai)
#pragma unroll
            for (int m = 0; m < 4; ++m) { const int row = row0 + ai * 128 + m * 16; bf16_t* rowp = O + (size_t)row * ld;
                f32x4 c4 = {1.f, 1.f, 1.f, 1.f}, s4 = {0.f, 0.f, 0.f, 0.f};
                if (rope) { const float* t = cs + (size_t)row * 16 + fq * 8; const f32x4 a = *(const f32x4*)t, b = *(const f32x4*)(t + 4);
                    c4[0] = a[0]; s4[0] = a[1]; c4[1] = a[2]; s4[1] = a[3]; c4[2] = b[0]; s4[2] = b[1]; c4[3] = b[2]; s4[3] = b[3]; }
                const float rs = rowss ? rsqrtf(rsv[ai * 4 + m] * (1.0f / 1024.0f) + 1e-6f) : 1.0f;
#pragma unroll
                for (int bj = 0; bj < 2; ++bj) { const f32x4 x1 = acc[ai][bj][m][0] * rs, x2 = acc[ai][bj][m][1] * rs;
                    const f32x4 y1 = x1 * c4 - x2 * s4, y2 = x2 * c4 + x1 * s4;
                    u32x4 w; w.x = cvt_pk_bf16(y1[0], y1[1]); w.y = cvt_pk_bf16(y1[2], y1[3]); w.z = cvt_pk_bf16(y2[0], y2[1]); w.w = cvt_pk_bf16(y2[2], y2[3]);
                    *(u32x4*)(rowp + u.pn * 256 + bj * 128 + wc * 32 + 8 * fq) = w; } }
    }
};
struct EpiLR {
    static constexpr bool PERM = false, AFTER_DRAIN = false, MID = false;
    float* dec; bf16_t* asg; bf16_t* gg; const float* w0; const float* a0;
    __device__ __forceinline__ void operator()(const f32x4 (&acc)[2][2][4][2], const Unit& u, int wr, int wc, int fr, int fq) const {
        const int row0 = u.pm * 256 + wr * 64 + fr, col0 = wc * 32 + 4 * fq;
#pragma unroll
        for (int ai = 0; ai < 2; ++ai)
#pragma unroll
            for (int m = 0; m < 4; ++m) { const size_t off = (size_t)(row0 + ai * 128 + m * 16) * 256 + col0;
#pragma unroll
                for (int bj = 0; bj < 2; ++bj)
#pragma unroll
                    for (int n = 0; n < 2; ++n) { const int c = col0 + bj * 128 + n * 16; const size_t o = off + bj * 128 + n * 16; const f32x4 a = acc[ai][bj][m][n];
                        if (u.pn == 0) { const f32x4 b = *(const f32x4*)(w0 + c); f32x4 d;
#pragma unroll
                            for (int e = 0; e < 4; ++e) { const float z = -(b[e] + a[e]);
                                const float sp = fmaxf(z, 0.f) + __logf(1.0f + __expf(-fabsf(z)));
                                d[e] = __expf(-__expf(-sp - 0.5f)); }
                            *(f32x4*)(dec + o) = d; }
                        else if (u.pn == 1) { const f32x4 b = *(const f32x4*)(a0 + c); u32x2 w;
                            w.x = cvt_pk_bf16(sigmoidf_(b[0] + a[0]), sigmoidf_(b[1] + a[1])); w.y = cvt_pk_bf16(sigmoidf_(b[2] + a[2]), sigmoidf_(b[3] + a[3]));
                            *(u32x2*)(asg + o) = w; }
                        else { u32x2 w; w.x = cvt_pk_bf16(a[0], a[1]); w.y = cvt_pk_bf16(a[2], a[3]); *(u32x2*)(gg + o) = w; } } }
    }
};
struct EpiTmp {
    static constexpr bool PERM = false, AFTER_DRAIN = false, MID = false;
    float* tmp;
    __device__ __forceinline__ void operator()(const f32x4 (&acc)[2][2][4][2], const Unit& u, int wr, int wc, int fr, int fq) const {
        const int row0 = u.pm * 256 + wr * 64 + fr, col0 = u.pn * 256 + wc * 32 + 4 * fq;
#pragma unroll
        for (int ai = 0; ai < 2; ++ai)
#pragma unroll
            for (int m = 0; m < 4; ++m) { const size_t off = (size_t)(row0 + ai * 128 + m * 16) * 1024 + col0;
#pragma unroll
                for (int bj = 0; bj < 2; ++bj)
#pragma unroll
                    for (int n = 0; n < 2; ++n) *(f32x4*)(tmp + off + bj * 128 + n * 16) = acc[ai][bj][m][n]; }
    }
};
struct EpiGate {
    static constexpr bool PERM = false, AFTER_DRAIN = false, MID = false;
    const float* tmp; const float* bias; bf16_t* merged; int first;
    __device__ __forceinline__ void operator()(const f32x4 (&acc)[2][2][4][2], const Unit& u, int wr, int wc, int fr, int fq) const {
        const int row0 = u.pm * 256 + wr * 64 + fr, col0 = u.pn * 256 + wc * 32 + 4 * fq;
#pragma unroll
        for (int ai = 0; ai < 2; ++ai)
#pragma unroll
            for (int m = 0; m < 4; ++m) { const size_t off = (size_t)(row0 + ai * 128 + m * 16) * 1024 + col0;
#pragma unroll
                for (int bj = 0; bj < 2; ++bj)
#pragma unroll
                    for (int n = 0; n < 2; ++n) { const size_t o = off + bj * 128 + n * 16; const f32x4 tv = *(const f32x4*)(tmp + o), b = *(const f32x4*)(bias + col0 + bj * 128 + n * 16), a = acc[ai][bj][m][n];
                        f32x4 v;
#pragma unroll
                        for (int e = 0; e < 4; ++e) v[e] = sigmoidf_(a[e] + b[e]) * tv[e];
                        if (!first) { const u32x2 old = *(const u32x2*)(merged + o); v[0] += bflo(old.x); v[1] += bfhi(old.x); v[2] += bflo(old.y); v[3] += bfhi(old.y); }
                        u32x2 w; w.x = cvt_pk_bf16(v[0], v[1]); w.y = cvt_pk_bf16(v[2], v[3]); *(u32x2*)(merged + o) = w; } }
    }
};

struct EpiSig {
    static constexpr bool PERM = false, AFTER_DRAIN = false, MID = true;
    bf16_t* G; const float* bias; const float* rowss; int tlast; mutable float rsv[8];
    __device__ __forceinline__ void mid(f32x4 (&)[2][2][4][2], const Unit& u, int t, int wr, int wc, int fr, int fq) const {
        if (rowss == nullptr || t != tlast) return;
        const float* rp = rowss + u.pm * 256 + wr * 64 + fr;
#pragma unroll
        for (int i = 0; i < 8; ++i) rsv[i] = rp[(i >> 2) * 128 + (i & 3) * 16];
    }
    __device__ __forceinline__ void operator()(const f32x4 (&acc)[2][2][4][2], const Unit& u, int wr, int wc, int fr, int fq) const {
        const int row0 = u.pm * 256 + wr * 64 + fr, col0 = u.pn * 256 + wc * 32 + 8 * fq;
#pragma unroll
        for (int ai = 0; ai < 2; ++ai)
#pragma unroll
            for (int m = 0; m < 4; ++m) { const int row = row0 + ai * 128 + m * 16; const size_t off = (size_t)row * 3072 + col0; const float rs = rsqrtf(rsv[ai * 4 + m] * (1.0f / 1024.0f) + 1e-6f);
#pragma unroll
                for (int bj = 0; bj < 2; ++bj) { const f32x4 b0 = *(const f32x4*)(bias + col0 + bj * 128), b1 = *(const f32x4*)(bias + col0 + bj * 128 + 4), a0 = acc[ai][bj][m][0], a1 = acc[ai][bj][m][1];
                    u32x4 w; w.x = cvt_pk_bf16(sigmoidf_(a0[0] * rs + b0[0]), sigmoidf_(a0[1] * rs + b0[1])); w.y = cvt_pk_bf16(sigmoidf_(a0[2] * rs + b0[2]), sigmoidf_(a0[3] * rs + b0[3]));
                    w.z = cvt_pk_bf16(sigmoidf_(a1[0] * rs + b1[0]), sigmoidf_(a1[1] * rs + b1[1])); w.w = cvt_pk_bf16(sigmoidf_(a1[2] * rs + b1[2]), sigmoidf_(a1[3] * rs + b1[3]));
                    *(u32x4*)(G + off + bj * 128) = w; } }
    }
};
struct EpiMix {
    static constexpr bool PERM = false, AFTER_DRAIN = false, MID = true;
    const bf16_t* G; bf16_t* merged;
    __device__ __forceinline__ void mid(f32x4 (&acc)[2][2][4][2], const Unit& u, int t, int wr, int wc, int fr, int fq) const {
        if (t != 8 && t != 12) return;
        const bf16_t* gp = G + (size_t)(u.pm * 256 + wr * 64 + fr) * 3072 + ((t == 8) ? 0 : 1024) + u.pn * 256 + wc * 32 + 8 * fq;
#pragma unroll
        for (int ai = 0; ai < 2; ++ai) {
#pragma unroll
            for (int m = 0; m < 4; ++m) {
#pragma unroll
                for (int bj = 0; bj < 2; ++bj) { f32x4 n0, n1, d0, d1; unpk8(*(const u32x4*)(gp + bj * 128), n0, n1); unpk8(*(const u32x4*)(gp + 1024 + bj * 128), d0, d1);
                    f32x4 r0, r1;
#pragma unroll
                    for (int e = 0; e < 4; ++e) { r0[e] = n0[e] * fast_rcp(d0[e]); r1[e] = n1[e] * fast_rcp(d1[e]); }
                    acc[ai][bj][m][0] *= r0; acc[ai][bj][m][1] *= r1; }
                gp += 16 * 3072; asm volatile("" : "+v"(gp) :: "memory"); }
            gp += 64 * 3072; asm volatile("" : "+v"(gp)); }
    }
    __device__ __forceinline__ void operator()(const f32x4 (&acc)[2][2][4][2], const Unit& u, int wr, int wc, int fr, int fq) const {
        const int row0 = u.pm * 256 + wr * 64 + fr, col0 = u.pn * 256 + wc * 32 + 8 * fq;
        const bf16_t* gp = G + (size_t)row0 * 3072 + 2048 + col0; bf16_t* mp = merged + (size_t)row0 * 1024 + col0;
        u32x4 c0 = *(const u32x4*)gp, c1 = *(const u32x4*)(gp + 128);
#pragma unroll
        for (int g = 0; g < 8; ++g) {
            const int ai = g >> 2, m = g & 3;
            const bf16_t* gn = gp + ((m == 3) ? 80 * 3072 : 16 * 3072);
            asm volatile("" : "+v"(gn));
            u32x4 n0 = c0, n1 = c1; if (g < 7) { n0 = *(const u32x4*)gn; n1 = *(const u32x4*)(gn + 128); }
#pragma unroll
            for (int bj = 0; bj < 2; ++bj) { f32x4 g0, g1; unpk8(bj ? c1 : c0, g0, g1); const f32x4 v0 = acc[ai][bj][m][0] * g0, v1 = acc[ai][bj][m][1] * g1;
                u32x4 w; w.x = cvt_pk_bf16(v0[0], v0[1]); w.y = cvt_pk_bf16(v0[2], v0[3]); w.z = cvt_pk_bf16(v1[0], v1[1]); w.w = cvt_pk_bf16(v1[2], v1[3]); *(u32x4*)(mp + bj * 128) = w; }
            asm volatile("" ::: "memory");
            gp = gn; mp += (m == 3) ? 80 * 1024 : 16 * 1024; c0 = n0; c1 = n1;
        }
    }
};

template <class Epi>
__device__ __forceinline__ void run_gemm(LAS unsigned char* lds, const bf16_t* A, const bf16_t* Bt, int M, int N, int K, const Epi& E) {
    Gemm g; g.A = A; g.Bt = Bt; g.M = M; g.N = N; g.K = K;
    StaticOrder S; S.init(M, N, (int)gridDim.x, (int)blockIdx.x);
    pg8::gemm_phase<Epi, StaticOrder, false>(lds, g, S, E, nullptr);
    __syncthreads();
}

constexpr int KSTR = 144, VSTR = 136;
constexpr int LK0 = 0, LK1 = 64 * KSTR, LVT = 2 * 64 * KSTR, LVTSZ = 128 * VSTR, LEX = LVT + 2 * LVTSZ;
constexpr float SC_LOG2E = 0.125f * 1.4426950408889634f;

template <int DV, bool TWO>
__device__ __forceinline__ void attn_core(LAS unsigned char* lds, const bf16_t* Qw, int ldq, const bf16_t* K0p, const bf16_t* K1p, int ldk,
                                          const bf16_t* Vp, int ldv, int ntiles, bool skip_last, f32x4 (&o)[DV / 16][2]) {
    const int tid = opaque_tid(), wave = tid >> 6, lane = tid & 63, r = lane & 15, quad = lane >> 4;
    const int kmap = TWO ? (wave >> 2) : 0;
    bf16x8 qf[2][2];
#pragma unroll
    for (int qt = 0; qt < 2; ++qt)
#pragma unroll
        for (int ks = 0; ks < 2; ++ks) qf[qt][ks] = *(const bf16x8*)(Qw + (size_t)(qt * 16 + r) * ldq + ks * 32 + quad * 8);
    float mrow[2] = {-INFINITY, -INFINITY}, lrow[2] = {0.f, 0.f};
#pragma unroll
    for (int dt = 0; dt < DV / 16; ++dt) { o[dt][0] = (f32x4){0.f, 0.f, 0.f, 0.f}; o[dt][1] = (f32x4){0.f, 0.f, 0.f, 0.f}; }
    u32x4 kreg[2], vreg[2];
    const int k_map = TWO ? (tid >> 8) : 0, k_row = TWO ? ((tid >> 2) & 63) : (tid >> 3), k_d = TWO ? (tid & 3) * 16 : (tid & 7) * 8;
    const bf16_t* kbase = (k_map ? K1p : K0p) + (size_t)k_row * ldk + k_d;
    const bool v_on = (DV == 128) || tid < 256;
    const int v_kp = (DV == 128) ? (tid >> 4) : (tid >> 3), v_dg = (DV == 128) ? (tid & 15) : (tid & 7);
    const bf16_t* vbase = Vp + (size_t)(2 * v_kp) * ldv + v_dg * 8;
    auto gload = [&](int tile) {
        const bf16_t* kp = kbase + (size_t)tile * 64 * ldk;
        kreg[0] = *(const u32x4*)kp; if (TWO) kreg[1] = *(const u32x4*)(kp + 8);
        if (v_on) { const bf16_t* vp = vbase + (size_t)tile * 64 * ldv; vreg[0] = *(const u32x4*)vp; vreg[1] = *(const u32x4*)(vp + ldv); }
    };
    bf16x8 pbp[2][2];
    bool prev = false;
    auto pv_half = [&](int vbuf, int h) {
#pragma unroll
        for (int d2 = 0; d2 < DV / 32; ++d2) { const int dt = h * (DV / 32) + d2;
#pragma unroll
            for (int kk = 0; kk < 2; ++kk) { LAS const unsigned char* vrow = lds + LVT + vbuf * LVTSZ + (dt * 16 + r) * VSTR;
                const u32x2 lo = *(LAS const u32x2*)(vrow + (((16 * kk + 2 * quad) ^ (4 * dt)) << 2)), hi = *(LAS const u32x2*)(vrow + (((16 * kk + 8 + 2 * quad) ^ (4 * dt)) << 2));
                u32x4 w; w.x = lo.x; w.y = lo.y; w.z = hi.x; w.w = hi.y; const bf16x8 vf = __builtin_bit_cast(bf16x8, w);
                o[dt][0] = __builtin_amdgcn_mfma_f32_16x16x32_bf16(vf, pbp[0][kk], o[dt][0], 0, 0, 0);
                o[dt][1] = __builtin_amdgcn_mfma_f32_16x16x32_bf16(vf, pbp[1][kk], o[dt][1], 0, 0, 0); } }
    };
    gload(0);
    for (int tile = 0; tile < ntiles; ++tile) {
        const int vb = tile & 1;
        __syncthreads();
        { LAS unsigned char* kd = lds + (k_map ? LK1 : LK0) + k_row * KSTR + k_d * 2;
          *(LAS u32x4*)kd = kreg[0]; if (TWO) *(LAS u32x4*)(kd + 16) = kreg[1];
          if (v_on) {
#pragma unroll
              for (int e = 0; e < 8; ++e) { const unsigned a = vreg[0][e >> 1], b = vreg[1][e >> 1];
                  const unsigned w = (e & 1) ? ((a >> 16) | (b & 0xffff0000u)) : ((a & 0xffffu) | (b << 16));
                  *(LAS unsigned*)(lds + LVT + vb * LVTSZ + (v_dg * 8 + e) * VSTR + ((v_kp ^ ((v_dg >> 1) << 2)) << 2)) = w; } } }
        __syncthreads();
        const bool active = !(skip_last && tile == ntiles - 1);
        if (!active) { if (prev) { pv_half(vb ^ 1, 0); pv_half(vb ^ 1, 1); prev = false; } continue; }
        f32x4 s[4][2];
#pragma unroll
        for (int kt = 0; kt < 4; ++kt) { s[kt][0] = (f32x4){0.f, 0.f, 0.f, 0.f}; s[kt][1] = (f32x4){0.f, 0.f, 0.f, 0.f};
#pragma unroll
            for (int ks = 0; ks < 2; ++ks) { const bf16x8 kf = *(const LAS bf16x8*)(lds + (kmap ? LK1 : LK0) + (kt * 16 + r) * KSTR + (ks * 32 + quad * 8) * 2);
                s[kt][0] = __builtin_amdgcn_mfma_f32_16x16x32_bf16(kf, qf[0][ks], s[kt][0], 0, 0, 0);
                s[kt][1] = __builtin_amdgcn_mfma_f32_16x16x32_bf16(kf, qf[1][ks], s[kt][1], 0, 0, 0); } }
        float alpha[2];
        auto softmax_q = [&](int qt, bf16x8 (&dst)[2]) {
            float mx = s[0][qt][0];
#pragma unroll
            for (int kt = 0; kt < 4; ++kt)
#pragma unroll
                for (int j = 0; j < 4; ++j) mx = fmaxf(mx, s[kt][qt][j]);
            mx = xquad_max(mx);
            const float mn = fmaxf(mrow[qt], mx * SC_LOG2E);
            alpha[qt] = __builtin_amdgcn_exp2f(mrow[qt] - mn); mrow[qt] = mn;
            float ps = 0.f; float p[4][4];
#pragma unroll
            for (int kt = 0; kt < 4; ++kt)
#pragma unroll
                for (int j = 0; j < 4; ++j) { p[kt][j] = __builtin_amdgcn_exp2f(s[kt][qt][j] * SC_LOG2E - mn); ps += p[kt][j]; }
            lrow[qt] = lrow[qt] * alpha[qt] + ps;
#pragma unroll
            for (int kk = 0; kk < 2; ++kk) { u32x4 w; w.x = cvt_pk_bf16(p[2 * kk][0], p[2 * kk][1]); w.y = cvt_pk_bf16(p[2 * kk][2], p[2 * kk][3]);
                w.z = cvt_pk_bf16(p[2 * kk + 1][0], p[2 * kk + 1][1]); w.w = cvt_pk_bf16(p[2 * kk + 1][2], p[2 * kk + 1][3]);
                dst[kk] = __builtin_bit_cast(bf16x8, w); }
        };
        bf16x8 pb0[2];
        if (prev) pv_half(vb ^ 1, 0);
        softmax_q(0, pb0);
        if (prev) pv_half(vb ^ 1, 1);
        if (tile + 1 < ntiles) gload(tile + 1);
        softmax_q(1, pbp[1]);
        pbp[0][0] = pb0[0]; pbp[0][1] = pb0[1];
#pragma unroll
        for (int qt = 0; qt < 2; ++qt) {
            if (__builtin_amdgcn_ballot_w64(alpha[qt] != 1.0f) != 0ull) {
#pragma unroll
                for (int dt = 0; dt < DV / 16; ++dt) o[dt][qt] *= alpha[qt]; } }
        prev = true;
    }
    if (prev) { const int vb = (ntiles - 1) & 1; pv_half(vb, 0); pv_half(vb, 1); }
#pragma unroll
    for (int qt = 0; qt < 2; ++qt) { float l = lrow[qt]; l = xquad_sum(l); const float inv = 1.0f / l;
#pragma unroll
        for (int dt = 0; dt < DV / 16; ++dt) o[dt][qt] *= inv; }
}

__device__ __forceinline__ void attention_phase(KP P, LAS unsigned char* lds) {
    const int tid = opaque_tid(), wave = tid >> 6, lane = tid & 63, r = lane & 15, quad = lane >> 4;
    const bf16_t* proj = (const bf16_t*)(P->ws + WS_ACT);
    const bf16_t* kvm = (const bf16_t*)(P->ws + WS_KVM);
    unsigned* qctr = (unsigned*)(P->ws + WS_QCTR);
    LAS unsigned* qslot = (LAS unsigned*)(lds + 120000);
    for (;;) {
        __syncthreads();
        if (tid == 0) {
            const unsigned x0 = ((unsigned)__builtin_amdgcn_s_getreg((3 << 11) | 20)) & 7u  ; unsigned got = 0xffffffffu;
            for (unsigned k = 0; k < 8u; ++k) { const unsigned q = (x0 + k) & 7u; const unsigned idx = __hip_atomic_fetch_add(qctr + q * 64u, 1u, __ATOMIC_RELAXED, __HIP_MEMORY_SCOPE_AGENT);
                if (idx < 384u) { got = q * 384u + idx; break; } }
            *qslot = got; }
        __syncthreads();
        const unsigned gotv = *qslot;
        if (gotv == 0xffffffffu) break;
        const int qx = (int)(gotv / 384u), qi = (int)(gotv % 384u);
        if (qi < 256) {
        const int qb = 31 - (qi & 31), bh = (qi >> 5) * 8 + qx, b = bh >> 2, h = bh & 3, map = wave >> 2, wq = wave & 3;
        const size_t tok0 = (size_t)b * SEQ;
        const int q0 = qb * 128 + wq * 32;
        f32x4 o[8][2];
        attn_core<128, true>(lds, proj + (tok0 + q0) * PLO + (2 * h + map) * 64, PLO, proj + tok0 * PLO + 512 + (2 * h) * 64, proj + tok0 * PLO + 512 + (2 * h + 1) * 64, PLO,
                             proj + tok0 * PLO + 1024 + h * 128, PLO, 2 * qb + 2, wq < 2, o);
        LAS float* ex = (LAS float*)(lds + LEX) + (size_t)wq * 4096 + lane;
        if (map == 1) {
            const float s1 = wave_sum(P->lq1[lane] * P->lk1[lane]), s2 = wave_sum(P->lq2[lane] * P->lk2[lane]); const float lam = expf(s1) - expf(s2) + 0.2f;
#pragma unroll
            for (int dt = 0; dt < 8; ++dt)
#pragma unroll
                for (int qt = 0; qt < 2; ++qt)
#pragma unroll
                    for (int j = 0; j < 4; ++j) ex[((dt * 2 + qt) * 4 + j) * 64] = o[dt][qt][j] * lam;
        }
        __syncthreads();
        if (map == 0) {
#pragma unroll
            for (int qt = 0; qt < 2; ++qt) { float ss = 0.f;
#pragma unroll
                for (int dt = 0; dt < 8; ++dt)
#pragma unroll
                    for (int j = 0; j < 4; ++j) { const float v = o[dt][qt][j] - ex[((dt * 2 + qt) * 4 + j) * 64]; o[dt][qt][j] = v; ss += v * v; }
                ss = xquad_sum(ss);
                const float rs = rsqrtf(ss * (1.0f / 128.0f) + 1e-6f) * 0.8f;
                int ro = r * 1024 + quad * 4; asm volatile("" : "+v"(ro));
                bf16_t* op = (bf16_t*)(P->ws + WS_OA) + (tok0 + q0 + qt * 16) * 1024 + h * 128 + ro;
#pragma unroll
                for (int dt = 0; dt < 8; ++dt) { const f32x4 g = *(const f32x4*)(P->subln + dt * 16 + quad * 4); const f32x4 v = o[dt][qt] * g * rs;
                    u32x2 w; w.x = cvt_pk_bf16(v[0], v[1]); w.y = cvt_pk_bf16(v[2], v[3]); *(u32x2*)(op + dt * 16) = w; } }
        }
    }
        else { const int j = qi - 256;
        const int b = (j >> 6) * 8 + qx, qblk = b * 16 + ((j & 63) >> 2), hx = j & 3;
        const size_t tokq = (size_t)qblk * 256 + wave * 32;
        f32x4 o[4][2];
        attn_core<64, false>(lds, proj + tokq * PLO + 2560 + hx * 64, PLO, kvm + (size_t)b * 256 * 512 + hx * 64, nullptr, 512,
                             kvm + (size_t)b * 256 * 512 + 256 + hx * 64, 512, 4, false, o);
#pragma unroll
        for (int qt = 0; qt < 2; ++qt) { int ro = r * 1024 + quad * 4; asm volatile("" : "+v"(ro)); bf16_t* op = (bf16_t*)(P->ws + WS_OA) + 768 + (tokq + qt * 16) * 1024 + hx * 64 + ro;
#pragma unroll
            for (int dt = 0; dt < 4; ++dt) { const f32x4 v = o[dt][qt]; u32x2 w; w.x = cvt_pk_bf16(v[0], v[1]); w.y = cvt_pk_bf16(v[2], v[3]); *(u32x2*)(op + dt * 16) = w; } }
    }
    }
}

__device__ __forceinline__ float red16(float v) { v += DPP_F(v, 0xB1); v += DPP_F(v, 0x4E); v += DPP_F(v, 0x141); v += DPP_F(v, 0x140); return v; }
constexpr int SB = 64;
__device__ __forceinline__ void rwkv_scan(KP P, LAS unsigned char* lds, int wg) {
    const int bh = (wg >> 4) * 8 + (wg & 7), half = (wg >> 3) & 1, b = bh >> 2, h = bh & 3, tid = opaque_tid();
    LAS float* __restrict__ vec = (LAS float*)lds;
    LAS float* __restrict__ ybuf = (LAS float*)lds + SB * 384;
    const bf16_t* proj = (const bf16_t*)(P->ws + WS_ACT);
    const float* dec = (const float*)(P->ws + WS_DEC);
    const bf16_t* asg = (const bf16_t*)(P->ws + WS_ASG);
    float* yraw = (float*)(P->ws + WS_YRAW);
    const int tl = tid >> 4, l4 = (tid & 15) * 4, c4 = h * 64 + l4;
    const f32x4 mu_r = *(const f32x4*)(P->rw_mu + c4), mu_k = *(const f32x4*)(P->rw_mu + 256 + c4), mu_v = *(const f32x4*)(P->rw_mu + 512 + c4);
    const f32x4 kkp = *(const f32x4*)(P->rw_k_k + c4), kap = *(const f32x4*)(P->rw_k_a + c4);
    const int il = tid >> 4, irow = half * 32 + il;
    f32x4 st = {0.f, 0.f, 0.f, 0.f};
    constexpr int NP = SB / 32;
    u32x2 ur[NP], uk[NP], uv[NP], urp[NP], ukp[NP], uvp[NP], as2[NP]; f32x4 dc[NP];
    const size_t tokb = (size_t)b * SEQ;
    auto load_raw = [&](int blk) {
#pragma unroll
        for (int q = 0; q < NP; ++q) {
        const int tt = blk * SB + tl + 32 * q; const size_t tok = tokb + tt;
        const bf16_t* base = proj + tok * PLO + 1536 + c4;
        ur[q] = *(const u32x2*)base; uk[q] = *(const u32x2*)(base + 256); uv[q] = *(const u32x2*)(base + 512);
        if (tt > 0) { urp[q] = *(const u32x2*)(base - PLO); ukp[q] = *(const u32x2*)(base - PLO + 256); uvp[q] = *(const u32x2*)(base - PLO + 512); }
        else { urp[q] = (u32x2){0u, 0u}; ukp[q] = urp[q]; uvp[q] = urp[q]; }
        dc[q] = *(const f32x4*)(dec + tok * 256 + c4); as2[q] = *(const u32x2*)(asg + tok * 256 + c4); }
    };
    auto prep = [&]() {
#pragma unroll
        for (int q = 0; q < NP; ++q) {
        const f32x4 r0 = unpk4(ur[q]), rp = unpk4(urp[q]), k0 = unpk4(uk[q]), kp = unpk4(ukp[q]), v0 = unpk4(uv[q]), vp = unpk4(uvp[q]), a = unpk4(as2[q]);
        const f32x4 rr = r0 + (rp - r0) * mu_r, kx = k0 + (kp - k0) * mu_k, vv = v0 + (vp - v0) * mu_v;
        f32x4 kk = kx * kkp;
        const float nrm = sqrtf(red16(kk[0] * kk[0] + kk[1] * kk[1] + kk[2] * kk[2] + kk[3] * kk[3]));
        kk = kk * fast_rcp(fmaxf(nrm, 1e-12f));
        const f32x4 kmod = kx * (1.0f + (a - 1.0f) * kap);
        LAS float* vt = vec + (tl + 32 * q) * 384 + l4;
        *(LAS f32x4*)(vt) = rr; *(LAS f32x4*)(vt + 64) = dc[q]; *(LAS f32x4*)(vt + 128) = kmod; *(LAS f32x4*)(vt + 192) = -kk; *(LAS f32x4*)(vt + 256) = kk * a; *(LAS f32x4*)(vt + 320) = vv; }
    };
    load_raw(0); prep(); __syncthreads();
    for (int blk = 0; blk < SEQ / SB; ++blk) {
        if (blk + 1 < SEQ / SB) load_raw(blk + 1);
        {
            LAS const float* vt = vec;
            f32x4 a4 = *(LAS const f32x4*)(vt + 192 + l4), w4 = *(LAS const f32x4*)(vt + 64 + l4), b4 = *(LAS const f32x4*)(vt + 256 + l4), k4 = *(LAS const f32x4*)(vt + 128 + l4), r4 = *(LAS const f32x4*)(vt + l4);
            float vi = vt[320 + irow], yprev = 0.f;
#pragma unroll 4
            for (int t = 0; t < SB; ++t) {
                const int tn = (t + 1 < SB) ? t + 1 : t; LAS const float* vn = vec + tn * 384;
                const f32x4 a4n = *(LAS const f32x4*)(vn + 192 + l4), w4n = *(LAS const f32x4*)(vn + 64 + l4), b4n = *(LAS const f32x4*)(vn + 256 + l4), k4n = *(LAS const f32x4*)(vn + 128 + l4), r4n = *(LAS const f32x4*)(vn + l4);
                const float vin = vn[320 + irow];
                float sa = st[0] * a4[0] + st[1] * a4[1] + st[2] * a4[2] + st[3] * a4[3];
                sa += DPP_F(sa, 0xB1); yprev += DPP_F(yprev, 0xB1);
                sa += DPP_F(sa, 0x4E); yprev += DPP_F(yprev, 0x4E);
                sa += DPP_F(sa, 0x141); yprev += DPP_F(yprev, 0x141);
                sa += DPP_F(sa, 0x140); yprev += DPP_F(yprev, 0x140);
                if (t > 0 && (tid & 15) == 0) ybuf[(t - 1) * 32 + il] = yprev;
                st = st * w4 + (b4 * sa + k4 * vi);
                yprev = st[0] * r4[0] + st[1] * r4[1] + st[2] * r4[2] + st[3] * r4[3];
                a4 = a4n; w4 = w4n; b4 = b4n; k4 = k4n; r4 = r4n; vi = vin; }
            yprev = red16(yprev);
            if ((tid & 15) == 0) ybuf[(SB - 1) * 32 + il] = yprev; }
        __syncthreads();
#pragma unroll
        for (int q = 0; q < NP; ++q) { const size_t tok = tokb + blk * SB + tl + 32 * q; const int p2 = (tid & 15) * 2;
          const float y0 = ybuf[(tl + 32 * q) * 32 + p2], y1 = ybuf[(tl + 32 * q) * 32 + p2 + 1];
          float2 yy; yy.x = y0; yy.y = y1;
          *(float2*)(yraw + tok * 256 + h * 64 + half * 32 + p2) = yy; }
        if (blk + 1 < SEQ / SB) prep();
        __syncthreads();
    }
}
__device__ __forceinline__ void rwkv_post(KP P) {
    const bf16_t* proj = (const bf16_t*)(P->ws + WS_ACT);
    const bf16_t* asg = (const bf16_t*)(P->ws + WS_ASG);
    const bf16_t* ggp = (const bf16_t*)(P->ws + WS_GG);
    const float* yraw = (const float*)(P->ws + WS_YRAW);
    bf16_t* ob = (bf16_t*)(P->ws + WS_OA) + 512;
    for (int idx = (int)blockIdx.x * 512 + opaque_tid(); idx < T * 64; idx += (int)gridDim.x * 512) {
        const int tok = idx >> 6, c4 = (idx & 63) * 4;
        const bf16_t* base = proj + (size_t)tok * PLO + 1536 + c4;
        const f32x4 r0 = unpk4(*(const u32x2*)base), k0 = unpk4(*(const u32x2*)(base + 256)), v0 = unpk4(*(const u32x2*)(base + 512));
        f32x4 rp = {0.f, 0.f, 0.f, 0.f}, kp = rp, vp = rp;
        if ((tok & (SEQ - 1)) != 0) { rp = unpk4(*(const u32x2*)(base - PLO)); kp = unpk4(*(const u32x2*)(base - PLO + 256)); vp = unpk4(*(const u32x2*)(base - PLO + 512)); }
        const f32x4 a = unpk4(*(const u32x2*)(asg + (size_t)tok * 256 + c4)), g = unpk4(*(const u32x2*)(ggp + (size_t)tok * 256 + c4));
        const f32x4 y = *(const f32x4*)(yraw + (size_t)tok * 256 + c4);
        const f32x4 mu_r = *(const f32x4*)(P->rw_mu + c4), mu_k = *(const f32x4*)(P->rw_mu + 256 + c4), mu_v = *(const f32x4*)(P->rw_mu + 512 + c4);
        const f32x4 kap = *(const f32x4*)(P->rw_k_a + c4), rkp = *(const f32x4*)(P->rw_r_k + c4), lnw = *(const f32x4*)(P->rw_ln_w + c4), lnb = *(const f32x4*)(P->rw_ln_b + c4);
        const f32x4 rr = r0 + (rp - r0) * mu_r, kx = k0 + (kp - k0) * mu_k, vv = v0 + (vp - v0) * mu_v;
        const f32x4 kmod = kx * (1.0f + (a - 1.0f) * kap), tb = rr * kmod * rkp;
        const float bon = red16(tb[0] + tb[1] + tb[2] + tb[3]);
        const float mean = red16(y[0] + y[1] + y[2] + y[3]) * (1.0f / 64.0f); const f32x4 d = y - mean;
        const float var = red16(d[0] * d[0] + d[1] * d[1] + d[2] * d[2] + d[3] * d[3]) * (1.0f / 64.0f);
        f32x4 yn = d * rsqrtf(var + 64e-5f) * lnw + lnb; yn = (yn + vv * bon) * g;
        u32x2 w; w.x = cvt_pk_bf16(yn[0], yn[1]); w.y = cvt_pk_bf16(yn[2], yn[3]);
        *(u32x2*)(ob + (size_t)tok * 1024 + c4) = w;
    }
}

#define XB_TMO      128
#define XB_XCNT(j)  (256  + 64 * (j))
#define XB_XSUB(j)  (1280 + 64 * (j))
#define XB_XGEN(j)  (2304 + 64 * (j))
#define XB_TOP      3328
#define XB_TOPGEN   3392
#define XCD_BAR_WORDS 3456
#define XB_SPIN_CAP (1u << 18)

__device__ __forceinline__ unsigned xb_ld(unsigned* p)              { return __hip_atomic_load(p, __ATOMIC_RELAXED, __HIP_MEMORY_SCOPE_AGENT); }
__device__ __forceinline__ unsigned xb_add(unsigned* p, unsigned v) { return __hip_atomic_fetch_add(p, v, __ATOMIC_RELAXED, __HIP_MEMORY_SCOPE_AGENT); }
__device__ __forceinline__ unsigned xb_xcc_id() { return (unsigned)__builtin_amdgcn_s_getreg((3 << 11) | 20) & 0xFu; }
#define XB_SPIN(cond, bar) do { unsigned _sp = 0; while (cond) { __builtin_amdgcn_s_sleep(1); \
    if ((++_sp & 255u) == 0u) { if (xb_ld(&(bar)[XB_TMO])) break; if (_sp > XB_SPIN_CAP) { atomicAdd(&(bar)[XB_TMO], 1u); break; } } } } while (0)

struct XcdBarrier {
    unsigned* bar; unsigned x;
    volatile PG8_LAS unsigned* st;
};

__device__ __forceinline__ XcdBarrier xcd_barrier_post(unsigned* bar, volatile PG8_LAS unsigned* st) {
    XcdBarrier b; b.bar = bar; b.x = xb_xcc_id(); b.st = st;
    if (threadIdx.x == 0) (void)xb_add(&bar[XB_XCNT(b.x)], 1u);
    return b;
}
__device__ __forceinline__ void xcd_barrier_complete(unsigned* bar, unsigned x, unsigned& nloc, unsigned& nx) {
    const unsigned G = gridDim.x * gridDim.y * gridDim.z;
    unsigned sum, cnt, mine, sp = 0u;
    for (;;) {
        sum = 0u; cnt = 0u; mine = 0u;
#pragma unroll
        for (unsigned j = 0; j < 16; ++j) { const unsigned c = xb_ld(&bar[XB_XCNT(j)]); sum += c; cnt += (c > 0u) ? 1u : 0u; mine = (j == x) ? c : mine; }
        if (sum == G) break;
        __builtin_amdgcn_s_sleep(1);
        if ((++sp & 255u) == 0u) { if (xb_ld(&bar[XB_TMO])) break; if (sp > XB_SPIN_CAP) { atomicAdd(&bar[XB_TMO], 1u); break; } }
    }
    nloc = mine > 0u ? mine : 1u; nx = cnt > 0u ? cnt : 1u;
}

__device__ __forceinline__ void xcd_barrier(const XcdBarrier& b) {
    asm volatile("s_waitcnt vmcnt(0)" ::: "memory");
    __syncthreads();
    if (threadIdx.x == 0) {
        unsigned* bar = b.bar;
        __builtin_amdgcn_s_waitcnt(0);
        unsigned nloc = b.st[0], nx = b.st[1];
        if (nloc == 0u) { xcd_barrier_complete(bar, b.x, nloc, nx); b.st[0] = nloc; b.st[1] = nx; }
        const unsigned old = xb_add(&bar[XB_XSUB(b.x)], 1u);
        const unsigned gen = old / nloc;
        if (old + 1u == (gen + 1u) * nloc) {
            __builtin_amdgcn_fence(__ATOMIC_RELEASE, "agent");
            asm volatile("s_waitcnt vmcnt(0)" ::: "memory");
            const unsigned og = xb_add(&bar[XB_TOP], 1u);
            const unsigned tg = og / nx;
            if (og + 1u == (tg + 1u) * nx) xb_add(&bar[XB_TOPGEN], 1u);
            else XB_SPIN(xb_ld(&bar[XB_TOPGEN]) == tg, bar);
            __builtin_amdgcn_fence(__ATOMIC_ACQUIRE, "agent");
            xb_add(&bar[XB_XGEN(b.x)], 1u);
            asm volatile("s_waitcnt vmcnt(0)" ::: "memory");
        } else {
            XB_SPIN(xb_ld(&bar[XB_XGEN(b.x)]) == gen, bar);
            __builtin_amdgcn_fence(__ATOMIC_ACQUIRE, "agent");
            asm volatile("s_waitcnt vmcnt(0)" ::: "memory");
        }
    }
    __syncthreads();
}
#define GRID_SYNC() do { XcdBarrier xb_; xb_.bar = (unsigned*)(ws + WS_BAR); xb_.x = xb_xcc_id(); xb_.st = (volatile PG8_LAS unsigned*)(lds + 131072); xcd_barrier(xb_); } while (0)
__global__ void __launch_bounds__(512, 2) fwd_megakernel(Params Pk_unused) {
#define P kp_fresh()
    extern __shared__ __attribute__((aligned(16))) unsigned char shm[];
    LAS unsigned char* lds = (LAS unsigned char*)shm;
    cg::grid_group grid = cg::this_grid();
#define ws (P->ws)
    const int nth = gridDim.x * 512;
#define GTID ((int)blockIdx.x * 512 + opaque_tid())
#define H ((bf16_t*)(ws + WS_H))
#define ACT ((bf16_t*)(ws + WS_ACT))
#define X (P->out)
#define CS ((float*)(ws + WS_CS))
    grid.sync();
    { volatile PG8_LAS unsigned* st = (volatile PG8_LAS unsigned*)(lds + 131072); if (threadIdx.x == 0) { st[0] = 0u; st[1] = 0u; } __syncthreads();
      (void)xcd_barrier_post((unsigned*)(ws + WS_BAR), st); }

    {
    { const float *w1 = P->ffn1_w1, *w3 = P->ffn1_w3, *w2 = P->ffn1_w2;
      conv_w((bf16_t*)(ws + W_UP1), 5632, 1024, [=](int R, int k) { return ((R & 128) ? w3 : w1)[(size_t)k * DFF + swiglu_col(R)]; }, lds);
      conv_w((bf16_t*)(ws + W_DN1), 1024, 2816, [=](int R, int k) { return w2[(size_t)k * 1024 + perm_col(R, false)]; }, lds); }
    { const float *w1 = P->ffn2_w1, *w3 = P->ffn2_w3, *w2 = P->ffn2_w2, *gn = P->ffn2_norm;
      conv_w((bf16_t*)(ws + W_UP2), 5632, 1024, [=](int R, int k) { return gn[k] * ((R & 128) ? w3 : w1)[(size_t)k * DFF + swiglu_col(R)]; }, lds);
      conv_w((bf16_t*)(ws + W_DN2), 1024, 2816, [=](int R, int k) { return w2[(size_t)k * 1024 + perm_col(R, false)]; }, lds); }
    { const float *wi = P->w_in, *gn = P->mix_norm;
      conv_w((bf16_t*)(ws + W_INLO), 2816, 1024, [=](int R, int k) { return gn[k] * wi[(size_t)k * PCOLS + perm_col(R, R < 1024)]; }, lds);
      conv_w((bf16_t*)(ws + W_GATE), 3072, 1024, [=](int R, int k) { return gn[k] * wi[(size_t)k * PCOLS + 2816 + perm_col(R, false)]; }, lds); }
    { const float *ua = P->w_up_a, *ub = P->w_up_b, *uc = P->w_up_c, *wo = P->w_out, *mk = P->w_mem_kv;
      conv_w((bf16_t*)(ws + W_UPA), 1024, 1024, [=](int R0, int k) { const int R = perm_col(R0, false); return k < 512 ? ua[(size_t)k * 1024 + R] : (k < 768 ? ub[(size_t)(k - 512) * 1024 + R] : uc[(size_t)(k - 768) * 1024 + R]); }, lds);
      conv_w((bf16_t*)(ws + W_OUT), 1024, 1024, [=](int R, int k) { return wo[(size_t)k * 1024 + perm_col(R, false)]; }, lds);
      conv_w((bf16_t*)(ws + W_MKV), 512, 1024, [=](int R, int k) { return mk[(size_t)k * 512 + perm_col(R, false)]; }, lds); }
    { const float *w2 = P->rw_w2, *a2 = P->rw_a2, *g2 = P->rw_g2;
      conv_w((bf16_t*)(ws + W_LR), 768, 256, [=](int R, int k) { float v = 0.f;
          if (R < 256) { if (k < 64) v = w2[k * 256 + R]; }
          else if (R < 512) { if (k >= 64 && k < 128) v = a2[(k - 64) * 256 + (R - 256)]; }
          else { if (k >= 128) v = g2[(k - 128) * 256 + (R - 512)]; }
          return v; }, lds); }
    for (int idx = GTID; idx < 2 * T; idx += nth) ((float*)(ws + WS_SS1))[idx] = 0.f;
    norm_rows(P->x, P->ffn1_norm, H, nullptr, T);
    norm_rows(P->mem, P->mem_norm, (bf16_t*)(ws + WS_HM), nullptr, MEMT);
    for (int idx = GTID; idx < T * 8; idx += nth) {
        const int t = idx >> 3, i = idx & 7;
        const float ang = (float)P->pos[t] * INVF[i];
        const double rev = (double)ang * 0.15915494309189535; const double fr = rev - rint(rev); const double rr = fr * 6.283185307179586, r2 = rr * rr;
        double cterm = 1.0, sterm = rr, cc = 1.0, sn = rr;
#pragma unroll
        for (int k = 1; k <= 14; ++k) { cterm *= -r2 * (1.0 / ((2.0 * k - 1.0) * (2.0 * k))); sterm *= -r2 * (1.0 / ((2.0 * k) * (2.0 * k + 1.0))); cc += cterm; sn += sterm; }
        CS[idx * 2] = (float)cc; CS[idx * 2 + 1] = (float)sn;
    }
    GRID_SYNC();
    { EpiSwiglu e; e.act = ACT; e.rowss = nullptr; e.tlast = 14; run_gemm(lds, H, (const bf16_t*)(ws + W_UP1), T, 5632, 1024, e); }
    GRID_SYNC();
    { EpiRes<true, false, false, true> e; e.resf = P->x; e.resb = nullptr; e.outf = nullptr; e.outb = H; e.rowss = (float*)(ws + WS_SS1); run_gemm(lds, ACT, (const bf16_t*)(ws + W_DN1), T, 1024, 2816, e); }
    GRID_SYNC();
    { EpiPerm e; e.O = ACT; e.ld = PLO; e.cs = CS; e.rowss = (const float*)(ws + WS_SS1); e.tlast = 14; run_gemm(lds, H, (const bf16_t*)(ws + W_INLO), T, 2816, 1024, e); }
    GRID_SYNC();
    { EpiPerm e; e.O = (bf16_t*)(ws + WS_KVM); e.ld = 512; e.cs = nullptr; e.rowss = nullptr; e.tlast = 14; run_gemm(lds, (const bf16_t*)(ws + WS_HM), (const bf16_t*)(ws + W_MKV), MEMT, 512, 1024, e); }
    { bf16_t* alr = (bf16_t*)(ws + WS_ALR);
      if (blockIdx.x >= 32) for (int idx = ((int)blockIdx.x - 32) * 512 + opaque_tid(); idx < T * 32; idx += ((int)gridDim.x - 32) * 512) {
          const int t = idx >> 5, col = (idx & 31) * 8;
          const bf16_t* up = ACT + (size_t)t * PLO + 1536 + 768 + col;
          const u32x4 cur = *(const u32x4*)up; u32x4 prv = {0u, 0u, 0u, 0u}; if ((t & (SEQ - 1)) != 0) prv = *(const u32x4*)(up - PLO);
          const f32x4 m0 = *(const f32x4*)(P->rw_mu + 768 + col), m1 = *(const f32x4*)(P->rw_mu + 768 + col + 4);
          float v[8];
#pragma unroll
          for (int e = 0; e < 8; ++e) { const float cu = (e & 1) ? bfhi(cur[e >> 1]) : bflo(cur[e >> 1]), pv = (e & 1) ? bfhi(prv[e >> 1]) : bflo(prv[e >> 1]);
              const float mu = e < 4 ? m0[e & 3] : m1[e & 3]; const float xs = cu + (pv - cu) * mu;
              v[e] = col < 64 ? (1.0f - 2.0f * fast_rcp(__expf(2.0f * xs) + 1.0f)) : (col < 128 ? xs : sigmoidf_(xs)); }
          u32x4 w; w.x = cvt_pk_bf16(v[0], v[1]); w.y = cvt_pk_bf16(v[2], v[3]); w.z = cvt_pk_bf16(v[4], v[5]); w.w = cvt_pk_bf16(v[6], v[7]);
          *(u32x4*)(alr + (size_t)t * 256 + col) = w; } }
    GRID_SYNC();
    { EpiLR e; e.dec = (float*)(ws + WS_DEC); e.asg = (bf16_t*)(ws + WS_ASG); e.gg = (bf16_t*)(ws + WS_GG); e.w0 = P->rw_w0; e.a0 = P->rw_a0;
      run_gemm(lds, (const bf16_t*)(ws + WS_ALR), (const bf16_t*)(ws + W_LR), T, 768, 256, e); }
    GRID_SYNC();
    if ((int)blockIdx.x < NSCAN) rwkv_scan(P, lds, blockIdx.x);
    attention_phase(P, lds);
    GRID_SYNC();
    rwkv_post(P);
    GRID_SYNC();
    { EpiSig e; e.G = (bf16_t*)(ws + WS_ACT); e.bias = P->gate_bias; e.rowss = (const float*)(ws + WS_SS1); e.tlast = 14; run_gemm(lds, H, (const bf16_t*)(ws + W_GATE), T, 3072, 1024, e); }
    GRID_SYNC();
    { EpiMix e; e.G = (const bf16_t*)(ws + WS_ACT); e.merged = (bf16_t*)(ws + WS_DEC); run_gemm(lds, (const bf16_t*)(ws + WS_OA), (const bf16_t*)(ws + W_UPA), T, 1024, 1024, e); }
    GRID_SYNC();
    { EpiRes<false, true, false, true> e; e.resf = nullptr; e.resb = H; e.outf = nullptr; e.outb = H; e.rowss = (float*)(ws + WS_SS2); run_gemm(lds, (const bf16_t*)(ws + WS_DEC), (const bf16_t*)(ws + W_OUT), T, 1024, 1024, e); }
    GRID_SYNC();
    { EpiSwiglu e; e.act = ACT; e.rowss = (const float*)(ws + WS_SS2); e.tlast = 14; run_gemm(lds, H, (const bf16_t*)(ws + W_UP2), T, 5632, 1024, e); }
    GRID_SYNC();
    { EpiRes<true, true, false, false> e; e.resf = nullptr; e.resb = H; e.outf = nullptr; e.outb = H; e.rowss = nullptr; run_gemm(lds, ACT, (const bf16_t*)(ws + W_DN2), T, 1024, 2816, e); }
    GRID_SYNC();
    norm_rows_b(H, P->final_norm, X, T);
    }
}

#undef P
#undef ws
#undef H
#undef ACT
#undef X
#undef CS
#undef GTID
extern "C" void kernel_launch(void* const* d_in, const int* in_sizes, int n_in, void* d_out, int out_size, void* d_ws, size_t ws_size, hipStream_t stream) {
    constexpr int LDS_BYTES = 131072 + 256;
    static int grid_blocks = 0;
    if (grid_blocks == 0) {
        if (n_in != 37 || ws_size < WS_END) { fprintf(stderr, "kernel_launch: unexpected inputs (n_in %d, ws %zu, need %zu)\n", n_in, ws_size, (size_t)WS_END); grid_blocks = -1; return; }
        int dev = 0, cus = 0, per_cu = 0;
        hipGetDevice(&dev);
        hipDeviceGetAttribute(&cus, hipDeviceAttributeMultiprocessorCount, dev);
        hipFuncSetAttribute((const void*)fwd_megakernel, hipFuncAttributeMaxDynamicSharedMemorySize, LDS_BYTES);
        hipOccupancyMaxActiveBlocksPerMultiprocessor(&per_cu, (const void*)fwd_megakernel, 512, LDS_BYTES);
        if (per_cu < 1) per_cu = 1;
        grid_blocks = cus * per_cu;
        (void)hipGetLastError();
    }
    if (grid_blocks < 0) return;
    hipMemsetAsync((unsigned char*)d_ws + WS_BAR, 0, 16384 + 2048, stream);
    Params p{};
    p.x = (const float*)d_in[0]; p.mem = (const float*)d_in[1]; p.pos = (const int*)d_in[2];
    p.ffn1_norm = (const float*)d_in[3]; p.ffn1_w1 = (const float*)d_in[4]; p.ffn1_w3 = (const float*)d_in[5]; p.ffn1_w2 = (const float*)d_in[6];
    p.mix_norm = (const float*)d_in[7]; p.w_in = (const float*)d_in[8]; p.gate_bias = (const float*)d_in[9];
    p.lq1 = (const float*)d_in[10]; p.lk1 = (const float*)d_in[11]; p.lq2 = (const float*)d_in[12]; p.lk2 = (const float*)d_in[13]; p.subln = (const float*)d_in[14];
    p.rw_mu = (const float*)d_in[15]; p.rw_w0 = (const float*)d_in[16]; p.rw_w2 = (const float*)d_in[17]; p.rw_a0 = (const float*)d_in[18]; p.rw_a2 = (const float*)d_in[19];
    p.rw_g2 = (const float*)d_in[20]; p.rw_k_k = (const float*)d_in[21]; p.rw_k_a = (const float*)d_in[22]; p.rw_r_k = (const float*)d_in[23];
    p.rw_ln_w = (const float*)d_in[24]; p.rw_ln_b = (const float*)d_in[25];
    p.mem_norm = (const float*)d_in[26]; p.w_mem_kv = (const float*)d_in[27]; p.w_up_a = (const float*)d_in[28]; p.w_up_b = (const float*)d_in[29]; p.w_up_c = (const float*)d_in[30];
    p.w_out = (const float*)d_in[31]; p.ffn2_norm = (const float*)d_in[32]; p.ffn2_w1 = (const float*)d_in[33]; p.ffn2_w3 = (const float*)d_in[34]; p.ffn2_w2 = (const float*)d_in[35];
    p.final_norm = (const float*)d_in[36];
    p.out = (float*)d_out; p.ws = (unsigned char*)d_ws;
    void* args[] = {&p};
    hipError_t e = hipLaunchCooperativeKernel((const void*)fwd_megakernel, dim3(grid_blocks), dim3(512), args, LDS_BYTES, stream);
    if (e != hipSuccess) fprintf(stderr, "cooperative launch failed: %s (grid %d)\n", hipGetErrorString(e), grid_blocks);
}
```

```cpp
#include <hip/hip_runtime.h>
#include <hip/hip_cooperative_groups.h>
#include <cstdio>
namespace pg8 {
#define PG8_LAS __attribute__((address_space(3)))
typedef unsigned short bf16_t;
typedef short bf16x8 __attribute__((ext_vector_type(8)));
typedef float f32x4 __attribute__((ext_vector_type(4)));
typedef unsigned u32x4 __attribute__((ext_vector_type(4)));
constexpr int BM = 256, BK = 64, HALF = 128, HTB = HALF * BK * 2  , STAGE_BYTES = 8 * HTB, NXCD = 8, WGM = 8;

__host__ __device__ __forceinline__ int lds_byte(int r, int c) { const int st = (r >> 4) * 2 + (c >> 5), rr = r & 15, cc = c & 31, ob = rr * 64 + cc * 2; return st * 1024 + (ob ^ (((ob >> 9) & 1) << 5)); }
__host__ __device__ __forceinline__ void stage_rc(int b, int& R, int& C) { const int st = b / 1024, sb = b % 1024, swz = sb ^ (((sb >> 9) & 1) << 5); R = (st >> 1) * 16 + swz / 64; C = (st & 1) * 32 + (swz % 64) / 2; }
__host__ __device__ __forceinline__ int perm32(int rho) { const int n = rho >> 4, i = rho & 15; return 8 * (i >> 2) + 4 * n + (i & 3); }

struct Unit { int pm, pn; };
struct Gemm { const bf16_t* A; const bf16_t* Bt; int M, N, K; };

struct StaticOrder {
    int nM, nN, nwg, G, c;
    __host__ __device__ void init(int M, int N, int G_, int c_) { nM = M / BM; nN = N / BM; nwg = nM * nN; G = G_; c = c_; }
    __host__ __device__ bool next(int i, Unit& u) const {
        const long L = (long)i * G + c; if (L >= nwg) return false;
        int wgid = (int)L; { const int q = nwg / NXCD, r = nwg % NXCD, xcd = wgid % NXCD, off = wgid / NXCD; wgid = (xcd < r ? xcd * (q + 1) : r * (q + 1) + (xcd - r) * q) + off; }
        const int nig = WGM * nN, gid = wgid / nig, fm = gid * WGM, gsz = (nM - fm) < WGM ? (nM - fm) : WGM;
        u.pm = fm + ((wgid % nig) % gsz); u.pn = (wgid % nig) / gsz; return true;
    }
    __device__ __forceinline__ void a_ready(const Unit&) const {}
    __device__ __forceinline__ void done(const Unit&) const {}
};
typedef float f32x2_c __attribute__((ext_vector_type(2))); typedef __bf16 bf16x2_c __attribute__((ext_vector_type(2)));
__device__ __forceinline__ unsigned cvt_pk_bf16(float lo, float hi) { const f32x2_c v = {lo, hi}; const bf16x2_c b = __builtin_convertvector(v, bf16x2_c); return __builtin_bit_cast(unsigned, b); }
template <class Epi, class Sched, bool STAMP = false>
__device__ __forceinline__ void gemm_phase(PG8_LAS unsigned char* lds, const Gemm g, const Sched& S, const Epi& E, unsigned long long* stamps) {
    int tid_l = threadIdx.x; asm volatile("" : "+v"(tid_l)); const int tid = tid_l, wid = __builtin_amdgcn_readfirstlane(tid >> 6), lane = tid & 63, wr = wid >> 2, wc = wid & 3, fr = lane & 15, fq = lane >> 4;
    const int K = g.K, nt = K / BK;
    int ts_lo = 0, ts_hi = 0, nts = 0; const unsigned long long rt_entry = STAMP ? (unsigned long long)wall_clock64() : 0ull;
#define PG8_STAMP() do { if (STAMP && wid == 0 && nts < 64) { const unsigned long long _c = (unsigned long long)clock64(); \
        ts_lo = (lane == nts) ? (int)(unsigned)_c : ts_lo; ts_hi = (lane == nts) ? (int)(unsigned)(_c >> 32) : ts_hi; ++nts; } } while (0)
    PG8_STAMP();
    unsigned voffA[2], voffB[2];
#pragma unroll
    for (int i = 0; i < 2; ++i) { int R, C; stage_rc(tid * 16 + i * 8192, R, C); const int Rb = Epi::PERM ? ((R & ~31) + perm32(R & 31)) : R;
        voffA[i] = (unsigned)(R * K + C) * 2u; voffB[i] = (unsigned)(Rb * K + C) * 2u; }
    const size_t kstep = (size_t)(BK * 2);
    const size_t hstep = (size_t)HALF * K * 2;
    const size_t tstep = 2 * hstep;
    const unsigned ldsw = (unsigned)wid * 1024u;
    const int aoff = lds_byte(wr * 64 + fr, fq * 8), boff = lds_byte(wc * 32 + fr, fq * 8);
#define PG8_SA(b, h) (((b) * 2 + (h)) * HTB)
#define PG8_SB(b, h) ((4 + (b) * 2 + (h)) * HTB)
#define PG8_STAGE(bufoff, gbase, voff) do { _Pragma("unroll") for (int _i = 0; _i < 2; ++_i) \
        __builtin_amdgcn_global_load_lds((const unsigned*)((const char*)(gbase) + (voff)[_i]), (PG8_LAS unsigned*)(lds + (bufoff) + ldsw + _i * 8192), 16, 0, 0); } while (0)
#define PG8_LDA(dst, b, h) do { _Pragma("unroll") for (int m = 0; m < 4; ++m) _Pragma("unroll") for (int k = 0; k < 2; ++k) dst[m][k] = *(const PG8_LAS bf16x8*)(lds + PG8_SA(b, h) + aoff + m * 2048 + k * 1024); } while (0)
#define PG8_LDB(dst, b, h) do { _Pragma("unroll") for (int n = 0; n < 2; ++n) _Pragma("unroll") for (int k = 0; k < 2; ++k) dst[n][k] = *(const PG8_LAS bf16x8*)(lds + PG8_SB(b, h) + boff + n * 2048 + k * 1024); } while (0)
#define PG8_MMA(ai, bj, At, Bt) do { __builtin_amdgcn_s_setprio(1); _Pragma("unroll") for (int m = 0; m < 4; ++m) _Pragma("unroll") for (int n = 0; n < 2; ++n) _Pragma("unroll") for (int k = 0; k < 2; ++k) \
        acc[ai][bj][m][n] = __builtin_amdgcn_mfma_f32_16x16x32_bf16(Bt[n][k], At[m][k], acc[ai][bj][m][n], 0, 0, 0); __builtin_amdgcn_s_setprio(0); } while (0)
#define PG8_WAIT_V(n) asm volatile("s_waitcnt vmcnt(" #n ")" ::: "memory")
#define PG8_WAIT_L(n) asm volatile("s_waitcnt lgkmcnt(" #n ")" ::: "memory")
#define PG8_BAR __builtin_amdgcn_s_barrier()
#define PG8_SCHED __builtin_amdgcn_sched_barrier(0)
    Unit cur, nxt; int ui = 0;
    if (!S.next(0, cur)) return;
    f32x4 acc[2][2][4][2];
#pragma unroll
    for (int a = 0; a < 2; ++a)
#pragma unroll
        for (int b = 0; b < 2; ++b)
#pragma unroll
            for (int m = 0; m < 4; ++m)
#pragma unroll
                for (int n = 0; n < 2; ++n) acc[a][b][m][n] = (f32x4){0.f, 0.f, 0.f, 0.f};
    bf16x8 At[4][2], B0[2][2], B1[2][2];
    const char* cA = (const char*)g.A + (size_t)cur.pm * tstep; const char* cB = (const char*)g.Bt + (size_t)cur.pn * tstep;
    S.a_ready(cur);
    PG8_STAGE(PG8_SB(0, 0), cB, voffB); PG8_STAGE(PG8_SA(0, 0), cA, voffA); PG8_STAGE(PG8_SB(0, 1), cB + hstep, voffB); PG8_STAGE(PG8_SA(0, 1), cA + hstep, voffA);
    if (wr == 1) PG8_BAR;
    PG8_WAIT_V(4); PG8_BAR;
    PG8_STAGE(PG8_SB(1, 0), cB + kstep, voffB); PG8_STAGE(PG8_SA(1, 0), cA + kstep, voffA); PG8_STAGE(PG8_SB(1, 1), cB + hstep + kstep, voffB);
    PG8_WAIT_V(6); PG8_BAR;
    PG8_STAMP();
    for (;;) {
        const bool has_next = S.next(ui + 1, nxt);
        const char* nA = has_next ? (const char*)g.A + (size_t)nxt.pm * tstep : cA; const char* nB = has_next ? (const char*)g.Bt + (size_t)nxt.pn * tstep : cB;
        for (int t = 0; t < nt; t += 2) {
            const bool last = (t == nt - 2);
            const char* a1 = cA + (size_t)(t + 1) * kstep;
            const char* a2 = last ? nA : cA + (size_t)(t + 2) * kstep; const char* b2 = last ? nB : cB + (size_t)(t + 2) * kstep;
            const char* a3 = a2 + kstep; const char* b3 = b2 + kstep;
            if (last && has_next) S.a_ready(nxt);
            if constexpr (Epi::MID) E.mid(acc, cur, t, wr, wc, fr, fq);
            PG8_LDB(B0, 0, 0); PG8_SCHED; PG8_LDA(At, 0, 0); PG8_STAGE(PG8_SA(1, 1), a1 + hstep, voffA);
            PG8_WAIT_L(8); PG8_BAR; PG8_WAIT_L(0); PG8_MMA(0, 0, At, B0); PG8_BAR; PG8_SCHED;
            PG8_LDB(B1, 0, 1); PG8_STAGE(PG8_SB(0, 0), b2, voffB);
            PG8_BAR; PG8_WAIT_L(0); PG8_MMA(0, 1, At, B1); PG8_BAR;
            PG8_LDA(At, 0, 1); PG8_STAGE(PG8_SA(0, 0), a2, voffA);
            PG8_BAR; PG8_WAIT_L(0); PG8_MMA(1, 0, At, B0); PG8_BAR; PG8_SCHED;
            PG8_STAGE(PG8_SB(0, 1), b2 + hstep, voffB);
            PG8_WAIT_V(6); PG8_BAR; PG8_MMA(1, 1, At, B1); PG8_BAR;
            PG8_LDB(B0, 1, 0); PG8_SCHED; PG8_LDA(At, 1, 0); PG8_STAGE(PG8_SA(0, 1), a2 + hstep, voffA);
            PG8_WAIT_L(8); PG8_BAR; PG8_WAIT_L(0); PG8_MMA(0, 0, At, B0); PG8_BAR; PG8_SCHED;
            PG8_LDB(B1, 1, 1); PG8_STAGE(PG8_SB(1, 0), b3, voffB);
            PG8_BAR; PG8_WAIT_L(0); PG8_MMA(0, 1, At, B1); PG8_BAR;
            PG8_LDA(At, 1, 1); PG8_STAGE(PG8_SA(1, 0), a3, voffA);
            PG8_BAR; PG8_WAIT_L(0); PG8_MMA(1, 0, At, B0); PG8_BAR; PG8_SCHED;
            PG8_STAGE(PG8_SB(1, 1), b3 + hstep, voffB);
            PG8_WAIT_V(6); PG8_BAR; PG8_MMA(1, 1, At, B1); PG8_BAR;
        }
        PG8_STAMP();
        if constexpr (!Epi::AFTER_DRAIN) { E(acc, cur, wr, wc, fr, fq); S.done(cur); }
        PG8_STAMP();
        if (!has_next) break;
#pragma unroll
        for (int a = 0; a < 2; ++a)
#pragma unroll
            for (int b = 0; b < 2; ++b)
#pragma unroll
                for (int m = 0; m < 4; ++m)
#pragma unroll
                    for (int n = 0; n < 2; ++n) acc[a][b][m][n] = (f32x4){0.f, 0.f, 0.f, 0.f};
        cur = nxt; cA = nA; cB = nB; ++ui;
    }
    PG8_WAIT_V(0);
    if (wr == 0) PG8_BAR;
    PG8_BAR;
    if constexpr (Epi::AFTER_DRAIN) { E.fused(acc, cur, wr, wc, fr, fq, lds, wid, lane); S.done(cur); }
    PG8_STAMP();
    if (STAMP && wid == 0) { stamps[lane] = lane < nts ? (((unsigned long long)(unsigned)ts_hi << 32) | (unsigned)ts_lo) : 0ull;
        if (lane == 62) stamps[62] = rt_entry; if (lane == 63) stamps[63] = (unsigned long long)wall_clock64(); }
#undef PG8_STAMP
#undef PG8_SA
#undef PG8_SB
#undef PG8_STAGE
#undef PG8_LDA
#undef PG8_LDB
#undef PG8_MMA
#undef PG8_WAIT_V
#undef PG8_WAIT_L
#undef PG8_BAR
#undef PG8_SCHED
}
}
namespace cg = cooperative_groups;
using pg8::bf16_t; using pg8::bf16x8; using pg8::f32x4; using pg8::cvt_pk_bf16; using pg8::Unit; using pg8::Gemm; using pg8::StaticOrder;
typedef unsigned u32x2 __attribute__((ext_vector_type(2)));
typedef unsigned u32x4 __attribute__((ext_vector_type(4)));
#define LAS PG8_LAS

constexpr int T = 65536, SEQ = 4096, DM = 1024, DFF = 2816, PCOLS = 5888, PLO = 2816, MEMT = 4096;
constexpr int NSCAN = 128;

constexpr size_t W_UP1 = 0;
constexpr size_t W_DN1 = W_UP1 + (size_t)5632 * 1024 * 2;
constexpr size_t W_UP2 = W_DN1 + (size_t)1024 * 2816 * 2;
constexpr size_t W_DN2 = W_UP2 + (size_t)5632 * 1024 * 2;
constexpr size_t W_INLO = W_DN2 + (size_t)1024 * 2816 * 2;
constexpr size_t W_GATE = W_INLO + (size_t)2816 * 1024 * 2;
constexpr size_t W_UPA = W_GATE + (size_t)3072 * 1024 * 2;
constexpr size_t W_UPB = W_UPA + (size_t)1024 * 512 * 2;
constexpr size_t W_UPC = W_UPB + (size_t)1024 * 256 * 2;
constexpr size_t W_OUT = W_UPC + (size_t)1024 * 256 * 2;
constexpr size_t W_MKV = W_OUT + (size_t)1024 * 1024 * 2;
constexpr size_t W_LR = W_MKV + (size_t)512 * 1024 * 2;
constexpr size_t WS_ACT = W_LR + (size_t)768 * 256 * 2;
constexpr size_t WS_ALR = WS_ACT + (size_t)T * 2816 * 2;
constexpr size_t WS_H = WS_ALR + (size_t)T * 256 * 2;
constexpr size_t WS_DEC = WS_H + (size_t)T * 1024 * 2;
constexpr size_t WS_ASG = WS_DEC + (size_t)T * 256 * 4;
constexpr size_t WS_GG = WS_ASG + (size_t)T * 256 * 2;
constexpr size_t WS_OA = WS_GG + (size_t)T * 256 * 2;
constexpr size_t WS_OB = WS_OA + (size_t)T * 512 * 2;
constexpr size_t WS_OC = WS_OB + (size_t)T * 256 * 2;
constexpr size_t WS_CS = WS_OC + (size_t)T * 256 * 2;
constexpr size_t WS_HM = WS_CS + (size_t)T * 16 * 4;
constexpr size_t WS_KVM = WS_HM + (size_t)MEMT * 1024 * 2;
constexpr size_t WS_BAR = WS_KVM + (size_t)MEMT * 512 * 2;
constexpr size_t WS_QCTR = WS_BAR + 16384;
constexpr size_t WS_SS1 = WS_BAR + 16384 + 2048;
constexpr size_t WS_SS2 = WS_SS1 + (size_t)T * 4;
constexpr size_t WS_YRAW = WS_SS2 + (size_t)T * 4;
constexpr size_t WS_END = WS_YRAW + (size_t)T * 256 * 4;

struct Params {
    const float* x; const float* mem; const int* pos;
    const float *ffn1_norm, *ffn1_w1, *ffn1_w3, *ffn1_w2, *mix_norm, *w_in, *gate_bias;
    const float *lq1, *lk1, *lq2, *lk2, *subln;
    const float *rw_mu, *rw_w0, *rw_w2, *rw_a0, *rw_a2, *rw_g2, *rw_k_k, *rw_k_a, *rw_r_k, *rw_ln_w, *rw_ln_b;
    const float *mem_norm, *w_mem_kv, *w_up_a, *w_up_b, *w_up_c, *w_out;
    const float *ffn2_norm, *ffn2_w1, *ffn2_w3, *ffn2_w2, *final_norm;
    float* out; unsigned char* ws;
};

typedef const __attribute__((address_space(4))) Params* KP;
__device__ __forceinline__ KP kp_fresh() { KP p = (KP)__builtin_amdgcn_kernarg_segment_ptr(); asm volatile("" : "+s"(p)); return p; }

__constant__ float INVF[8] = {1.0f, 0.1939227432012558f, 0.03760603070259094f, 0.007292664609849453f, 0.0014142135623842478f,
                              0.00027424818836152554f, 5.3182957344688475e-05f, 1.0313385246263351e-05f};

__device__ __forceinline__ float bf2f(bf16_t b) { return __uint_as_float(((unsigned)b) << 16); }
__device__ __forceinline__ float bflo(unsigned w) { return __uint_as_float(w << 16); }
__device__ __forceinline__ float bfhi(unsigned w) { return __uint_as_float(w & 0xffff0000u); }
__device__ __forceinline__ bf16_t f2bf(float f) { return (bf16_t)(cvt_pk_bf16(f, 0.f) & 0xffffu); }
__device__ __forceinline__ f32x4 unpk4(u32x2 w) { f32x4 r; r[0] = bflo(w.x); r[1] = bfhi(w.x); r[2] = bflo(w.y); r[3] = bfhi(w.y); return r; }
__device__ __forceinline__ float xquad_max(float x) {
    auto a = __builtin_amdgcn_permlane32_swap(__float_as_uint(x), __float_as_uint(x), false, false);
    const float m = fmaxf(__uint_as_float(a[0]), __uint_as_float(a[1]));
    auto b = __builtin_amdgcn_permlane16_swap(__float_as_uint(m), __float_as_uint(m), false, false);
    return fmaxf(__uint_as_float(b[0]), __uint_as_float(b[1]));
}
__device__ __forceinline__ float xquad_sum(float x) {
    auto a = __builtin_amdgcn_permlane32_swap(__float_as_uint(x), __float_as_uint(x), false, false);
    const float m = __uint_as_float(a[0]) + __uint_as_float(a[1]);
    auto b = __builtin_amdgcn_permlane16_swap(__float_as_uint(m), __float_as_uint(m), false, false);
    return __uint_as_float(b[0]) + __uint_as_float(b[1]);
}
__device__ __forceinline__ float fast_rcp(float x) { return __builtin_amdgcn_rcpf(x); }
__device__ __forceinline__ float sigmoidf_(float x) { return fast_rcp(1.0f + __expf(-x)); }
__device__ __forceinline__ int opaque_tid() { int t = threadIdx.x; asm volatile("" : "+v"(t)); return t; }
#define DPP_F(v, ctrl) __int_as_float(__builtin_amdgcn_update_dpp(0, __float_as_int(v), ctrl, 0xF, 0xF, true))
__device__ __forceinline__ float wave_sum(float v) { v += DPP_F(v, 0xB1); v += DPP_F(v, 0x4E); v += DPP_F(v, 0x141); v += DPP_F(v, 0x140); return xquad_sum(v); }
__device__ __forceinline__ float red8(float v) { v += DPP_F(v, 0xB1); v += DPP_F(v, 0x4E); v += DPP_F(v, 0x141); return v; }

template <class F>
__device__ __forceinline__ void conv_w(bf16_t* dst, int N, int K, F src, LAS unsigned char* lds) {
    LAS float* tl = (LAS float*)lds;
    const int tid = opaque_tid(), kt = K >> 6, ntiles = (N >> 6) * kt;
    float cur[8];
    int tile = blockIdx.x;
    if (tile < ntiles) { const int R0 = (tile / kt) * 64, k0 = (tile % kt) * 64;
#pragma unroll
        for (int j = 0; j < 8; ++j) { const int e = tid + 512 * j; cur[j] = src(R0 + (e & 63), k0 + (e >> 6)); } }
    for (; tile < ntiles; tile += gridDim.x) {
        const int R0 = (tile / kt) * 64, k0 = (tile % kt) * 64;
#pragma unroll
        for (int j = 0; j < 8; ++j) { const int e = tid + 512 * j; tl[(e & 63) * 65 + (e >> 6)] = cur[j]; }
        const int nt2 = tile + gridDim.x;
        if (nt2 < ntiles) { const int R1 = (nt2 / kt) * 64, k1 = (nt2 % kt) * 64;
#pragma unroll
            for (int j = 0; j < 8; ++j) { const int e = tid + 512 * j; cur[j] = src(R1 + (e & 63), k1 + (e >> 6)); } }
        __syncthreads();
        { const int r = tid >> 3, k8 = (tid & 7) * 8; LAS const float* p = tl + r * 65 + k8;
          u32x4 w; w.x = cvt_pk_bf16(p[0], p[1]); w.y = cvt_pk_bf16(p[2], p[3]); w.z = cvt_pk_bf16(p[4], p[5]); w.w = cvt_pk_bf16(p[6], p[7]);
          *(u32x4*)(dst + (size_t)(R0 + r) * K + k0 + k8) = w; }
        __syncthreads();
    }
}
__device__ __forceinline__ int perm_col(int R, bool rope) {
    const int Gb = R & ~31, rho = R & 31, n = rho >> 4, fq = (rho >> 2) & 3, e = rho & 3;
    int d;
    if (rope && (Gb & 32) == 0) d = fq < 2 ? 4 * fq + 8 * n + e : 16 + (fq - 2) * 8 + 4 * n + e;
    else d = 8 * fq + 4 * n + e;
    return Gb + d;
}

__device__ __forceinline__ int swiglu_col(int R) { const int pn = R >> 8, wcg = (R >> 5) & 3, rho = R & 31; return pn * 128 + wcg * 32 + 8 * ((rho >> 2) & 3) + 4 * (rho >> 4) + (rho & 3); }

__device__ __forceinline__ void norm_rows(const float* in, const float* gain, bf16_t* outb, float* outf, int rows) {
    const int tid = opaque_tid(), wave = tid >> 6, lane = tid & 63, stride = gridDim.x * 8;
    int row = blockIdx.x * 8 + wave;
    float4 nx[4];
    if (row < rows) { const float4* p = (const float4*)(in + (size_t)row * 1024);
#pragma unroll
        for (int j = 0; j < 4; ++j) nx[j] = p[j * 64 + lane]; }
    for (; row < rows; row += stride) {
        float4 v[4]; float ss = 0.f;
#pragma unroll
        for (int j = 0; j < 4; ++j) { v[j] = nx[j]; ss += v[j].x * v[j].x + v[j].y * v[j].y + v[j].z * v[j].z + v[j].w * v[j].w; }
        if (row + stride < rows) { const float4* p = (const float4*)(in + (size_t)(row + stride) * 1024);
#pragma unroll
            for (int j = 0; j < 4; ++j) nx[j] = p[j * 64 + lane]; }
        ss = wave_sum(ss);
        const float r = rsqrtf(ss * (1.0f / 1024.0f) + 1e-6f);
#pragma unroll
        for (int j = 0; j < 4; ++j) {
            const float4 g = ((const float4*)gain)[j * 64 + lane];
            float4 y; y.x = v[j].x * r * g.x; y.y = v[j].y * r * g.y; y.z = v[j].z * r * g.z; y.w = v[j].w * r * g.w;
            if (outf) ((float4*)(outf + (size_t)row * 1024))[j * 64 + lane] = y;
            else { u32x2 w; w.x = cvt_pk_bf16(y.x, y.y); w.y = cvt_pk_bf16(y.z, y.w); *(u32x2*)(outb + (size_t)row * 1024 + (j * 64 + lane) * 4) = w; }
        }
    }
}

__device__ __forceinline__ void unpk8(u32x4 w, f32x4& lo, f32x4& hi) { lo[0] = bflo(w.x); lo[1] = bfhi(w.x); lo[2] = bflo(w.y); lo[3] = bfhi(w.y); hi[0] = bflo(w.z); hi[1] = bfhi(w.z); hi[2] = bflo(w.w); hi[3] = bfhi(w.w); }
__device__ __forceinline__ void norm_rows_b(const bf16_t* in, const float* gain, float* outf, int rows) {
    const int tid = opaque_tid(), wave = tid >> 6, lane = tid & 63, stride = gridDim.x * 8;
    int row = blockIdx.x * 8 + wave;
    u32x4 nx[2];
    if (row < rows) { const u32x4* p = (const u32x4*)(in + (size_t)row * 1024); nx[0] = p[lane]; nx[1] = p[64 + lane]; }
    for (; row < rows; row += stride) {
        f32x4 v[4]; float ss = 0.f;
        unpk8(nx[0], v[0], v[1]); unpk8(nx[1], v[2], v[3]);
#pragma unroll
        for (int j = 0; j < 4; ++j) ss += v[j][0] * v[j][0] + v[j][1] * v[j][1] + v[j][2] * v[j][2] + v[j][3] * v[j][3];
        if (row + stride < rows) { const u32x4* p = (const u32x4*)(in + (size_t)(row + stride) * 1024); nx[0] = p[lane]; nx[1] = p[64 + lane]; }
        ss = wave_sum(ss);
        const float r = rsqrtf(ss * (1.0f / 1024.0f) + 1e-6f);
#pragma unroll
        for (int j = 0; j < 2; ++j) { const int c = (j * 64 + lane) * 8;
            const f32x4 g0 = *(const f32x4*)(gain + c), g1 = *(const f32x4*)(gain + c + 4);
            *(f32x4*)(outf + (size_t)row * 1024 + c) = v[2 * j] * r * g0; *(f32x4*)(outf + (size_t)row * 1024 + c + 4) = v[2 * j + 1] * r * g1; }
    }
}

struct EpiSwiglu {
    static constexpr bool PERM = false, AFTER_DRAIN = false, MID = true;
    bf16_t* act; const float* rowss; int tlast; mutable float rsv[8];
    __device__ __forceinline__ void mid(f32x4 (&)[2][2][4][2], const Unit& u, int t, int wr, int wc, int fr, int fq) const {
        if (rowss == nullptr || t != tlast) return;
        const float* rp = rowss + u.pm * 256 + wr * 64 + fr;
#pragma unroll
        for (int i = 0; i < 8; ++i) rsv[i] = rp[(i >> 2) * 128 + (i & 3) * 16];
    }
    __device__ __forceinline__ void operator()(const f32x4 (&acc)[2][2][4][2], const Unit& u, int wr, int wc, int fr, int fq) const {
        const int row0 = u.pm * 256 + wr * 64 + fr;
#pragma unroll
        for (int ai = 0; ai < 2; ++ai)
#pragma unroll
            for (int m = 0; m < 4; ++m) { const int row = row0 + ai * 128 + m * 16; bf16_t* rowp = act + (size_t)row * DFF + u.pn * 128 + wc * 32 + 8 * fq;
                const float rs = rowss ? rsqrtf(rsv[ai * 4 + m] * (1.0f / 1024.0f) + 1e-6f) : 1.0f;
                float o[8];
#pragma unroll
                for (int n = 0; n < 2; ++n) { const f32x4 g = acc[ai][0][m][n] * rs, v = acc[ai][1][m][n] * rs;
#pragma unroll
                    for (int e = 0; e < 4; ++e) o[4 * n + e] = g[e] * fast_rcp(1.0f + __expf(-g[e])) * v[e]; }
                u32x4 w; w.x = cvt_pk_bf16(o[0], o[1]); w.y = cvt_pk_bf16(o[2], o[3]); w.z = cvt_pk_bf16(o[4], o[5]); w.w = cvt_pk_bf16(o[6], o[7]);
                *(u32x4*)rowp = w; }
    }
};
template <bool HALF, bool RESB, bool OUTF, bool STATS> struct EpiRes {
    static constexpr bool PERM = false, AFTER_DRAIN = false, MID = false;
    const float* resf; const bf16_t* resb; float* outf; bf16_t* outb; float* rowss;
    __device__ __forceinline__ void ldres(size_t off, f32x4 (&r)[4]) const {
        if (RESB) { r[0] = __builtin_bit_cast(f32x4, *(const u32x4*)(resb + off)); r[1] = __builtin_bit_cast(f32x4, *(const u32x4*)(resb + off + 128)); }
        else { r[0] = *(const f32x4*)(resf + off); r[1] = *(const f32x4*)(resf + off + 4); r[2] = *(const f32x4*)(resf + off + 128); r[3] = *(const f32x4*)(resf + off + 132); }
    }
    __device__ __forceinline__ void operator()(const f32x4 (&acc)[2][2][4][2], const Unit& u, int wr, int wc, int fr, int fq) const {
        const int row0 = u.pm * 256 + wr * 64 + fr, col0 = u.pn * 256 + wc * 32 + 8 * fq;
        size_t off = (size_t)row0 * 1024 + col0; int row = row0;
        f32x4 cur[4]; ldres(off, cur);
#pragma unroll
        for (int g = 0; g < 8; ++g) {
            const int ai = g >> 2, m = g & 3;
            size_t offn = off + ((m == 3) ? (size_t)80 * 1024 : (size_t)16 * 1024);
            asm volatile("" : "+v"(offn));
            f32x4 nxt[4]; if (g < 7) ldres(offn, nxt);
            float ss = 0.f;
#pragma unroll
            for (int bj = 0; bj < 2; ++bj) { f32x4 r0, r1;
                if (RESB) unpk8(__builtin_bit_cast(u32x4, cur[bj]), r0, r1); else { r0 = cur[2 * bj]; r1 = cur[2 * bj + 1]; }
                const f32x4 v0 = r0 + acc[ai][bj][m][0] * (HALF ? 0.5f : 1.0f), v1 = r1 + acc[ai][bj][m][1] * (HALF ? 0.5f : 1.0f);
                if (OUTF) { *(f32x4*)(outf + off + bj * 128) = v0; *(f32x4*)(outf + off + bj * 128 + 4) = v1; }
                else { u32x4 w; w.x = cvt_pk_bf16(v0[0], v0[1]); w.y = cvt_pk_bf16(v0[2], v0[3]); w.z = cvt_pk_bf16(v1[0], v1[1]); w.w = cvt_pk_bf16(v1[2], v1[3]); *(u32x4*)(outb + off + bj * 128) = w; }
                if (STATS) ss += v0[0] * v0[0] + v0[1] * v0[1] + v0[2] * v0[2] + v0[3] * v0[3] + v1[0] * v1[0] + v1[1] * v1[1] + v1[2] * v1[2] + v1[3] * v1[3]; }
            if (STATS) { ss = xquad_sum(ss); if (fq == 0) atomicAdd(rowss + row, ss); }
            asm volatile("" ::: "memory");
            off = offn; row += (m == 3) ? 80 : 16;
#pragma unroll
            for (int k = 0; k < 4; ++k) cur[k] = nxt[k];
        }
    }
};
struct EpiPerm {
    static constexpr bool PERM = false, AFTER_DRAIN = false, MID = true;
    bf16_t* O; int ld; const float* cs; const float* rowss; int tlast; mutable float rsv[8];
    __device__ __forceinline__ void mid(f32x4 (&)[2][2][4][2], const Unit& u, int t, int wr, int wc, int fr, int fq) const {
        if (rowss == nullptr || t != tlast) return;
        const float* rp = rowss + u.pm * 256 + wr * 64 + fr;
#pragma unroll
        for (int i = 0; i < 8; ++i) rsv[i] = rp[(i >> 2) * 128 + (i & 3) * 16];
    }
    __device__ __forceinline__ void operator()(const f32x4 (&acc)[2][2][4][2], const Unit& u, int wr, int wc, int fr, int fq) const {
        const int row0 = u.pm * 256 + wr * 64 + fr;
        const bool rope = cs != nullptr && u.pn < 4 && (wc & 1) == 0 && fq < 2;
#pragma unroll
        for (int ai = 0; ai < 2; ++ai)
#pragma unroll
            for (int m = 0; m < 4; ++m) { const int row = row0 + ai * 128 + m * 16; bf16_t* rowp = O + (size_t)row * ld;
                f32x4 c4 = {1.f, 1.f, 1.f, 1.f}, s4 = {0.f, 0.f, 0.f, 0.f};
                if (rope) { const float* t = cs + (size_t)row * 16 + fq * 8; const f32x4 a = *(const f32x4*)t, b = *(const f32x4*)(t + 4);
                    c4[0] = a[0]; s4[0] = a[1]; c4[1] = a[2]; s4[1] = a[3]; c4[2] = b[0]; s4[2] = b[1]; c4[3] = b[2]; s4[3] = b[3]; }
                const float rs = rowss ? rsqrtf(rsv[ai * 4 + m] * (1.0f / 1024.0f) + 1e-6f) : 1.0f;
#pragma unroll
                for (int bj = 0; bj < 2; ++bj) { const f32x4 x1 = acc[ai][bj][m][0] * rs, x2 = acc[ai][bj][m][1] * rs;
                    const f32x4 y1 = x1 * c4 - x2 * s4, y2 = x2 * c4 + x1 * s4;
                    u32x4 w; w.x = cvt_pk_bf16(y1[0], y1[1]); w.y = cvt_pk_bf16(y1[2], y1[3]); w.z = cvt_pk_bf16(y2[0], y2[1]); w.w = cvt_pk_bf16(y2[2], y2[3]);
                    *(u32x4*)(rowp + u.pn * 256 + bj * 128 + wc * 32 + 8 * fq) = w; } }
    }
};
struct EpiLR {
    static constexpr bool PERM = false, AFTER_DRAIN = false, MID = false;
    float* dec; bf16_t* asg; bf16_t* gg; const float* w0; const float* a0;
    __device__ __forceinline__ void operator()(const f32x4 (&acc)[2][2][4][2], const Unit& u, int wr, int wc, int fr, int fq) const {
        const int row0 = u.pm * 256 + wr * 64 + fr, col0 = wc * 32 + 4 * fq;
#pragma unroll
        for (int ai = 0; ai < 2; ++ai)
#pragma unroll
            for (int m = 0; m < 4; ++m) { const size_t off = (size_t)(row0 + ai * 128 + m * 16) * 256 + col0;
#pragma unroll
                for (int bj = 0; bj < 2; ++bj)
#pragma unroll
                    for (int n = 0; n < 2; ++n) { const int c = col0 + bj * 128 + n * 16; const size_t o = off + bj * 128 + n * 16; const f32x4 a = acc[ai][bj][m][n];
                        if (u.pn == 0) { const f32x4 b = *(const f32x4*)(w0 + c); f32x4 d;
#pragma unroll
                            for (int e = 0; e < 4; ++e) { const float z = -(b[e] + a[e]);
                                const float sp = fmaxf(z, 0.f) + __logf(1.0f + __expf(-fabsf(z)));
                                d[e] = __expf(-__expf(-sp - 0.5f)); }
                            *(f32x4*)(dec + o) = d; }
                        else if (u.pn == 1) { const f32x4 b = *(const f32x4*)(a0 + c); u32x2 w;
                            w.x = cvt_pk_bf16(sigmoidf_(b[0] + a[0]), sigmoidf_(b[1] + a[1])); w.y = cvt_pk_bf16(sigmoidf_(b[2] + a[2]), sigmoidf_(b[3] + a[3]));
                            *(u32x2*)(asg + o) = w; }
                        else { u32x2 w; w.x = cvt_pk_bf16(a[0], a[1]); w.y = cvt_pk_bf16(a[2], a[3]); *(u32x2*)(gg + o) = w; } } }
    }
};
struct EpiTmp {
    static constexpr bool PERM = false, AFTER_DRAIN = false, MID = false;
    float* tmp;
    __device__ __forceinline__ void operator()(const f32x4 (&acc)[2][2][4][2], const Unit& u, int wr, int wc, int fr, int fq) const {
        const int row0 = u.pm * 256 + wr * 64 + fr, col0 = u.pn * 256 + wc * 32 + 4 * fq;
#pragma unroll
        for (int ai = 0; ai < 2; ++ai)
#pragma unroll
            for (int m = 0; m < 4; ++m) { const size_t off = (size_t)(row0 + ai * 128 + m * 16) * 1024 + col0;
#pragma unroll
                for (int bj = 0; bj < 2; ++bj)
#pragma unroll
                    for (int n = 0; n < 2; ++n) *(f32x4*)(tmp + off + bj * 128 + n * 16) = acc[ai][bj][m][n]; }
    }
};
struct EpiGate {
    static constexpr bool PERM = false, AFTER_DRAIN = false, MID = false;
    const float* tmp; const float* bias; bf16_t* merged; int first;
    __device__ __forceinline__ void operator()(const f32x4 (&acc)[2][2][4][2], const Unit& u, int wr, int wc, int fr, int fq) const {
        const int row0 = u.pm * 256 + wr * 64 + fr, col0 = u.pn * 256 + wc * 32 + 4 * fq;
#pragma unroll
        for (int ai = 0; ai < 2; ++ai)
#pragma unroll
            for (int m = 0; m < 4; ++m) { const size_t off = (size_t)(row0 + ai * 128 + m * 16) * 1024 + col0;
#pragma unroll
                for (int bj = 0; bj < 2; ++bj)
#pragma unroll
                    for (int n = 0; n < 2; ++n) { const size_t o = off + bj * 128 + n * 16; const f32x4 tv = *(const f32x4*)(tmp + o), b = *(const f32x4*)(bias + col0 + bj * 128 + n * 16), a = acc[ai][bj][m][n];
                        f32x4 v;
#pragma unroll
                        for (int e = 0; e < 4; ++e) v[e] = sigmoidf_(a[e] + b[e]) * tv[e];
                        if (!first) { const u32x2 old = *(const u32x2*)(merged + o); v[0] += bflo(old.x); v[1] += bfhi(old.x); v[2] += bflo(old.y); v[3] += bfhi(old.y); }
                        u32x2 w; w.x = cvt_pk_bf16(v[0], v[1]); w.y = cvt_pk_bf16(v[2], v[3]); *(u32x2*)(merged + o) = w; } }
    }
};

struct EpiSig {
    static constexpr bool PERM = false, AFTER_DRAIN = false, MID = true;
    bf16_t* G; const float* bias; const float* rowss; int tlast; mutable float rsv[8];
    __device__ __forceinline__ void mid(f32x4 (&)[2][2][4][2], const Unit& u, int t, int wr, int wc, int fr, int fq) const {
        if (rowss == nullptr || t != tlast) return;
        const float* rp = rowss + u.pm * 256 + wr * 64 + fr;
#pragma unroll
        for (int i = 0; i < 8; ++i) rsv[i] = rp[(i >> 2) * 128 + (i & 3) * 16];
    }
    __device__ __forceinline__ void operator()(const f32x4 (&acc)[2][2][4][2], const Unit& u, int wr, int wc, int fr, int fq) const {
        const int row0 = u.pm * 256 + wr * 64 + fr, col0 = u.pn * 256 + wc * 32 + 8 * fq;
#pragma unroll
        for (int ai = 0; ai < 2; ++ai)
#pragma unroll
            for (int m = 0; m < 4; ++m) { const int row = row0 + ai * 128 + m * 16; const size_t off = (size_t)row * 3072 + col0; const float rs = rsqrtf(rsv[ai * 4 + m] * (1.0f / 1024.0f) + 1e-6f);
#pragma unroll
                for (int bj = 0; bj < 2; ++bj) { const f32x4 b0 = *(const f32x4*)(bias + col0 + bj * 128), b1 = *(const f32x4*)(bias + col0 + bj * 128 + 4), a0 = acc[ai][bj][m][0], a1 = acc[ai][bj][m][1];
                    u32x4 w; w.x = cvt_pk_bf16(sigmoidf_(a0[0] * rs + b0[0]), sigmoidf_(a0[1] * rs + b0[1])); w.y = cvt_pk_bf16(sigmoidf_(a0[2] * rs + b0[2]), sigmoidf_(a0[3] * rs + b0[3]));
                    w.z = cvt_pk_bf16(sigmoidf_(a1[0] * rs + b1[0]), sigmoidf_(a1[1] * rs + b1[1])); w.w = cvt_pk_bf16(sigmoidf_(a1[2] * rs + b1[2]), sigmoidf_(a1[3] * rs + b1[3]));
                    *(u32x4*)(G + off + bj * 128) = w; } }
    }
};
struct EpiMix {
    static constexpr bool PERM = false, AFTER_DRAIN = false, MID = true;
    const bf16_t* G; bf16_t* merged;
    __device__ __forceinline__ void mid(f32x4 (&acc)[2][2][4][2], const Unit& u, int t, int wr, int wc, int fr, int fq) const {
        if (t != 8 && t != 12) return;
        const bf16_t* gp = G + (size_t)(u.pm * 256 + wr * 64 + fr) * 3072 + ((t == 8) ? 0 : 1024) + u.pn * 256 + wc * 32 + 8 * fq;
#pragma unroll
        for (int ai = 0; ai < 2; ++ai) {
#pragma unroll
            for (int m = 0; m < 4; ++m) {
#pragma unroll
                for (int bj = 0; bj < 2; ++bj) { f32x4 n0, n1, d0, d1; unpk8(*(const u32x4*)(gp + bj * 128), n0, n1); unpk8(*(const u32x4*)(gp + 1024 + bj * 128), d0, d1);
                    f32x4 r0, r1;
#pragma unroll
                    for (int e = 0; e < 4; ++e) { r0[e] = n0[e] * fast_rcp(d0[e]); r1[e] = n1[e] * fast_rcp(d1[e]); }
                    acc[ai][bj][m][0] *= r0; acc[ai][bj][m][1] *= r1; }
                gp += 16 * 3072; asm volatile("" : "+v"(gp) :: "memory"); }
            gp += 64 * 3072; asm volatile("" : "+v"(gp)); }
    }
    __device__ __forceinline__ void operator()(const f32x4 (&acc)[2][2][4][2], const Unit& u, int wr, int wc, int fr, int fq) const {
        const int row0 = u.pm * 256 + wr * 64 + fr, col0 = u.pn * 256 + wc * 32 + 8 * fq;
        const bf16_t* gp = G + (size_t)row0 * 3072 + 2048 + col0; bf16_t* mp = merged + (size_t)row0 * 1024 + col0;
        u32x4 c0 = *(const u32x4*)gp, c1 = *(const u32x4*)(gp + 128);
#pragma unroll
        for (int g = 0; g < 8; ++g) {
            const int ai = g >> 2, m = g & 3;
            const bf16_t* gn = gp + ((m == 3) ? 80 * 3072 : 16 * 3072);
            asm volatile("" : "+v"(gn));
            u32x4 n0 = c0, n1 = c1; if (g < 7) { n0 = *(const u32x4*)gn; n1 = *(const u32x4*)(gn + 128); }
#pragma unroll
            for (int bj = 0; bj < 2; ++bj) { f32x4 g0, g1; unpk8(bj ? c1 : c0, g0, g1); const f32x4 v0 = acc[ai][bj][m][0] * g0, v1 = acc[ai][bj][m][1] * g1;
                u32x4 w; w.x = cvt_pk_bf16(v0[0], v0[1]); w.y = cvt_pk_bf16(v0[2], v0[3]); w.z = cvt_pk_bf16(v1[0], v1[1]); w.w = cvt_pk_bf16(v1[2], v1[3]); *(u32x4*)(mp + bj * 128) = w; }
            asm volatile("" ::: "memory");
            gp = gn; mp += (m == 3) ? 80 * 1024 : 16 * 1024; c0 = n0; c1 = n1;
        }
    }
};

template <class Epi>
__device__ __forceinline__ void run_gemm(LAS unsigned char* lds, const bf16_t* A, const bf16_t* Bt, int M, int N, int K, const Epi& E) {
    Gemm g; g.A = A; g.Bt = Bt; g.M = M; g.N = N; g.K = K;
    StaticOrder S; S.init(M, N, (int)gridDim.x, (int)blockIdx.x);
    pg8::gemm_phase<Epi, StaticOrder, false>(lds, g, S, E, nullptr);
    __syncthreads();
}

constexpr int KSTR = 144, VSTR = 136;
constexpr int LK0 = 0, LK1 = 64 * KSTR, LVT = 2 * 64 * KSTR, LVTSZ = 128 * VSTR, LEX = LVT + 2 * LVTSZ;
constexpr float SC_LOG2E = 0.125f * 1.4426950408889634f;

template <int DV, bool TWO>
__device__ __forceinline__ void attn_core(LAS unsigned char* lds, const bf16_t* Qw, int ldq, const bf16_t* K0p, const bf16_t* K1p, int ldk,
                                          const bf16_t* Vp, int ldv, int ntiles, bool skip_last, f32x4 (&o)[DV / 16][2]) {
    const int tid = opaque_tid(), wave = tid >> 6, lane = tid & 63, r = lane & 15, quad = lane >> 4;
    const int kmap = TWO ? (wave >> 2) : 0;
    bf16x8 qf[2][2];
#pragma unroll
    for (int qt = 0; qt < 2; ++qt)
#pragma unroll
        for (int ks = 0; ks < 2; ++ks) qf[qt][ks] = *(const bf16x8*)(Qw + (size_t)(qt * 16 + r) * ldq + ks * 32 + quad * 8);
    float mrow[2] = {-INFINITY, -INFINITY}, lrow[2] = {0.f, 0.f};
#pragma unroll
    for (int dt = 0; dt < DV / 16; ++dt) { o[dt][0] = (f32x4){0.f, 0.f, 0.f, 0.f}; o[dt][1] = (f32x4){0.f, 0.f, 0.f, 0.f}; }
    u32x4 kreg[2], vreg[2];
    const int k_map = TWO ? (tid >> 8) : 0, k_row = TWO ? ((tid >> 2) & 63) : (tid >> 3), k_d = TWO ? (tid & 3) * 16 : (tid & 7) * 8;
    const bf16_t* kbase = (k_map ? K1p : K0p) + (size_t)k_row * ldk + k_d;
    const bool v_on = (DV == 128) || tid < 256;
    const int v_kp = (DV == 128) ? (tid >> 4) : (tid >> 3), v_dg = (DV == 128) ? (tid & 15) : (tid & 7);
    const bf16_t* vbase = Vp + (size_t)(2 * v_kp) * ldv + v_dg * 8;
    auto gload = [&](int tile) {
        const bf16_t* kp = kbase + (size_t)tile * 64 * ldk;
        kreg[0] = *(const u32x4*)kp; if (TWO) kreg[1] = *(const u32x4*)(kp + 8);
        if (v_on) { const bf16_t* vp = vbase + (size_t)tile * 64 * ldv; vreg[0] = *(const u32x4*)vp; vreg[1] = *(const u32x4*)(vp + ldv); }
    };
    bf16x8 pbp[2][2];
    bool prev = false;
    auto pv_half = [&](int vbuf, int h) {
#pragma unroll
        for (int d2 = 0; d2 < DV / 32; ++d2) { const int dt = h * (DV / 32) + d2;
#pragma unroll
            for (int kk = 0; kk < 2; ++kk) { LAS const unsigned char* vrow = lds + LVT + vbuf * LVTSZ + (dt * 16 + r) * VSTR;
                const u32x2 lo = *(LAS const u32x2*)(vrow + (((16 * kk + 2 * quad) ^ (4 * dt)) << 2)), hi = *(LAS const u32x2*)(vrow + (((16 * kk + 8 + 2 * quad) ^ (4 * dt)) << 2));
                u32x4 w; w.x = lo.x; w.y = lo.y; w.z = hi.x; w.w = hi.y; const bf16x8 vf = __builtin_bit_cast(bf16x8, w);
                o[dt][0] = __builtin_amdgcn_mfma_f32_16x16x32_bf16(vf, pbp[0][kk], o[dt][0], 0, 0, 0);
                o[dt][1] = __builtin_amdgcn_mfma_f32_16x16x32_bf16(vf, pbp[1][kk], o[dt][1], 0, 0, 0); } }
    };
    gload(0);
    for (int tile = 0; tile < ntiles; ++tile) {
        const int vb = tile & 1;
        __syncthreads();
        { LAS unsigned char* kd = lds + (k_map ? LK1 : LK0) + k_row * KSTR + k_d * 2;
          *(LAS u32x4*)kd = kreg[0]; if (TWO) *(LAS u32x4*)(kd + 16) = kreg[1];
          if (v_on) {
#pragma unroll
              for (int e = 0; e < 8; ++e) { const unsigned a = vreg[0][e >> 1], b = vreg[1][e >> 1];
                  const unsigned w = (e & 1) ? ((a >> 16) | (b & 0xffff0000u)) : ((a & 0xffffu) | (b << 16));
                  *(LAS unsigned*)(lds + LVT + vb * LVTSZ + (v_dg * 8 + e) * VSTR + ((v_kp ^ ((v_dg >> 1) << 2)) << 2)) = w; } } }
        __syncthreads();
        const bool active = !(skip_last && tile == ntiles - 1);
        if (!active) { if (prev) { pv_half(vb ^ 1, 0); pv_half(vb ^ 1, 1); prev = false; } continue; }
        f32x4 s[4][2];
#pragma unroll
        for (int kt = 0; kt < 4; ++kt) { s[kt][0] = (f32x4){0.f, 0.f, 0.f, 0.f}; s[kt][1] = (f32x4){0.f, 0.f, 0.f, 0.f};
#pragma unroll
            for (int ks = 0; ks < 2; ++ks) { const bf16x8 kf = *(const LAS bf16x8*)(lds + (kmap ? LK1 : LK0) + (kt * 16 + r) * KSTR + (ks * 32 + quad * 8) * 2);
                s[kt][0] = __builtin_amdgcn_mfma_f32_16x16x32_bf16(kf, qf[0][ks], s[kt][0], 0, 0, 0);
                s[kt][1] = __builtin_amdgcn_mfma_f32_16x16x32_bf16(kf, qf[1][ks], s[kt][1], 0, 0, 0); } }
        float alpha[2];
        auto softmax_q = [&](int qt, bf16x8 (&dst)[2]) {
            float mx = s[0][qt][0];
#pragma unroll
            for (int kt = 0; kt < 4; ++kt)
#pragma unroll
                for (int j = 0; j < 4; ++j) mx = fmaxf(mx, s[kt][qt][j]);
            mx = xquad_max(mx);
            const float mn = fmaxf(mrow[qt], mx * SC_LOG2E);
            alpha[qt] = __builtin_amdgcn_exp2f(mrow[qt] - mn); mrow[qt] = mn;
            float ps = 0.f; float p[4][4];
#pragma unroll
            for (int kt = 0; kt < 4; ++kt)
#pragma unroll
                for (int j = 0; j < 4; ++j) { p[kt][j] = __builtin_amdgcn_exp2f(s[kt][qt][j] * SC_LOG2E - mn); ps += p[kt][j]; }
            lrow[qt] = lrow[qt] * alpha[qt] + ps;
#pragma unroll
            for (int kk = 0; kk < 2; ++kk) { u32x4 w; w.x = cvt_pk_bf16(p[2 * kk][0], p[2 * kk][1]); w.y = cvt_pk_bf16(p[2 * kk][2], p[2 * kk][3]);
                w.z = cvt_pk_bf16(p[2 * kk + 1][0], p[2 * kk + 1][1]); w.w = cvt_pk_bf16(p[2 * kk + 1][2], p[2 * kk + 1][3]);
                dst[kk] = __builtin_bit_cast(bf16x8, w); }
        };
        bf16x8 pb0[2];
        if (prev) pv_half(vb ^ 1, 0);
        softmax_q(0, pb0);
        if (prev) pv_half(vb ^ 1, 1);
        if (tile + 1 < ntiles) gload(tile + 1);
        softmax_q(1, pbp[1]);
        pbp[0][0] = pb0[0]; pbp[0][1] = pb0[1];
#pragma unroll
        for (int qt = 0; qt < 2; ++qt) {
            if (__builtin_amdgcn_ballot_w64(alpha[qt] != 1.0f) != 0ull) {
#pragma unroll
                for (int dt = 0; dt < DV / 16; ++dt) o[dt][qt] *= alpha[qt]; } }
        prev = true;
    }
    if (prev) { const int vb = (ntiles - 1) & 1; pv_half(vb, 0); pv_half(vb, 1); }
#pragma unroll
    for (int qt = 0; qt < 2; ++qt) { float l = lrow[qt]; l = xquad_sum(l); const float inv = 1.0f / l;
#pragma unroll
        for (int dt = 0; dt < DV / 16; ++dt) o[dt][qt] *= inv; }
}

__device__ __forceinline__ void attention_phase(KP P, LAS unsigned char* lds) {
    const int tid = opaque_tid(), wave = tid >> 6, lane = tid & 63, r = lane & 15, quad = lane >> 4;
    const bf16_t* proj = (const bf16_t*)(P->ws + WS_ACT);
    const bf16_t* kvm = (const bf16_t*)(P->ws + WS_KVM);
    unsigned* qctr = (unsigned*)(P->ws + WS_QCTR);
    LAS unsigned* qslot = (LAS unsigned*)(lds + 120000);
    for (;;) {
        __syncthreads();
        if (tid == 0) {
            const unsigned x0 = ((unsigned)__builtin_amdgcn_s_getreg((3 << 11) | 20)) & 7u  ; unsigned got = 0xffffffffu;
            for (unsigned k = 0; k < 8u; ++k) { const unsigned q = (x0 + k) & 7u; const unsigned idx = __hip_atomic_fetch_add(qctr + q * 64u, 1u, __ATOMIC_RELAXED, __HIP_MEMORY_SCOPE_AGENT);
                if (idx < 384u) { got = q * 384u + idx; break; } }
            *qslot = got; }
        __syncthreads();
        const unsigned gotv = *qslot;
        if (gotv == 0xffffffffu) break;
        const int qx = (int)(gotv / 384u), qi = (int)(gotv % 384u);
        if (qi < 256) {
        const int qb = 31 - (qi & 31), bh = (qi >> 5) * 8 + qx, b = bh >> 2, h = bh & 3, map = wave >> 2, wq = wave & 3;
        const size_t tok0 = (size_t)b * SEQ;
        const int q0 = qb * 128 + wq * 32;
        f32x4 o[8][2];
        attn_core<128, true>(lds, proj + (tok0 + q0) * PLO + (2 * h + map) * 64, PLO, proj + tok0 * PLO + 512 + (2 * h) * 64, proj + tok0 * PLO + 512 + (2 * h + 1) * 64, PLO,
                             proj + tok0 * PLO + 1024 + h * 128, PLO, 2 * qb + 2, wq < 2, o);
        LAS float* ex = (LAS float*)(lds + LEX) + (size_t)wq * 4096 + lane;
        if (map == 1) {
            const float s1 = wave_sum(P->lq1[lane] * P->lk1[lane]), s2 = wave_sum(P->lq2[lane] * P->lk2[lane]); const float lam = expf(s1) - expf(s2) + 0.2f;
#pragma unroll
            for (int dt = 0; dt < 8; ++dt)
#pragma unroll
                for (int qt = 0; qt < 2; ++qt)
#pragma unroll
                    for (int j = 0; j < 4; ++j) ex[((dt * 2 + qt) * 4 + j) * 64] = o[dt][qt][j] * lam;
        }
        __syncthreads();
        if (map == 0) {
#pragma unroll
            for (int qt = 0; qt < 2; ++qt) { float ss = 0.f;
#pragma unroll
                for (int dt = 0; dt < 8; ++dt)
#pragma unroll
                    for (int j = 0; j < 4; ++j) { const float v = o[dt][qt][j] - ex[((dt * 2 + qt) * 4 + j) * 64]; o[dt][qt][j] = v; ss += v * v; }
                ss = xquad_sum(ss);
                const float rs = rsqrtf(ss * (1.0f / 128.0f) + 1e-6f) * 0.8f;
                int ro = r * 1024 + quad * 4; asm volatile("" : "+v"(ro));
                bf16_t* op = (bf16_t*)(P->ws + WS_OA) + (tok0 + q0 + qt * 16) * 1024 + h * 128 + ro;
#pragma unroll
                for (int dt = 0; dt < 8; ++dt) { const f32x4 g = *(const f32x4*)(P->subln + dt * 16 + quad * 4); const f32x4 v = o[dt][qt] * g * rs;
                    u32x2 w; w.x = cvt_pk_bf16(v[0], v[1]); w.y = cvt_pk_bf16(v[2], v[3]); *(u32x2*)(op + dt * 16) = w; } }
        }
    }
        else { const int j = qi - 256;
        const int b = (j >> 6) * 8 + qx, qblk = b * 16 + ((j & 63) >> 2), hx = j & 3;
        const size_t tokq = (size_t)qblk * 256 + wave * 32;
        f32x4 o[4][2];
        attn_core<64, false>(lds, proj + tokq * PLO + 2560 + hx * 64, PLO, kvm + (size_t)b * 256 * 512 + hx * 64, nullptr, 512,
                             kvm + (size_t)b * 256 * 512 + 256 + hx * 64, 512, 4, false, o);
#pragma unroll
        for (int qt = 0; qt < 2; ++qt) { int ro = r * 1024 + quad * 4; asm volatile("" : "+v"(ro)); bf16_t* op = (bf16_t*)(P->ws + WS_OA) + 768 + (tokq + qt * 16) * 1024 + hx * 64 + ro;
#pragma unroll
            for (int dt = 0; dt < 4; ++dt) { const f32x4 v = o[dt][qt]; u32x2 w; w.x = cvt_pk_bf16(v[0], v[1]); w.y = cvt_pk_bf16(v[2], v[3]); *(u32x2*)(op + dt * 16) = w; } }
    }
    }
}

__device__ __forceinline__ float red16(float v) { v += DPP_F(v, 0xB1); v += DPP_F(v, 0x4E); v += DPP_F(v, 0x141); v += DPP_F(v, 0x140); return v; }
constexpr int SB = 64;
__device__ __forceinline__ void rwkv_scan(KP P, LAS unsigned char* lds, int wg) {
    const int bh = wg >> 1, half = wg & 1, b = bh >> 2, h = bh & 3, tid = opaque_tid();
    LAS float* __restrict__ vec = (LAS float*)lds;
    LAS float* __restrict__ ybuf = (LAS float*)lds + SB * 384;
    const bf16_t* proj = (const bf16_t*)(P->ws + WS_ACT);
    const float* dec = (const float*)(P->ws + WS_DEC);
    const bf16_t* asg = (const bf16_t*)(P->ws + WS_ASG);
    float* yraw = (float*)(P->ws + WS_YRAW);
    const int tl = tid >> 4, l4 = (tid & 15) * 4, c4 = h * 64 + l4;
    const f32x4 mu_r = *(const f32x4*)(P->rw_mu + c4), mu_k = *(const f32x4*)(P->rw_mu + 256 + c4), mu_v = *(const f32x4*)(P->rw_mu + 512 + c4);
    const f32x4 kkp = *(const f32x4*)(P->rw_k_k + c4), kap = *(const f32x4*)(P->rw_k_a + c4);
    const int il = tid >> 4, irow = half * 32 + il;
    f32x4 st = {0.f, 0.f, 0.f, 0.f};
    constexpr int NP = SB / 32;
    u32x2 ur[NP], uk[NP], uv[NP], urp[NP], ukp[NP], uvp[NP], as2[NP]; f32x4 dc[NP];
    const size_t tokb = (size_t)b * SEQ;
    auto load_raw = [&](int blk) {
#pragma unroll
        for (int q = 0; q < NP; ++q) {
        const int tt = blk * SB + tl + 32 * q; const size_t tok = tokb + tt;
        const bf16_t* base = proj + tok * PLO + 1536 + c4;
        ur[q] = *(const u32x2*)base; uk[q] = *(const u32x2*)(base + 256); uv[q] = *(const u32x2*)(base + 512);
        if (tt > 0) { urp[q] = *(const u32x2*)(base - PLO); ukp[q] = *(const u32x2*)(base - PLO + 256); uvp[q] = *(const u32x2*)(base - PLO + 512); }
        else { urp[q] = (u32x2){0u, 0u}; ukp[q] = urp[q]; uvp[q] = urp[q]; }
        dc[q] = *(const f32x4*)(dec + tok * 256 + c4); as2[q] = *(const u32x2*)(asg + tok * 256 + c4); }
    };
    auto prep = [&]() {
#pragma unroll
        for (int q = 0; q < NP; ++q) {
        const f32x4 r0 = unpk4(ur[q]), rp = unpk4(urp[q]), k0 = unpk4(uk[q]), kp = unpk4(ukp[q]), v0 = unpk4(uv[q]), vp = unpk4(uvp[q]), a = unpk4(as2[q]);
        const f32x4 rr = r0 + (rp - r0) * mu_r, kx = k0 + (kp - k0) * mu_k, vv = v0 + (vp - v0) * mu_v;
        f32x4 kk = kx * kkp;
        const float nrm = sqrtf(red16(kk[0] * kk[0] + kk[1] * kk[1] + kk[2] * kk[2] + kk[3] * kk[3]));
        kk = kk * fast_rcp(fmaxf(nrm, 1e-12f));
        const f32x4 kmod = kx * (1.0f + (a - 1.0f) * kap);
        LAS float* vt = vec + (tl + 32 * q) * 384 + l4;
        *(LAS f32x4*)(vt) = rr; *(LAS f32x4*)(vt + 64) = dc[q]; *(LAS f32x4*)(vt + 128) = kmod; *(LAS f32x4*)(vt + 192) = -kk; *(LAS f32x4*)(vt + 256) = kk * a; *(LAS f32x4*)(vt + 320) = vv; }
    };
    load_raw(0); prep(); __syncthreads();
    for (int blk = 0; blk < SEQ / SB; ++blk) {
        if (blk + 1 < SEQ / SB) load_raw(blk + 1);
        {
            LAS const float* vt = vec;
            f32x4 a4 = *(LAS const f32x4*)(vt + 192 + l4), w4 = *(LAS const f32x4*)(vt + 64 + l4), b4 = *(LAS const f32x4*)(vt + 256 + l4), k4 = *(LAS const f32x4*)(vt + 128 + l4), r4 = *(LAS const f32x4*)(vt + l4);
            float vi = vt[320 + irow], yprev = 0.f;
#pragma unroll 8
            for (int t = 0; t < SB; ++t) {
                const int tn = (t + 1 < SB) ? t + 1 : t; LAS const float* vn = vec + tn * 384;
                const f32x4 a4n = *(LAS const f32x4*)(vn + 192 + l4), w4n = *(LAS const f32x4*)(vn + 64 + l4), b4n = *(LAS const f32x4*)(vn + 256 + l4), k4n = *(LAS const f32x4*)(vn + 128 + l4), r4n = *(LAS const f32x4*)(vn + l4);
                const float vin = vn[320 + irow];
                float sa = st[0] * a4[0] + st[1] * a4[1] + st[2] * a4[2] + st[3] * a4[3];
                sa += DPP_F(sa, 0xB1); yprev += DPP_F(yprev, 0xB1);
                sa += DPP_F(sa, 0x4E); yprev += DPP_F(yprev, 0x4E);
                sa += DPP_F(sa, 0x141); yprev += DPP_F(yprev, 0x141);
                sa += DPP_F(sa, 0x140); yprev += DPP_F(yprev, 0x140);
                if (t > 0 && (tid & 15) == 0) ybuf[(t - 1) * 32 + il] = yprev;
                st = st * w4 + (b4 * sa + k4 * vi);
                yprev = st[0] * r4[0] + st[1] * r4[1] + st[2] * r4[2] + st[3] * r4[3];
                a4 = a4n; w4 = w4n; b4 = b4n; k4 = k4n; r4 = r4n; vi = vin; }
            yprev = red16(yprev);
            if ((tid & 15) == 0) ybuf[(SB - 1) * 32 + il] = yprev; }
        __syncthreads();
#pragma unroll
        for (int q = 0; q < NP; ++q) { const size_t tok = tokb + blk * SB + tl + 32 * q; const int p2 = (tid & 15) * 2;
          const float y0 = ybuf[(tl + 32 * q) * 32 + p2], y1 = ybuf[(tl + 32 * q) * 32 + p2 + 1];
          float2 yy; yy.x = y0; yy.y = y1;
          *(float2*)(yraw + tok * 256 + h * 64 + half * 32 + p2) = yy; }
        if (blk + 1 < SEQ / SB) prep();
        __syncthreads();
    }
}
__device__ __forceinline__ void rwkv_post(KP P) {
    const bf16_t* proj = (const bf16_t*)(P->ws + WS_ACT);
    const bf16_t* asg = (const bf16_t*)(P->ws + WS_ASG);
    const bf16_t* ggp = (const bf16_t*)(P->ws + WS_GG);
    const float* yraw = (const float*)(P->ws + WS_YRAW);
    bf16_t* ob = (bf16_t*)(P->ws + WS_OA) + 512;
    for (int idx = (int)blockIdx.x * 512 + opaque_tid(); idx < T * 64; idx += (int)gridDim.x * 512) {
        const int tok = idx >> 6, c4 = (idx & 63) * 4;
        const bf16_t* base = proj + (size_t)tok * PLO + 1536 + c4;
        const f32x4 r0 = unpk4(*(const u32x2*)base), k0 = unpk4(*(const u32x2*)(base + 256)), v0 = unpk4(*(const u32x2*)(base + 512));
        f32x4 rp = {0.f, 0.f, 0.f, 0.f}, kp = rp, vp = rp;
        if ((tok & (SEQ - 1)) != 0) { rp = unpk4(*(const u32x2*)(base - PLO)); kp = unpk4(*(const u32x2*)(base - PLO + 256)); vp = unpk4(*(const u32x2*)(base - PLO + 512)); }
        const f32x4 a = unpk4(*(const u32x2*)(asg + (size_t)tok * 256 + c4)), g = unpk4(*(const u32x2*)(ggp + (size_t)tok * 256 + c4));
        const f32x4 y = *(const f32x4*)(yraw + (size_t)tok * 256 + c4);
        const f32x4 mu_r = *(const f32x4*)(P->rw_mu + c4), mu_k = *(const f32x4*)(P->rw_mu + 256 + c4), mu_v = *(const f32x4*)(P->rw_mu + 512 + c4);
        const f32x4 kap = *(const f32x4*)(P->rw_k_a + c4), rkp = *(const f32x4*)(P->rw_r_k + c4), lnw = *(const f32x4*)(P->rw_ln_w + c4), lnb = *(const f32x4*)(P->rw_ln_b + c4);
        const f32x4 rr = r0 + (rp - r0) * mu_r, kx = k0 + (kp - k0) * mu_k, vv = v0 + (vp - v0) * mu_v;
        const f32x4 kmod = kx * (1.0f + (a - 1.0f) * kap), tb = rr * kmod * rkp;
        const float bon = red16(tb[0] + tb[1] + tb[2] + tb[3]);
        const float mean = red16(y[0] + y[1] + y[2] + y[3]) * (1.0f / 64.0f); const f32x4 d = y - mean;
        const float var = red16(d[0] * d[0] + d[1] * d[1] + d[2] * d[2] + d[3] * d[3]) * (1.0f / 64.0f);
        f32x4 yn = d * rsqrtf(var + 64e-5f) * lnw + lnb; yn = (yn + vv * bon) * g;
        u32x2 w; w.x = cvt_pk_bf16(yn[0], yn[1]); w.y = cvt_pk_bf16(yn[2], yn[3]);
        *(u32x2*)(ob + (size_t)tok * 1024 + c4) = w;
    }
}

#define XB_TMO      128
#define XB_XCNT(j)  (256  + 64 * (j))
#define XB_XSUB(j)  (1280 + 64 * (j))
#define XB_XGEN(j)  (2304 + 64 * (j))
#define XB_TOP      3328
#define XB_TOPGEN   3392
#define XCD_BAR_WORDS 3456
#define XB_SPIN_CAP (1u << 18)

__device__ __forceinline__ unsigned xb_ld(unsigned* p)              { return __hip_atomic_load(p, __ATOMIC_RELAXED, __HIP_MEMORY_SCOPE_AGENT); }
__device__ __forceinline__ unsigned xb_add(unsigned* p, unsigned v) { return __hip_atomic_fetch_add(p, v, __ATOMIC_RELAXED, __HIP_MEMORY_SCOPE_AGENT); }
__device__ __forceinline__ unsigned xb_xcc_id() { return (unsigned)__builtin_amdgcn_s_getreg((3 << 11) | 20) & 0xFu; }
#define XB_SPIN(cond, bar) do { unsigned _sp = 0; while (cond) { __builtin_amdgcn_s_sleep(1); \
    if ((++_sp & 255u) == 0u) { if (xb_ld(&(bar)[XB_TMO])) break; if (_sp > XB_SPIN_CAP) { atomicAdd(&(bar)[XB_TMO], 1u); break; } } } } while (0)

struct XcdBarrier {
    unsigned* bar; unsigned x;
    volatile PG8_LAS unsigned* st;
};

__device__ __forceinline__ XcdBarrier xcd_barrier_post(unsigned* bar, volatile PG8_LAS unsigned* st) {
    XcdBarrier b; b.bar = bar; b.x = xb_xcc_id(); b.st = st;
    if (threadIdx.x == 0) (void)xb_add(&bar[XB_XCNT(b.x)], 1u);
    return b;
}
__device__ __forceinline__ void xcd_barrier_complete(unsigned* bar, unsigned x, unsigned& nloc, unsigned& nx) {
    const unsigned G = gridDim.x * gridDim.y * gridDim.z;
    unsigned sum, cnt, mine, sp = 0u;
    for (;;) {
        sum = 0u; cnt = 0u; mine = 0u;
#pragma unroll
        for (unsigned j = 0; j < 16; ++j) { const unsigned c = xb_ld(&bar[XB_XCNT(j)]); sum += c; cnt += (c > 0u) ? 1u : 0u; mine = (j == x) ? c : mine; }
        if (sum == G) break;
        __builtin_amdgcn_s_sleep(1);
        if ((++sp & 255u) == 0u) { if (xb_ld(&bar[XB_TMO])) break; if (sp > XB_SPIN_CAP) { atomicAdd(&bar[XB_TMO], 1u); break; } }
    }
    nloc = mine > 0u ? mine : 1u; nx = cnt > 0u ? cnt : 1u;
}

__device__ __forceinline__ void xcd_barrier(const XcdBarrier& b) {
    asm volatile("s_waitcnt vmcnt(0)" ::: "memory");
    __syncthreads();
    if (threadIdx.x == 0) {
        unsigned* bar = b.bar;
        __builtin_amdgcn_s_waitcnt(0);
        unsigned nloc = b.st[0], nx = b.st[1];
        if (nloc == 0u) { xcd_barrier_complete(bar, b.x, nloc, nx); b.st[0] = nloc; b.st[1] = nx; }
        const unsigned old = xb_add(&bar[XB_XSUB(b.x)], 1u);
        const unsigned gen = old / nloc;
        if (old + 1u == (gen + 1u) * nloc) {
            __builtin_amdgcn_fence(__ATOMIC_RELEASE, "agent");
            asm volatile("s_waitcnt vmcnt(0)" ::: "memory");
            const unsigned og = xb_add(&bar[XB_TOP], 1u);
            const unsigned tg = og / nx;
            if (og + 1u == (tg + 1u) * nx) xb_add(&bar[XB_TOPGEN], 1u);
            else XB_SPIN(xb_ld(&bar[XB_TOPGEN]) == tg, bar);
            __builtin_amdgcn_fence(__ATOMIC_ACQUIRE, "agent");
            xb_add(&bar[XB_XGEN(b.x)], 1u);
            asm volatile("s_waitcnt vmcnt(0)" ::: "memory");
        } else {
            XB_SPIN(xb_ld(&bar[XB_XGEN(b.x)]) == gen, bar);
            __builtin_amdgcn_fence(__ATOMIC_ACQUIRE, "agent");
            asm volatile("s_waitcnt vmcnt(0)" ::: "memory");
        }
    }
    __syncthreads();
}
#define GRID_SYNC() do { XcdBarrier xb_; xb_.bar = (unsigned*)(ws + WS_BAR); xb_.x = xb_xcc_id(); xb_.st = (volatile PG8_LAS unsigned*)(lds + 131072); xcd_barrier(xb_); } while (0)
__global__ void __launch_bounds__(512, 2) fwd_megakernel(Params Pk_unused) {
#define P kp_fresh()
    extern __shared__ __attribute__((aligned(16))) unsigned char shm[];
    LAS unsigned char* lds = (LAS unsigned char*)shm;
    cg::grid_group grid = cg::this_grid();
#define ws (P->ws)
    const int nth = gridDim.x * 512;
#define GTID ((int)blockIdx.x * 512 + opaque_tid())
#define H ((bf16_t*)(ws + WS_H))
#define ACT ((bf16_t*)(ws + WS_ACT))
#define X (P->out)
#define CS ((float*)(ws + WS_CS))
    grid.sync();
    { volatile PG8_LAS unsigned* st = (volatile PG8_LAS unsigned*)(lds + 131072); if (threadIdx.x == 0) { st[0] = 0u; st[1] = 0u; } __syncthreads();
      (void)xcd_barrier_post((unsigned*)(ws + WS_BAR), st); }

    {
    { const float *w1 = P->ffn1_w1, *w3 = P->ffn1_w3, *w2 = P->ffn1_w2;
      conv_w((bf16_t*)(ws + W_UP1), 5632, 1024, [=](int R, int k) { return ((R & 128) ? w3 : w1)[(size_t)k * DFF + swiglu_col(R)]; }, lds);
      conv_w((bf16_t*)(ws + W_DN1), 1024, 2816, [=](int R, int k) { return w2[(size_t)k * 1024 + perm_col(R, false)]; }, lds); }
    { const float *w1 = P->ffn2_w1, *w3 = P->ffn2_w3, *w2 = P->ffn2_w2, *gn = P->ffn2_norm;
      conv_w((bf16_t*)(ws + W_UP2), 5632, 1024, [=](int R, int k) { return gn[k] * ((R & 128) ? w3 : w1)[(size_t)k * DFF + swiglu_col(R)]; }, lds);
      conv_w((bf16_t*)(ws + W_DN2), 1024, 2816, [=](int R, int k) { return w2[(size_t)k * 1024 + perm_col(R, false)]; }, lds); }
    { const float *wi = P->w_in, *gn = P->mix_norm;
      conv_w((bf16_t*)(ws + W_INLO), 2816, 1024, [=](int R, int k) { return gn[k] * wi[(size_t)k * PCOLS + perm_col(R, R < 1024)]; }, lds);
      conv_w((bf16_t*)(ws + W_GATE), 3072, 1024, [=](int R, int k) { return gn[k] * wi[(size_t)k * PCOLS + 2816 + perm_col(R, false)]; }, lds); }
    { const float *ua = P->w_up_a, *ub = P->w_up_b, *uc = P->w_up_c, *wo = P->w_out, *mk = P->w_mem_kv;
      conv_w((bf16_t*)(ws + W_UPA), 1024, 1024, [=](int R0, int k) { const int R = perm_col(R0, false); return k < 512 ? ua[(size_t)k * 1024 + R] : (k < 768 ? ub[(size_t)(k - 512) * 1024 + R] : uc[(size_t)(k - 768) * 1024 + R]); }, lds);
      conv_w((bf16_t*)(ws + W_OUT), 1024, 1024, [=](int R, int k) { return wo[(size_t)k * 1024 + perm_col(R, false)]; }, lds);
      conv_w((bf16_t*)(ws + W_MKV), 512, 1024, [=](int R, int k) { return mk[(size_t)k * 512 + perm_col(R, false)]; }, lds); }
    { const float *w2 = P->rw_w2, *a2 = P->rw_a2, *g2 = P->rw_g2;
      conv_w((bf16_t*)(ws + W_LR), 768, 256, [=](int R, int k) { float v = 0.f;
          if (R < 256) { if (k < 64) v = w2[k * 256 + R]; }
          else if (R < 512) { if (k >= 64 && k < 128) v = a2[(k - 64) * 256 + (R - 256)]; }
          else { if (k >= 128) v = g2[(k - 128) * 256 + (R - 512)]; }
          return v; }, lds); }
    for (int idx = GTID; idx < 2 * T; idx += nth) ((float*)(ws + WS_SS1))[idx] = 0.f;
    norm_rows(P->x, P->ffn1_norm, H, nullptr, T);
    norm_rows(P->mem, P->mem_norm, (bf16_t*)(ws + WS_HM), nullptr, MEMT);
    for (int idx = GTID; idx < T * 8; idx += nth) {
        const int t = idx >> 3, i = idx & 7;
        const float ang = (float)P->pos[t] * INVF[i];
        const double rev = (double)ang * 0.15915494309189535; const double fr = rev - rint(rev); const double rr = fr * 6.283185307179586, r2 = rr * rr;
        double cterm = 1.0, sterm = rr, cc = 1.0, sn = rr;
#pragma unroll
        for (int k = 1; k <= 14; ++k) { cterm *= -r2 * (1.0 / ((2.0 * k - 1.0) * (2.0 * k))); sterm *= -r2 * (1.0 / ((2.0 * k) * (2.0 * k + 1.0))); cc += cterm; sn += sterm; }
        CS[idx * 2] = (float)cc; CS[idx * 2 + 1] = (float)sn;
    }
    GRID_SYNC();
    { EpiSwiglu e; e.act = ACT; e.rowss = nullptr; e.tlast = 14; run_gemm(lds, H, (const bf16_t*)(ws + W_UP1), T, 5632, 1024, e); }
    GRID_SYNC();
    { EpiRes<true, false, false, true> e; e.resf = P->x; e.resb = nullptr; e.outf = nullptr; e.outb = H; e.rowss = (float*)(ws + WS_SS1); run_gemm(lds, ACT, (const bf16_t*)(ws + W_DN1), T, 1024, 2816, e); }
    GRID_SYNC();
    { EpiPerm e; e.O = ACT; e.ld = PLO; e.cs = CS; e.rowss = (const float*)(ws + WS_SS1); e.tlast = 14; run_gemm(lds, H, (const bf16_t*)(ws + W_INLO), T, 2816, 1024, e); }
    GRID_SYNC();
    { EpiPerm e; e.O = (bf16_t*)(ws + WS_KVM); e.ld = 512; e.cs = nullptr; e.rowss = nullptr; e.tlast = 14; run_gemm(lds, (const bf16_t*)(ws + WS_HM), (const bf16_t*)(ws + W_MKV), MEMT, 512, 1024, e); }
    { bf16_t* alr = (bf16_t*)(ws + WS_ALR);
      if (blockIdx.x >= 32) for (int idx = ((int)blockIdx.x - 32) * 512 + opaque_tid(); idx < T * 32; idx += ((int)gridDim.x - 32) * 512) {
          const int t = idx >> 5, col = (idx & 31) * 8;
          const bf16_t* up = ACT + (size_t)t * PLO + 1536 + 768 + col;
          const u32x4 cur = *(const u32x4*)up; u32x4 prv = {0u, 0u, 0u, 0u}; if ((t & (SEQ - 1)) != 0) prv = *(const u32x4*)(up - PLO);
          const f32x4 m0 = *(const f32x4*)(P->rw_mu + 768 + col), m1 = *(const f32x4*)(P->rw_mu + 768 + col + 4);
          float v[8];
#pragma unroll
          for (int e = 0; e < 8; ++e) { const float cu = (e & 1) ? bfhi(cur[e >> 1]) : bflo(cur[e >> 1]), pv = (e & 1) ? bfhi(prv[e >> 1]) : bflo(prv[e >> 1]);
              const float mu = e < 4 ? m0[e & 3] : m1[e & 3]; const float xs = cu + (pv - cu) * mu;
              v[e] = col < 64 ? (1.0f - 2.0f * fast_rcp(__expf(2.0f * xs) + 1.0f)) : (col < 128 ? xs : sigmoidf_(xs)); }
          u32x4 w; w.x = cvt_pk_bf16(v[0], v[1]); w.y = cvt_pk_bf16(v[2], v[3]); w.z = cvt_pk_bf16(v[4], v[5]); w.w = cvt_pk_bf16(v[6], v[7]);
          *(u32x4*)(alr + (size_t)t * 256 + col) = w; } }
    GRID_SYNC();
    { EpiLR e; e.dec = (float*)(ws + WS_DEC); e.asg = (bf16_t*)(ws + WS_ASG); e.gg = (bf16_t*)(ws + WS_GG); e.w0 = P->rw_w0; e.a0 = P->rw_a0;
      run_gemm(lds, (const bf16_t*)(ws + WS_ALR), (const bf16_t*)(ws + W_LR), T, 768, 256, e); }
    GRID_SYNC();
    if ((int)blockIdx.x < NSCAN) rwkv_scan(P, lds, blockIdx.x);
    attention_phase(P, lds);
    GRID_SYNC();
    rwkv_post(P);
    GRID_SYNC();
    { EpiSig e; e.G = (bf16_t*)(ws + WS_ACT); e.bias = P->gate_bias; e.rowss = (const float*)(ws + WS_SS1); e.tlast = 14; run_gemm(lds, H, (const bf16_t*)(ws + W_GATE), T, 3072, 1024, e); }
    GRID_SYNC();
    { EpiMix e; e.G = (const bf16_t*)(ws + WS_ACT); e.merged = (bf16_t*)(ws + WS_DEC); run_gemm(lds, (const bf16_t*)(ws + WS_OA), (const bf16_t*)(ws + W_UPA), T, 1024, 1024, e); }
    GRID_SYNC();
    { EpiRes<false, true, false, true> e; e.resf = nullptr; e.resb = H; e.outf = nullptr; e.outb = H; e.rowss = (float*)(ws + WS_SS2); run_gemm(lds, (const bf16_t*)(ws + WS_DEC), (const bf16_t*)(ws + W_OUT), T, 1024, 1024, e); }
    GRID_SYNC();
    { EpiSwiglu e; e.act = ACT; e.rowss = (const float*)(ws + WS_SS2); e.tlast = 14; run_gemm(lds, H, (const bf16_t*)(ws + W_UP2), T, 5632, 1024, e); }
    GRID_SYNC();
    { EpiRes<true, true, false, false> e; e.resf = nullptr; e.resb = H; e.outf = nullptr; e.outb = H; e.rowss = nullptr; run_gemm(lds, ACT, (const bf16_t*)(ws + W_DN2), T, 1024, 2816, e); }
    GRID_SYNC();
    norm_rows_b(H, P->final_norm, X, T);
    }
}

#undef P
#undef ws
#undef H
#undef ACT
#undef X
#undef CS
#undef GTID
extern "C" void kernel_launch(void* const* d_in, const int* in_sizes, int n_in, void* d_out, int out_size, void* d_ws, size_t ws_size, hipStream_t stream) {
    constexpr int LDS_BYTES = 131072 + 256;
    static int grid_blocks = 0;
    if (grid_blocks == 0) {
        if (n_in != 37 || ws_size < WS_END) { fprintf(stderr, "kernel_launch: unexpected inputs (n_in %d, ws %zu, need %zu)\n", n_in, ws_size, (size_t)WS_END); grid_blocks = -1; return; }
        int dev = 0, cus = 0, per_cu = 0;
        hipGetDevice(&dev);
        hipDeviceGetAttribute(&cus, hipDeviceAttributeMultiprocessorCount, dev);
        hipFuncSetAttribute((const void*)fwd_megakernel, hipFuncAttributeMaxDynamicSharedMemorySize, LDS_BYTES);
        hipOccupancyMaxActiveBlocksPerMultiprocessor(&per_cu, (const void*)fwd_megakernel, 512, LDS_BYTES);
        if (per_cu < 1) per_cu = 1;
        grid_blocks = cus * per_cu;
        (void)hipGetLastError();
    }
    if (grid_blocks < 0) return;
    hipMemsetAsync((unsigned char*)d_ws + WS_BAR, 0, 16384 + 2048, stream);
    Params p{};
    p.x = (const float*)d_in[0]; p.mem = (const float*)d_in[1]; p.pos = (const int*)d_in[2];
    p.ffn1_norm = (const float*)d_in[3]; p.ffn1_w1 = (const float*)d_in[4]; p.ffn1_w3 = (const float*)d_in[5]; p.ffn1_w2 = (const float*)d_in[6];
    p.mix_norm = (const float*)d_in[7]; p.w_in = (const float*)d_in[8]; p.gate_bias = (const float*)d_in[9];
    p.lq1 = (const float*)d_in[10]; p.lk1 = (const float*)d_in[11]; p.lq2 = (const float*)d_in[12]; p.lk2 = (const float*)d_in[13]; p.subln = (const float*)d_in[14];
    p.rw_mu = (const float*)d_in[15]; p.rw_w0 = (const float*)d_in[16]; p.rw_w2 = (const float*)d_in[17]; p.rw_a0 = (const float*)d_in[18]; p.rw_a2 = (const float*)d_in[19];
    p.rw_g2 = (const float*)d_in[20]; p.rw_k_k = (const float*)d_in[21]; p.rw_k_a = (const float*)d_in[22]; p.rw_r_k = (const float*)d_in[23];
    p.rw_ln_w = (const float*)d_in[24]; p.rw_ln_b = (const float*)d_in[25];
    p.mem_norm = (const float*)d_in[26]; p.w_mem_kv = (const float*)d_in[27]; p.w_up_a = (const float*)d_in[28]; p.w_up_b = (const float*)d_in[29]; p.w_up_c = (const float*)d_in[30];
    p.w_out = (const float*)d_in[31]; p.ffn2_norm = (const float*)d_in[32]; p.ffn2_w1 = (const float*)d_in[33]; p.ffn2_w3 = (const float*)d_in[34]; p.ffn2_w2 = (const float*)d_in[35];
    p.final_norm = (const float*)d_in[36];
    p.out = (float*)d_out; p.ws = (unsigned char*)d_ws;
    void* args[] = {&p};
    hipError_t e = hipLaunchCooperativeKernel((const void*)fwd_megakernel, dim3(grid_blocks), dim3(512), args, LDS_BYTES, stream);
    if (e != hipSuccess) fprintf(stderr, "cooperative launch failed: %s (grid %d)\n", hipGetErrorString(e), grid_blocks);
}
```

```cpp
#include <hip/hip_runtime.h>
#include <hip/hip_cooperative_groups.h>
#include <cstdio>
namespace pg8 {
#define PG8_LAS __attribute__((address_space(3)))
typedef unsigned short bf16_t;
typedef short bf16x8 __attribute__((ext_vector_type(8)));
typedef float f32x4 __attribute__((ext_vector_type(4)));
typedef unsigned u32x4 __attribute__((ext_vector_type(4)));
constexpr int BM = 256, BK = 64, HALF = 128, HTB = HALF * BK * 2  , STAGE_BYTES = 8 * HTB, NXCD = 8, WGM = 8;

__host__ __device__ __forceinline__ int lds_byte(int r, int c) { const int st = (r >> 4) * 2 + (c >> 5), rr = r & 15, cc = c & 31, ob = rr * 64 + cc * 2; return st * 1024 + (ob ^ (((ob >> 9) & 1) << 5)); }
__host__ __device__ __forceinline__ void stage_rc(int b, int& R, int& C) { const int st = b / 1024, sb = b % 1024, swz = sb ^ (((sb >> 9) & 1) << 5); R = (st >> 1) * 16 + swz / 64; C = (st & 1) * 32 + (swz % 64) / 2; }
__host__ __device__ __forceinline__ int perm32(int rho) { const int n = rho >> 4, i = rho & 15; return 8 * (i >> 2) + 4 * n + (i & 3); }

struct Unit { int pm, pn; };
struct Gemm { const bf16_t* A; const bf16_t* Bt; int M, N, K; };

struct StaticOrder {
    int nM, nN, nwg, G, c;
    __host__ __device__ void init(int M, int N, int G_, int c_) { nM = M / BM; nN = N / BM; nwg = nM * nN; G = G_; c = c_; }
    __host__ __device__ bool next(int i, Unit& u) const {
        const long L = (long)i * G + c; if (L >= nwg) return false;
        int wgid = (int)L; { const int q = nwg / NXCD, r = nwg % NXCD, xcd = wgid % NXCD, off = wgid / NXCD; wgid = (xcd < r ? xcd * (q + 1) : r * (q + 1) + (xcd - r) * q) + off; }
        const int nig = WGM * nN, gid = wgid / nig, fm = gid * WGM, gsz = (nM - fm) < WGM ? (nM - fm) : WGM;
        u.pm = fm + ((wgid % nig) % gsz); u.pn = (wgid % nig) / gsz; return true;
    }
    __device__ __forceinline__ void a_ready(const Unit&) const {}
    __device__ __forceinline__ void done(const Unit&) const {}
};
typedef float f32x2_c __attribute__((ext_vector_type(2))); typedef __bf16 bf16x2_c __attribute__((ext_vector_type(2)));
__device__ __forceinline__ unsigned cvt_pk_bf16(float lo, float hi) { const f32x2_c v = {lo, hi}; const bf16x2_c b = __builtin_convertvector(v, bf16x2_c); return __builtin_bit_cast(unsigned, b); }
template <class Epi, class Sched, bool STAMP = false>
__device__ __forceinline__ void gemm_phase(PG8_LAS unsigned char* lds, const Gemm g, const Sched& S, const Epi& E, unsigned long long* stamps) {
    int tid_l = threadIdx.x; asm volatile("" : "+v"(tid_l)); const int tid = tid_l, wid = __builtin_amdgcn_readfirstlane(tid >> 6), lane = tid & 63, wr = wid >> 2, wc = wid & 3, fr = lane & 15, fq = lane >> 4;
    const int K = g.K, nt = K / BK;
    int ts_lo = 0, ts_hi = 0, nts = 0; const unsigned long long rt_entry = STAMP ? (unsigned long long)wall_clock64() : 0ull;
#define PG8_STAMP() do { if (STAMP && wid == 0 && nts < 64) { const unsigned long long _c = (unsigned long long)clock64(); \
        ts_lo = (lane == nts) ? (int)(unsigned)_c : ts_lo; ts_hi = (lane == nts) ? (int)(unsigned)(_c >> 32) : ts_hi; ++nts; } } while (0)
    PG8_STAMP();
    unsigned voffA[2], voffB[2];
#pragma unroll
    for (int i = 0; i < 2; ++i) { int R, C; stage_rc(tid * 16 + i * 8192, R, C); const int Rb = Epi::PERM ? ((R & ~31) + perm32(R & 31)) : R;
        voffA[i] = (unsigned)(R * K + C) * 2u; voffB[i] = (unsigned)(Rb * K + C) * 2u; }
    const size_t kstep = (size_t)(BK * 2);
    const size_t hstep = (size_t)HALF * K * 2;
    const size_t tstep = 2 * hstep;
    const unsigned ldsw = (unsigned)wid * 1024u;
    const int aoff = lds_byte(wr * 64 + fr, fq * 8), boff = lds_byte(wc * 32 + fr, fq * 8);
#define PG8_SA(b, h) (((b) * 2 + (h)) * HTB)
#define PG8_SB(b, h) ((4 + (b) * 2 + (h)) * HTB)
#define PG8_STAGE(bufoff, gbase, voff) do { _Pragma("unroll") for (int _i = 0; _i < 2; ++_i) \
        __builtin_amdgcn_global_load_lds((const unsigned*)((const char*)(gbase) + (voff)[_i]), (PG8_LAS unsigned*)(lds + (bufoff) + ldsw + _i * 8192), 16, 0, 0); } while (0)
#define PG8_LDA(dst, b, h) do { _Pragma("unroll") for (int m = 0; m < 4; ++m) _Pragma("unroll") for (int k = 0; k < 2; ++k) dst[m][k] = *(const PG8_LAS bf16x8*)(lds + PG8_SA(b, h) + aoff + m * 2048 + k * 1024); } while (0)
#define PG8_LDB(dst, b, h) do { _Pragma("unroll") for (int n = 0; n < 2; ++n) _Pragma("unroll") for (int k = 0; k < 2; ++k) dst[n][k] = *(const PG8_LAS bf16x8*)(lds + PG8_SB(b, h) + boff + n * 2048 + k * 1024); } while (0)
#define PG8_MMA(ai, bj, At, Bt) do { __builtin_amdgcn_s_setprio(1); _Pragma("unroll") for (int m = 0; m < 4; ++m) _Pragma("unroll") for (int n = 0; n < 2; ++n) _Pragma("unroll") for (int k = 0; k < 2; ++k) \
        acc[ai][bj][m][n] = __builtin_amdgcn_mfma_f32_16x16x32_bf16(Bt[n][k], At[m][k], acc[ai][bj][m][n], 0, 0, 0); __builtin_amdgcn_s_setprio(0); } while (0)
#define PG8_WAIT_V(n) asm volatile("s_waitcnt vmcnt(" #n ")" ::: "memory")
#define PG8_WAIT_L(n) asm volatile("s_waitcnt lgkmcnt(" #n ")" ::: "memory")
#define PG8_BAR __builtin_amdgcn_s_barrier()
#define PG8_SCHED __builtin_amdgcn_sched_barrier(0)
    Unit cur, nxt; int ui = 0;
    if (!S.next(0, cur)) return;
    f32x4 acc[2][2][4][2];
#pragma unroll
    for (int a = 0; a < 2; ++a)
#pragma unroll
        for (int b = 0; b < 2; ++b)
#pragma unroll
            for (int m = 0; m < 4; ++m)
#pragma unroll
                for (int n = 0; n < 2; ++n) acc[a][b][m][n] = (f32x4){0.f, 0.f, 0.f, 0.f};
    bf16x8 At[4][2], B0[2][2], B1[2][2];
    const char* cA = (const char*)g.A + (size_t)cur.pm * tstep; const char* cB = (const char*)g.Bt + (size_t)cur.pn * tstep;
    S.a_ready(cur);
    PG8_STAGE(PG8_SB(0, 0), cB, voffB); PG8_STAGE(PG8_SA(0, 0), cA, voffA); PG8_STAGE(PG8_SB(0, 1), cB + hstep, voffB); PG8_STAGE(PG8_SA(0, 1), cA + hstep, voffA);
    if (wr == 1) PG8_BAR;
    PG8_WAIT_V(4); PG8_BAR;
    PG8_STAGE(PG8_SB(1, 0), cB + kstep, voffB); PG8_STAGE(PG8_SA(1, 0), cA + kstep, voffA); PG8_STAGE(PG8_SB(1, 1), cB + hstep + kstep, voffB);
    PG8_WAIT_V(6); PG8_BAR;
    PG8_STAMP();
    for (;;) {
        const bool has_next = S.next(ui + 1, nxt);
        const char* nA = has_next ? (const char*)g.A + (size_t)nxt.pm * tstep : cA; const char* nB = has_next ? (const char*)g.Bt + (size_t)nxt.pn * tstep : cB;
        for (int t = 0; t < nt; t += 2) {
            const bool last = (t == nt - 2);
            const char* a1 = cA + (size_t)(t + 1) * kstep;
            const char* a2 = last ? nA : cA + (size_t)(t + 2) * kstep; const char* b2 = last ? nB : cB + (size_t)(t + 2) * kstep;
            const char* a3 = a2 + kstep; const char* b3 = b2 + kstep;
            if (last && has_next) S.a_ready(nxt);
            if constexpr (Epi::MID) E.mid(acc, cur, t, wr, wc, fr, fq);
            PG8_LDB(B0, 0, 0); PG8_SCHED; PG8_LDA(At, 0, 0); PG8_STAGE(PG8_SA(1, 1), a1 + hstep, voffA);
            PG8_WAIT_L(8); PG8_BAR; PG8_WAIT_L(0); PG8_MMA(0, 0, At, B0); PG8_BAR; PG8_SCHED;
            PG8_LDB(B1, 0, 1); PG8_STAGE(PG8_SB(0, 0), b2, voffB);
            PG8_BAR; PG8_WAIT_L(0); PG8_MMA(0, 1, At, B1); PG8_BAR;
            PG8_LDA(At, 0, 1); PG8_STAGE(PG8_SA(0, 0), a2, voffA);
            PG8_BAR; PG8_WAIT_L(0); PG8_MMA(1, 0, At, B0); PG8_BAR; PG8_SCHED;
            PG8_STAGE(PG8_SB(0, 1), b2 + hstep, voffB);
            PG8_WAIT_V(6); PG8_BAR; PG8_MMA(1, 1, At, B1); PG8_BAR;
            PG8_LDB(B0, 1, 0); PG8_SCHED; PG8_LDA(At, 1, 0); PG8_STAGE(PG8_SA(0, 1), a2 + hstep, voffA);
            PG8_WAIT_L(8); PG8_BAR; PG8_WAIT_L(0); PG8_MMA(0, 0, At, B0); PG8_BAR; PG8_SCHED;
            PG8_LDB(B1, 1, 1); PG8_STAGE(PG8_SB(1, 0), b3, voffB);
            PG8_BAR; PG8_WAIT_L(0); PG8_MMA(0, 1, At, B1); PG8_BAR;
            PG8_LDA(At, 1, 1); PG8_STAGE(PG8_SA(1, 0), a3, voffA);
            PG8_BAR; PG8_WAIT_L(0); PG8_MMA(1, 0, At, B0); PG8_BAR; PG8_SCHED;
            PG8_STAGE(PG8_SB(1, 1), b3 + hstep, voffB);
            PG8_WAIT_V(6); PG8_BAR; PG8_MMA(1, 1, At, B1); PG8_BAR;
        }
        PG8_STAMP();
        if constexpr (!Epi::AFTER_DRAIN) { E(acc, cur, wr, wc, fr, fq); S.done(cur); }
        PG8_STAMP();
        if (!has_next) break;
#pragma unroll
        for (int a = 0; a < 2; ++a)
#pragma unroll
            for (int b = 0; b < 2; ++b)
#pragma unroll
                for (int m = 0; m < 4; ++m)
#pragma unroll
                    for (int n = 0; n < 2; ++n) acc[a][b][m][n] = (f32x4){0.f, 0.f, 0.f, 0.f};
        cur = nxt; cA = nA; cB = nB; ++ui;
    }
    PG8_WAIT_V(0);
    if (wr == 0) PG8_BAR;
    PG8_BAR;
    if constexpr (Epi::AFTER_DRAIN) { E.fused(acc, cur, wr, wc, fr, fq, lds, wid, lane); S.done(cur); }
    PG8_STAMP();
    if (STAMP && wid == 0) { stamps[lane] = lane < nts ? (((unsigned long long)(unsigned)ts_hi << 32) | (unsigned)ts_lo) : 0ull;
        if (lane == 62) stamps[62] = rt_entry; if (lane == 63) stamps[63] = (unsigned long long)wall_clock64(); }
#undef PG8_STAMP
#undef PG8_SA
#undef PG8_SB
#undef PG8_STAGE
#undef PG8_LDA
#undef PG8_LDB
#undef PG8_MMA
#undef PG8_WAIT_V
#undef PG8_WAIT_L
#undef PG8_BAR
#undef PG8_SCHED
}
}
namespace cg = cooperative_groups;
using pg8::bf16_t; using pg8::bf16x8; using pg8::f32x4; using pg8::cvt_pk_bf16; using pg8::Unit; using pg8::Gemm; using pg8::StaticOrder;
typedef unsigned u32x2 __attribute__((ext_vector_type(2)));
typedef unsigned u32x4 __attribute__((ext_vector_type(4)));
#define LAS PG8_LAS

constexpr int T = 65536, SEQ = 4096, DM = 1024, DFF = 2816, PCOLS = 5888, PLO = 2816, MEMT = 4096;
constexpr int NSCAN = 128;

constexpr size_t W_UP1 = 0;
constexpr size_t W_DN1 = W_UP1 + (size_t)5632 * 1024 * 2;
constexpr size_t W_UP2 = W_DN1 + (size_t)1024 * 2816 * 2;
constexpr size_t W_DN2 = W_UP2 + (size_t)5632 * 1024 * 2;
constexpr size_t W_INLO = W_DN2 + (size_t)1024 * 2816 * 2;
constexpr size_t W_GATE = W_INLO + (size_t)2816 * 1024 * 2;
constexpr size_t W_UPA = W_GATE + (size_t)3072 * 1024 * 2;
constexpr size_t W_UPB = W_UPA + (size_t)1024 * 512 * 2;
constexpr size_t W_UPC = W_UPB + (size_t)1024 * 256 * 2;
constexpr size_t W_OUT = W_UPC + (size_t)1024 * 256 * 2;
constexpr size_t W_MKV = W_OUT + (size_t)1024 * 1024 * 2;
constexpr size_t W_LR = W_MKV + (size_t)512 * 1024 * 2;
constexpr size_t WS_ACT = W_LR + (size_t)768 * 256 * 2;
constexpr size_t WS_ALR = WS_ACT + (size_t)T * 2816 * 2;
constexpr size_t WS_H = WS_ALR + (size_t)T * 256 * 2;
constexpr size_t WS_DEC = WS_H + (size_t)T * 1024 * 2;
constexpr size_t WS_ASG = WS_DEC + (size_t)T * 256 * 4;
constexpr size_t WS_GG = WS_ASG + (size_t)T * 256 * 2;
constexpr size_t WS_OA = WS_GG + (size_t)T * 256 * 2;
constexpr size_t WS_OB = WS_OA + (size_t)T * 512 * 2;
constexpr size_t WS_OC = WS_OB + (size_t)T * 256 * 2;
constexpr size_t WS_CS = WS_OC + (size_t)T * 256 * 2;
constexpr size_t WS_HM = WS_CS + (size_t)T * 16 * 4;
constexpr size_t WS_KVM = WS_HM + (size_t)MEMT * 1024 * 2;
constexpr size_t WS_BAR = WS_KVM + (size_t)MEMT * 512 * 2;
constexpr size_t WS_QCTR = WS_BAR + 16384;
constexpr size_t WS_SS1 = WS_BAR + 16384 + 2048;
constexpr size_t WS_SS2 = WS_SS1 + (size_t)T * 4;
constexpr size_t WS_YRAW = WS_SS2 + (size_t)T * 4;
constexpr size_t WS_END = WS_YRAW + (size_t)T * 256 * 4;

struct Params {
    const float* x; const float* mem; const int* pos;
    const float *ffn1_norm, *ffn1_w1, *ffn1_w3, *ffn1_w2, *mix_norm, *w_in, *gate_bias;
    const float *lq1, *lk1, *lq2, *lk2, *subln;
    const float *rw_mu, *rw_w0, *rw_w2, *rw_a0, *rw_a2, *rw_g2, *rw_k_k, *rw_k_a, *rw_r_k, *rw_ln_w, *rw_ln_b;
    const float *mem_norm, *w_mem_kv, *w_up_a, *w_up_b, *w_up_c, *w_out;
    const float *ffn2_norm, *ffn2_w1, *ffn2_w3, *ffn2_w2, *final_norm;
    float* out; unsigned char* ws;
};

typedef const __attribute__((address_space(4))) Params* KP;
__device__ __forceinline__ KP kp_fresh() { KP p = (KP)__builtin_amdgcn_kernarg_segment_ptr(); asm volatile("" : "+s"(p)); return p; }

__constant__ float INVF[8] = {1.0f, 0.1939227432012558f, 0.03760603070259094f, 0.007292664609849453f, 0.0014142135623842478f,
                              0.00027424818836152554f, 5.3182957344688475e-05f, 1.0313385246263351e-05f};

__device__ __forceinline__ float bf2f(bf16_t b) { return __uint_as_float(((unsigned)b) << 16); }
__device__ __forceinline__ float bflo(unsigned w) { return __uint_as_float(w << 16); }
__device__ __forceinline__ float bfhi(unsigned w) { return __uint_as_float(w & 0xffff0000u); }
__device__ __forceinline__ bf16_t f2bf(float f) { return (bf16_t)(cvt_pk_bf16(f, 0.f) & 0xffffu); }
__device__ __forceinline__ f32x4 unpk4(u32x2 w) { f32x4 r; r[0] = bflo(w.x); r[1] = bfhi(w.x); r[2] = bflo(w.y); r[3] = bfhi(w.y); return r; }
__device__ __forceinline__ float xquad_max(float x) {
    auto a = __builtin_amdgcn_permlane32_swap(__float_as_uint(x), __float_as_uint(x), false, false);
    const float m = fmaxf(__uint_as_float(a[0]), __uint_as_float(a[1]));
    auto b = __builtin_amdgcn_permlane16_swap(__float_as_uint(m), __float_as_uint(m), false, false);
    return fmaxf(__uint_as_float(b[0]), __uint_as_float(b[1]));
}
__device__ __forceinline__ float xquad_sum(float x) {
    auto a = __builtin_amdgcn_permlane32_swap(__float_as_uint(x), __float_as_uint(x), false, false);
    const float m = __uint_as_float(a[0]) + __uint_as_float(a[1]);
    auto b = __builtin_amdgcn_permlane16_swap(__float_as_uint(m), __float_as_uint(m), false, false);
    return __uint_as_float(b[0]) + __uint_as_float(b[1]);
}
__device__ __forceinline__ float fast_rcp(float x) { return __builtin_amdgcn_rcpf(x); }
__device__ __forceinline__ float sigmoidf_(float x) { return fast_rcp(1.0f + __expf(-x)); }
__device__ __forceinline__ int opaque_tid() { int t = threadIdx.x; asm volatile("" : "+v"(t)); return t; }
#define DPP_F(v, ctrl) __int_as_float(__builtin_amdgcn_update_dpp(0, __float_as_int(v), ctrl, 0xF, 0xF, true))
__device__ __forceinline__ float wave_sum(float v) { v += DPP_F(v, 0xB1); v += DPP_F(v, 0x4E); v += DPP_F(v, 0x141); v += DPP_F(v, 0x140); return xquad_sum(v); }
__device__ __forceinline__ float red8(float v) { v += DPP_F(v, 0xB1); v += DPP_F(v, 0x4E); v += DPP_F(v, 0x141); return v; }

template <class F>
__device__ __forceinline__ void conv_w(bf16_t* dst, int N, int K, F src, LAS unsigned char* lds) {
    LAS float* tl = (LAS float*)lds;
    const int tid = opaque_tid(), kt = K >> 6, ntiles = (N >> 6) * kt;
    float cur[8];
    int tile = blockIdx.x;
    if (tile < ntiles) { const int R0 = (tile / kt) * 64, k0 = (tile % kt) * 64;
#pragma unroll
        for (int j = 0; j < 8; ++j) { const int e = tid + 512 * j; cur[j] = src(R0 + (e & 63), k0 + (e >> 6)); } }
    for (; tile < ntiles; tile += gridDim.x) {
        const int R0 = (tile / kt) * 64, k0 = (tile % kt) * 64;
#pragma unroll
        for (int j = 0; j < 8; ++j) { const int e = tid + 512 * j; tl[(e & 63) * 65 + (e >> 6)] = cur[j]; }
        const int nt2 = tile + gridDim.x;
        if (nt2 < ntiles) { const int R1 = (nt2 / kt) * 64, k1 = (nt2 % kt) * 64;
#pragma unroll
            for (int j = 0; j < 8; ++j) { const int e = tid + 512 * j; cur[j] = src(R1 + (e & 63), k1 + (e >> 6)); } }
        __syncthreads();
        { const int r = tid >> 3, k8 = (tid & 7) * 8; LAS const float* p = tl + r * 65 + k8;
          u32x4 w; w.x = cvt_pk_bf16(p[0], p[1]); w.y = cvt_pk_bf16(p[2], p[3]); w.z = cvt_pk_bf16(p[4], p[5]); w.w = cvt_pk_bf16(p[6], p[7]);
          *(u32x4*)(dst + (size_t)(R0 + r) * K + k0 + k8) = w; }
        __syncthreads();
    }
}
__device__ __forceinline__ int perm_col(int R, bool rope) {
    const int Gb = R & ~31, rho = R & 31, n = rho >> 4, fq = (rho >> 2) & 3, e = rho & 3;
    int d;
    if (rope && (Gb & 32) == 0) d = fq < 2 ? 4 * fq + 8 * n + e : 16 + (fq - 2) * 8 + 4 * n + e;
    else d = 8 * fq + 4 * n + e;
    return Gb + d;
}

__device__ __forceinline__ int swiglu_col(int R) { const int pn = R >> 8, wcg = (R >> 5) & 3, rho = R & 31; return pn * 128 + wcg * 32 + 8 * ((rho >> 2) & 3) + 4 * (rho >> 4) + (rho & 3); }

__device__ __forceinline__ void norm_rows(const float* in, const float* gain, bf16_t* outb, float* outf, int rows) {
    const int tid = opaque_tid(), wave = tid >> 6, lane = tid & 63, stride = gridDim.x * 8;
    int row = blockIdx.x * 8 + wave;
    float4 nx[4];
    if (row < rows) { const float4* p = (const float4*)(in + (size_t)row * 1024);
#pragma unroll
        for (int j = 0; j < 4; ++j) nx[j] = p[j * 64 + lane]; }
    for (; row < rows; row += stride) {
        float4 v[4]; float ss = 0.f;
#pragma unroll
        for (int j = 0; j < 4; ++j) { v[j] = nx[j]; ss += v[j].x * v[j].x + v[j].y * v[j].y + v[j].z * v[j].z + v[j].w * v[j].w; }
        if (row + stride < rows) { const float4* p = (const float4*)(in + (size_t)(row + stride) * 1024);
#pragma unroll
            for (int j = 0; j < 4; ++j) nx[j] = p[j * 64 + lane]; }
        ss = wave_sum(ss);
        const float r = rsqrtf(ss * (1.0f / 1024.0f) + 1e-6f);
#pragma unroll
        for (int j = 0; j < 4; ++j) {
            const float4 g = ((const float4*)gain)[j * 64 + lane];
            float4 y; y.x = v[j].x * r * g.x; y.y = v[j].y * r * g.y; y.z = v[j].z * r * g.z; y.w = v[j].w * r * g.w;
            if (outf) ((float4*)(outf + (size_t)row * 1024))[j * 64 + lane] = y;
            else { u32x2 w; w.x = cvt_pk_bf16(y.x, y.y); w.y = cvt_pk_bf16(y.z, y.w); *(u32x2*)(outb + (size_t)row * 1024 + (j * 64 + lane) * 4) = w; }
        }
    }
}

__device__ __forceinline__ void unpk8(u32x4 w, f32x4& lo, f32x4& hi) { lo[0] = bflo(w.x); lo[1] = bfhi(w.x); lo[2] = bflo(w.y); lo[3] = bfhi(w.y); hi[0] = bflo(w.z); hi[1] = bfhi(w.z); hi[2] = bflo(w.w); hi[3] = bfhi(w.w); }
__device__ __forceinline__ void norm_rows_b(const bf16_t* in, const float* gain, float* outf, int rows) {
    const int tid = opaque_tid(), wave = tid >> 6, lane = tid & 63, stride = gridDim.x * 8;
    int row = blockIdx.x * 8 + wave;
    u32x4 nx[2];
    if (row < rows) { const u32x4* p = (const u32x4*)(in + (size_t)row * 1024); nx[0] = p[lane]; nx[1] = p[64 + lane]; }
    for (; row < rows; row += stride) {
        f32x4 v[4]; float ss = 0.f;
        unpk8(nx[0], v[0], v[1]); unpk8(nx[1], v[2], v[3]);
#pragma unroll
        for (int j = 0; j < 4; ++j) ss += v[j][0] * v[j][0] + v[j][1] * v[j][1] + v[j][2] * v[j][2] + v[j][3] * v[j][3];
        if (row + stride < rows) { const u32x4* p = (const u32x4*)(in + (size_t)(row + stride) * 1024); nx[0] = p[lane]; nx[1] = p[64 + lane]; }
        ss = wave_sum(ss);
        const float r = rsqrtf(ss * (1.0f / 1024.0f) + 1e-6f);
#pragma unroll
        for (int j = 0; j < 2; ++j) { const int c = (j * 64 + lane) * 8;
            const f32x4 g0 = *(const f32x4*)(gain + c), g1 = *(const f32x4*)(gain + c + 4);
            *(f32x4*)(outf + (size_t)row * 1024 + c) = v[2 * j] * r * g0; *(f32x4*)(outf + (size_t)row * 1024 + c + 4) = v[2 * j + 1] * r * g1; }
    }
}

struct EpiSwiglu {
    static constexpr bool PERM = false, AFTER_DRAIN = false, MID = true;
    bf16_t* act; const float* rowss; int tlast; mutable float rsv[8];
    __device__ __forceinline__ void mid(f32x4 (&)[2][2][4][2], const Unit& u, int t, int wr, int wc, int fr, int fq) const {
        if (rowss == nullptr || t != tlast) return;
        const float* rp = rowss + u.pm * 256 + wr * 64 + fr;
#pragma unroll
        for (int i = 0; i < 8; ++i) rsv[i] = rp[(i >> 2) * 128 + (i & 3) * 16];
    }
    __device__ __forceinline__ void operator()(const f32x4 (&acc)[2][2][4][2], const Unit& u, int wr, int wc, int fr, int fq) const {
        const int row0 = u.pm * 256 + wr * 64 + fr;
#pragma unroll
        for (int ai = 0; ai < 2; ++ai)
#pragma unroll
            for (int m = 0; m < 4; ++m) { const int row = row0 + ai * 128 + m * 16; bf16_t* rowp = act + (size_t)row * DFF + u.pn * 128 + wc * 32 + 8 * fq;
                const float rs = rowss ? rsqrtf(rsv[ai * 4 + m] * (1.0f / 1024.0f) + 1e-6f) : 1.0f;
                float o[8];
#pragma unroll
                for (int n = 0; n < 2; ++n) { const f32x4 g = acc[ai][0][m][n] * rs, v = acc[ai][1][m][n] * rs;
#pragma unroll
                    for (int e = 0; e < 4; ++e) o[4 * n + e] = g[e] * fast_rcp(1.0f + __expf(-g[e])) * v[e]; }
                u32x4 w; w.x = cvt_pk_bf16(o[0], o[1]); w.y = cvt_pk_bf16(o[2], o[3]); w.z = cvt_pk_bf16(o[4], o[5]); w.w = cvt_pk_bf16(o[6], o[7]);
                *(u32x4*)rowp = w; }
    }
};
template <bool HALF, bool RESB, bool OUTF, bool STATS> struct EpiRes {
    static constexpr bool PERM = false, AFTER_DRAIN = false, MID = false;
    const float* resf; const bf16_t* resb; float* outf; bf16_t* outb; float* rowss;
    __device__ __forceinline__ void ldres(size_t off, f32x4 (&r)[4]) const {
        if (RESB) { r[0] = __builtin_bit_cast(f32x4, *(const u32x4*)(resb + off)); r[1] = __builtin_bit_cast(f32x4, *(const u32x4*)(resb + off + 128)); }
        else { r[0] = *(const f32x4*)(resf + off); r[1] = *(const f32x4*)(resf + off + 4); r[2] = *(const f32x4*)(resf + off + 128); r[3] = *(const f32x4*)(resf + off + 132); }
    }
    __device__ __forceinline__ void operator()(const f32x4 (&acc)[2][2][4][2], const Unit& u, int wr, int wc, int fr, int fq) const {
        const int row0 = u.pm * 256 + wr * 64 + fr, col0 = u.pn * 256 + wc * 32 + 8 * fq;
        size_t off = (size_t)row0 * 1024 + col0; int row = row0;
        f32x4 cur[4]; ldres(off, cur);
#pragma unroll
        for (int g = 0; g < 8; ++g) {
            const int ai = g >> 2, m = g & 3;
            size_t offn = off + ((m == 3) ? (size_t)80 * 1024 : (size_t)16 * 1024);
            asm volatile("" : "+v"(offn));
            f32x4 nxt[4]; if (g < 7) ldres(offn, nxt);
            float ss = 0.f;
#pragma unroll
            for (int bj = 0; bj < 2; ++bj) { f32x4 r0, r1;
                if (RESB) unpk8(__builtin_bit_cast(u32x4, cur[bj]), r0, r1); else { r0 = cur[2 * bj]; r1 = cur[2 * bj + 1]; }
                const f32x4 v0 = r0 + acc[ai][bj][m][0] * (HALF ? 0.5f : 1.0f), v1 = r1 + acc[ai][bj][m][1] * (HALF ? 0.5f : 1.0f);
                if (OUTF) { *(f32x4*)(outf + off + bj * 128) = v0; *(f32x4*)(outf + off + bj * 128 + 4) = v1; }
                else { u32x4 w; w.x = cvt_pk_bf16(v0[0], v0[1]); w.y = cvt_pk_bf16(v0[2], v0[3]); w.z = cvt_pk_bf16(v1[0], v1[1]); w.w = cvt_pk_bf16(v1[2], v1[3]); *(u32x4*)(outb + off + bj * 128) = w; }
                if (STATS) ss += v0[0] * v0[0] + v0[1] * v0[1] + v0[2] * v0[2] + v0[3] * v0[3] + v1[0] * v1[0] + v1[1] * v1[1] + v1[2] * v1[2] + v1[3] * v1[3]; }
            if (STATS) { ss = xquad_sum(ss); if (fq == 0) atomicAdd(rowss + row, ss); }
            asm volatile("" ::: "memory");
            off = offn; row += (m == 3) ? 80 : 16;
#pragma unroll
            for (int k = 0; k < 4; ++k) cur[k] = nxt[k];
        }
    }
};
struct EpiPerm {
    static constexpr bool PERM = false, AFTER_DRAIN = false, MID = true;
    bf16_t* O; int ld; const float* cs; const float* rowss; int tlast; mutable float rsv[8];
    __device__ __forceinline__ void mid(f32x4 (&)[2][2][4][2], const Unit& u, int t, int wr, int wc, int fr, int fq) const {
        if (rowss == nullptr || t != tlast) return;
        const float* rp = rowss + u.pm * 256 + wr * 64 + fr;
#pragma unroll
        for (int i = 0; i < 8; ++i) rsv[i] = rp[(i >> 2) * 128 + (i & 3) * 16];
    }
    __device__ __forceinline__ void operator()(const f32x4 (&acc)[2][2][4][2], const Unit& u, int wr, int wc, int fr, int fq) const {
        const int row0 = u.pm * 256 + wr * 64 + fr;
        const bool rope = cs != nullptr && u.pn < 4 && (wc & 1) == 0 && fq < 2;
#pragma unroll
        for (int ai = 0; ai < 2; ++ai)
#pragma unroll
            for (int m = 0; m < 4; ++m) { const int row = row0 + ai * 128 + m * 16; bf16_t* rowp = O + (size_t)row * ld;
                f32x4 c4 = {1.f, 1.f, 1.f, 1.f}, s4 = {0.f, 0.f, 0.f, 0.f};
                if (rope) { const float* t = cs + (size_t)row * 16 + fq * 8; const f32x4 a = *(const f32x4*)t, b = *(const f32x4*)(t + 4);
                    c4[0] = a[0]; s4[0] = a[1]; c4[1] = a[2]; s4[1] = a[3]; c4[2] = b[0]; s4[2] = b[1]; c4[3] = b[2]; s4[3] = b[3]; }
                const float rs = rowss ? rsqrtf(rsv[ai * 4 + m] * (1.0f / 1024.0f) + 1e-6f) : 1.0f;
#pragma unroll
                for (int bj = 0; bj < 2; ++bj) { const f32x4 x1 = acc[ai][bj][m][0] * rs, x2 = acc[ai][bj][m][1] * rs;
                    const f32x4 y1 = x1 * c4 - x2 * s4, y2 = x2 * c4 + x1 * s4;
                    u32x4 w; w.x = cvt_pk_bf16(y1[0], y1[1]); w.y = cvt_pk_bf16(y1[2], y1[3]); w.z = cvt_pk_bf16(y2[0], y2[1]); w.w = cvt_pk_bf16(y2[2], y2[3]);
                    *(u32x4*)(rowp + u.pn * 256 + bj * 128 + wc * 32 + 8 * fq) = w; } }
    }
};
struct EpiLR {
    static constexpr bool PERM = false, AFTER_DRAIN = false, MID = false;
    float* dec; bf16_t* asg; bf16_t* gg; const float* w0; const float* a0;
    __device__ __forceinline__ void operator()(const f32x4 (&acc)[2][2][4][2], const Unit& u, int wr, int wc, int fr, int fq) const {
        const int row0 = u.pm * 256 + wr * 64 + fr, col0 = wc * 32 + 4 * fq;
#pragma unroll
        for (int ai = 0; ai < 2; ++ai)
#pragma unroll
            for (int m = 0; m < 4; ++m) { const size_t off = (size_t)(row0 + ai * 128 + m * 16) * 256 + col0;
#pragma unroll
                for (int bj = 0; bj < 2; ++bj)
#pragma unroll
                    for (int n = 0; n < 2; ++n) { const int c = col0 + bj * 128 + n * 16; const size_t o = off + bj * 128 + n * 16; const f32x4 a = acc[ai][bj][m][n];
                        if (u.pn == 0) { const f32x4 b = *(const f32x4*)(w0 + c); f32x4 d;
#pragma unroll
                            for (int e = 0; e < 4; ++e) { const float z = -(b[e] + a[e]);
                                const float sp = fmaxf(z, 0.f) + __logf(1.0f + __expf(-fabsf(z)));
                                d[e] = __expf(-__expf(-sp - 0.5f)); }
                            *(f32x4*)(dec + o) = d; }
                        else if (u.pn == 1) { const f32x4 b = *(const f32x4*)(a0 + c); u32x2 w;
                            w.x = cvt_pk_bf16(sigmoidf_(b[0] + a[0]), sigmoidf_(b[1] + a[1])); w.y = cvt_pk_bf16(sigmoidf_(b[2] + a[2]), sigmoidf_(b[3] + a[3]));
                            *(u32x2*)(asg + o) = w; }
                        else { u32x2 w; w.x = cvt_pk_bf16(a[0], a[1]); w.y = cvt_pk_bf16(a[2], a[3]); *(u32x2*)(gg + o) = w; } } }
    }
};
struct EpiTmp {
    static constexpr bool PERM = false, AFTER_DRAIN = false, MID = false;
    float* tmp;
    __device__ __forceinline__ void operator()(const f32x4 (&acc)[2][2][4][2], const Unit& u, int wr, int wc, int fr, int fq) const {
        const int row0 = u.pm * 256 + wr * 64 + fr, col0 = u.pn * 256 + wc * 32 + 4 * fq;
#pragma unroll
        for (int ai = 0; ai < 2; ++ai)
#pragma unroll
            for (int m = 0; m < 4; ++m) { const size_t off = (size_t)(row0 + ai * 128 + m * 16) * 1024 + col0;
#pragma unroll
                for (int bj = 0; bj < 2; ++bj)
#pragma unroll
                    for (int n = 0; n < 2; ++n) *(f32x4*)(tmp + off + bj * 128 + n * 16) = acc[ai][bj][m][n]; }
    }
};
struct EpiGate {
    static constexpr bool PERM = false, AFTER_DRAIN = false, MID = false;
    const float* tmp; const float* bias; bf16_t* merged; int first;
    __device__ __forceinline__ void operator()(const f32x4 (&acc)[2][2][4][2], const Unit& u, int wr, int wc, int fr, int fq) const {
        const int row0 = u.pm * 256 + wr * 64 + fr, col0 = u.pn * 256 + wc * 32 + 4 * fq;
#pragma unroll
        for (int ai = 0; ai < 2; ++ai)
#pragma unroll
            for (int m = 0; m < 4; ++m) { const size_t off = (size_t)(row0 + ai * 128 + m * 16) * 1024 + col0;
#pragma unroll
                for (int bj = 0; bj < 2; ++bj)
#pragma unroll
                    for (int n = 0; n < 2; ++n) { const size_t o = off + bj * 128 + n * 16; const f32x4 tv = *(const f32x4*)(tmp + o), b = *(const f32x4*)(bias + col0 + bj * 128 + n * 16), a = acc[ai][bj][m][n];
                        f32x4 v;
#pragma unroll
                        for (int e = 0; e < 4; ++e) v[e] = sigmoidf_(a[e] + b[e]) * tv[e];
                        if (!first) { const u32x2 old = *(const u32x2*)(merged + o); v[0] += bflo(old.x); v[1] += bfhi(old.x); v[2] += bflo(old.y); v[3] += bfhi(old.y); }
                        u32x2 w; w.x = cvt_pk_bf16(v[0], v[1]); w.y = cvt_pk_bf16(v[2], v[3]); *(u32x2*)(merged + o) = w; } }
    }
};

struct EpiSig {
    static constexpr bool PERM = false, AFTER_DRAIN = false, MID = true;
    bf16_t* G; const float* bias; const float* rowss; int tlast; mutable float rsv[8];
    __device__ __forceinline__ void mid(f32x4 (&)[2][2][4][2], const Unit& u, int t, int wr, int wc, int fr, int fq) const {
        if (rowss == nullptr || t != tlast) return;
        const float* rp = rowss + u.pm * 256 + wr * 64 + fr;
#pragma unroll
        for (int i = 0; i < 8; ++i) rsv[i] = rp[(i >> 2) * 128 + (i & 3) * 16];
    }
    __device__ __forceinline__ void operator()(const f32x4 (&acc)[2][2][4][2], const Unit& u, int wr, int wc, int fr, int fq) const {
        const int row0 = u.pm * 256 + wr * 64 + fr, col0 = u.pn * 256 + wc * 32 + 8 * fq;
#pragma unroll
        for (int ai = 0; ai < 2; ++ai)
#pragma unroll
            for (int m = 0; m < 4; ++m) { const int row = row0 + ai * 128 + m * 16; const size_t off = (size_t)row * 3072 + col0; const float rs = rsqrtf(rsv[ai * 4 + m] * (1.0f / 1024.0f) + 1e-6f);
#pragma unroll
                for (int bj = 0; bj < 2; ++bj) { const f32x4 b0 = *(const f32x4*)(bias + col0 + bj * 128), b1 = *(const f32x4*)(bias + col0 + bj * 128 + 4), a0 = acc[ai][bj][m][0], a1 = acc[ai][bj][m][1];
                    u32x4 w; w.x = cvt_pk_bf16(sigmoidf_(a0[0] * rs + b0[0]), sigmoidf_(a0[1] * rs + b0[1])); w.y = cvt_pk_bf16(sigmoidf_(a0[2] * rs + b0[2]), sigmoidf_(a0[3] * rs + b0[3]));
                    w.z = cvt_pk_bf16(sigmoidf_(a1[0] * rs + b1[0]), sigmoidf_(a1[1] * rs + b1[1])); w.w = cvt_pk_bf16(sigmoidf_(a1[2] * rs + b1[2]), sigmoidf_(a1[3] * rs + b1[3]));
                    *(u32x4*)(G + off + bj * 128) = w; } }
    }
};
struct EpiMix {
    static constexpr bool PERM = false, AFTER_DRAIN = false, MID = true;
    const bf16_t* G; bf16_t* merged;
    __device__ __forceinline__ void mid(f32x4 (&acc)[2][2][4][2], const Unit& u, int t, int wr, int wc, int fr, int fq) const {
        if (t != 8 && t != 12) return;
        const bf16_t* gp = G + (size_t)(u.pm * 256 + wr * 64 + fr) * 3072 + ((t == 8) ? 0 : 1024) + u.pn * 256 + wc * 32 + 8 * fq;
#pragma unroll
        for (int ai = 0; ai < 2; ++ai) {
#pragma unroll
            for (int m = 0; m < 4; ++m) {
#pragma unroll
                for (int bj = 0; bj < 2; ++bj) { f32x4 n0, n1, d0, d1; unpk8(*(const u32x4*)(gp + bj * 128), n0, n1); unpk8(*(const u32x4*)(gp + 1024 + bj * 128), d0, d1);
                    f32x4 r0, r1;
#pragma unroll
                    for (int e = 0; e < 4; ++e) { r0[e] = n0[e] * fast_rcp(d0[e]); r1[e] = n1[e] * fast_rcp(d1[e]); }
                    acc[ai][bj][m][0] *= r0; acc[ai][bj][m][1] *= r1; }
                gp += 16 * 3072; asm volatile("" : "+v"(gp) :: "memory"); }
            gp += 64 * 3072; asm volatile("" : "+v"(gp)); }
    }
    __device__ __forceinline__ void operator()(const f32x4 (&acc)[2][2][4][2], const Unit& u, int wr, int wc, int fr, int fq) const {
        const int row0 = u.pm * 256 + wr * 64 + fr, col0 = u.pn * 256 + wc * 32 + 8 * fq;
        const bf16_t* gp = G + (size_t)row0 * 3072 + 2048 + col0; bf16_t* mp = merged + (size_t)row0 * 1024 + col0;
        u32x4 c0 = *(const u32x4*)gp, c1 = *(const u32x4*)(gp + 128);
#pragma unroll
        for (int g = 0; g < 8; ++g) {
            const int ai = g >> 2, m = g & 3;
            const bf16_t* gn = gp + ((m == 3) ? 80 * 3072 : 16 * 3072);
            asm volatile("" : "+v"(gn));
            u32x4 n0 = c0, n1 = c1; if (g < 7) { n0 = *(const u32x4*)gn; n1 = *(const u32x4*)(gn + 128); }
#pragma unroll
            for (int bj = 0; bj < 2; ++bj) { f32x4 g0, g1; unpk8(bj ? c1 : c0, g0, g1); const f32x4 v0 = acc[ai][bj][m][0] * g0, v1 = acc[ai][bj][m][1] * g1;
                u32x4 w; w.x = cvt_pk_bf16(v0[0], v0[1]); w.y = cvt_pk_bf16(v0[2], v0[3]); w.z = cvt_pk_bf16(v1[0], v1[1]); w.w = cvt_pk_bf16(v1[2], v1[3]); *(u32x4*)(mp + bj * 128) = w; }
            asm volatile("" ::: "memory");
            gp = gn; mp += (m == 3) ? 80 * 1024 : 16 * 1024; c0 = n0; c1 = n1;
        }
    }
};

template <class Epi>
__device__ __forceinline__ void run_gemm(LAS unsigned char* lds, const bf16_t* A, const bf16_t* Bt, int M, int N, int K, const Epi& E) {
    Gemm g; g.A = A; g.Bt = Bt; g.M = M; g.N = N; g.K = K;
    StaticOrder S; S.init(M, N, (int)gridDim.x, (int)blockIdx.x);
    pg8::gemm_phase<Epi, StaticOrder, false>(lds, g, S, E, nullptr);
    __syncthreads();
}

constexpr int KSTR = 144, VSTR = 136;
constexpr int LK0 = 0, LK1 = 64 * KSTR, LVT = 2 * 64 * KSTR, LVTSZ = 128 * VSTR, LEX = LVT + 2 * LVTSZ;
constexpr float SC_LOG2E = 0.125f * 1.4426950408889634f;

template <int DV, bool TWO>
__device__ __forceinline__ void attn_core(LAS unsigned char* lds, const bf16_t* Qw, int ldq, const bf16_t* K0p, const bf16_t* K1p, int ldk,
                                          const bf16_t* Vp, int ldv, int ntiles, bool skip_last, f32x4 (&o)[DV / 16][2]) {
    const int tid = opaque_tid(), wave = tid >> 6, lane = tid & 63, r = lane & 15, quad = lane >> 4;
    const int kmap = TWO ? (wave >> 2) : 0;
    bf16x8 qf[2][2];
#pragma unroll
    for (int qt = 0; qt < 2; ++qt)
#pragma unroll
        for (int ks = 0; ks < 2; ++ks) qf[qt][ks] = *(const bf16x8*)(Qw + (size_t)(qt * 16 + r) * ldq + ks * 32 + quad * 8);
    float mrow[2] = {-INFINITY, -INFINITY}, lrow[2] = {0.f, 0.f};
#pragma unroll
    for (int dt = 0; dt < DV / 16; ++dt) { o[dt][0] = (f32x4){0.f, 0.f, 0.f, 0.f}; o[dt][1] = (f32x4){0.f, 0.f, 0.f, 0.f}; }
    u32x4 kreg[2], vreg[2];
    const int k_map = TWO ? (tid >> 8) : 0, k_row = TWO ? ((tid >> 2) & 63) : (tid >> 3), k_d = TWO ? (tid & 3) * 16 : (tid & 7) * 8;
    const bf16_t* kbase = (k_map ? K1p : K0p) + (size_t)k_row * ldk + k_d;
    const bool v_on = (DV == 128) || tid < 256;
    const int v_kp = (DV == 128) ? (tid >> 4) : (tid >> 3), v_dg = (DV == 128) ? (tid & 15) : (tid & 7);
    const bf16_t* vbase = Vp + (size_t)(2 * v_kp) * ldv + v_dg * 8;
    auto gload = [&](int tile) {
        const bf16_t* kp = kbase + (size_t)tile * 64 * ldk;
        kreg[0] = *(const u32x4*)kp; if (TWO) kreg[1] = *(const u32x4*)(kp + 8);
        if (v_on) { const bf16_t* vp = vbase + (size_t)tile * 64 * ldv; vreg[0] = *(const u32x4*)vp; vreg[1] = *(const u32x4*)(vp + ldv); }
    };
    bf16x8 pbp[2][2];
    bool prev = false;
    auto pv_half = [&](int vbuf, int h) {
#pragma unroll
        for (int d2 = 0; d2 < DV / 32; ++d2) { const int dt = h * (DV / 32) + d2;
#pragma unroll
            for (int kk = 0; kk < 2; ++kk) { LAS const unsigned char* vrow = lds + LVT + vbuf * LVTSZ + (dt * 16 + r) * VSTR;
                const u32x2 lo = *(LAS const u32x2*)(vrow + (((16 * kk + 2 * quad) ^ (4 * dt)) << 2)), hi = *(LAS const u32x2*)(vrow + (((16 * kk + 8 + 2 * quad) ^ (4 * dt)) << 2));
                u32x4 w; w.x = lo.x; w.y = lo.y; w.z = hi.x; w.w = hi.y; const bf16x8 vf = __builtin_bit_cast(bf16x8, w);
                o[dt][0] = __builtin_amdgcn_mfma_f32_16x16x32_bf16(vf, pbp[0][kk], o[dt][0], 0, 0, 0);
                o[dt][1] = __builtin_amdgcn_mfma_f32_16x16x32_bf16(vf, pbp[1][kk], o[dt][1], 0, 0, 0); } }
    };
    gload(0);
    for (int tile = 0; tile < ntiles; ++tile) {
        const int vb = tile & 1;
        __syncthreads();
        { LAS unsigned char* kd = lds + (k_map ? LK1 : LK0) + k_row * KSTR + k_d * 2;
          *(LAS u32x4*)kd = kreg[0]; if (TWO) *(LAS u32x4*)(kd + 16) = kreg[1];
          if (v_on) {
#pragma unroll
              for (int e = 0; e < 8; ++e) { const unsigned a = vreg[0][e >> 1], b = vreg[1][e >> 1];
                  const unsigned w = (e & 1) ? ((a >> 16) | (b & 0xffff0000u)) : ((a & 0xffffu) | (b << 16));
                  *(LAS unsigned*)(lds + LVT + vb * LVTSZ + (v_dg * 8 + e) * VSTR + ((v_kp ^ ((v_dg >> 1) << 2)) << 2)) = w; } } }
        __syncthreads();
        const bool active = !(skip_last && tile == ntiles - 1);
        if (!active) { if (prev) { pv_half(vb ^ 1, 0); pv_half(vb ^ 1, 1); prev = false; } continue; }
        f32x4 s[4][2];
#pragma unroll
        for (int kt = 0; kt < 4; ++kt) { s[kt][0] = (f32x4){0.f, 0.f, 0.f, 0.f}; s[kt][1] = (f32x4){0.f, 0.f, 0.f, 0.f};
#pragma unroll
            for (int ks = 0; ks < 2; ++ks) { const bf16x8 kf = *(const LAS bf16x8*)(lds + (kmap ? LK1 : LK0) + (kt * 16 + r) * KSTR + (ks * 32 + quad * 8) * 2);
                s[kt][0] = __builtin_amdgcn_mfma_f32_16x16x32_bf16(kf, qf[0][ks], s[kt][0], 0, 0, 0);
                s[kt][1] = __builtin_amdgcn_mfma_f32_16x16x32_bf16(kf, qf[1][ks], s[kt][1], 0, 0, 0); } }
        float alpha[2];
        auto softmax_q = [&](int qt, bf16x8 (&dst)[2]) {
            float mx = s[0][qt][0];
#pragma unroll
            for (int kt = 0; kt < 4; ++kt)
#pragma unroll
                for (int j = 0; j < 4; ++j) mx = fmaxf(mx, s[kt][qt][j]);
            mx = xquad_max(mx);
            const float mn = fmaxf(mrow[qt], mx * SC_LOG2E);
            alpha[qt] = __builtin_amdgcn_exp2f(mrow[qt] - mn); mrow[qt] = mn;
            float ps = 0.f; float p[4][4];
#pragma unroll
            for (int kt = 0; kt < 4; ++kt)
#pragma unroll
                for (int j = 0; j < 4; ++j) { p[kt][j] = __builtin_amdgcn_exp2f(s[kt][qt][j] * SC_LOG2E - mn); ps += p[kt][j]; }
            lrow[qt] = lrow[qt] * alpha[qt] + ps;
#pragma unroll
            for (int kk = 0; kk < 2; ++kk) { u32x4 w; w.x = cvt_pk_bf16(p[2 * kk][0], p[2 * kk][1]); w.y = cvt_pk_bf16(p[2 * kk][2], p[2 * kk][3]);
                w.z = cvt_pk_bf16(p[2 * kk + 1][0], p[2 * kk + 1][1]); w.w = cvt_pk_bf16(p[2 * kk + 1][2], p[2 * kk + 1][3]);
                dst[kk] = __builtin_bit_cast(bf16x8, w); }
        };
        bf16x8 pb0[2];
        if (prev) pv_half(vb ^ 1, 0);
        softmax_q(0, pb0);
        if (prev) pv_half(vb ^ 1, 1);
        if (tile + 1 < ntiles) gload(tile + 1);
        softmax_q(1, pbp[1]);
        pbp[0][0] = pb0[0]; pbp[0][1] = pb0[1];
#pragma unroll
        for (int qt = 0; qt < 2; ++qt) {
            if (__builtin_amdgcn_ballot_w64(alpha[qt] != 1.0f) != 0ull) {
#pragma unroll
                for (int dt = 0; dt < DV / 16; ++dt) o[dt][qt] *= alpha[qt]; } }
        prev = true;
    }
    if (prev) { const int vb = (ntiles - 1) & 1; pv_half(vb, 0); pv_half(vb, 1); }
#pragma unroll
    for (int qt = 0; qt < 2; ++qt) { float l = lrow[qt]; l = xquad_sum(l); const float inv = 1.0f / l;
#pragma unroll
        for (int dt = 0; dt < DV / 16; ++dt) o[dt][qt] *= inv; }
}

__device__ __forceinline__ void attention_phase(KP P, LAS unsigned char* lds) {
    const int tid = opaque_tid(), wave = tid >> 6, lane = tid & 63, r = lane & 15, quad = lane >> 4;
    const bf16_t* proj = (const bf16_t*)(P->ws + WS_ACT);
    const bf16_t* kvm = (const bf16_t*)(P->ws + WS_KVM);
    unsigned* qctr = (unsigned*)(P->ws + WS_QCTR);
    LAS unsigned* qslot = (LAS unsigned*)(lds + 120000);
    for (;;) {
        __syncthreads();
        if (tid == 0) {
            const unsigned x0 = ((unsigned)__builtin_amdgcn_s_getreg((3 << 11) | 20)) & 7u  ; unsigned got = 0xffffffffu;
            for (unsigned k = 0; k < 8u; ++k) { const unsigned q = (x0 + k) & 7u; const unsigned idx = __hip_atomic_fetch_add(qctr + q * 64u, 1u, __ATOMIC_RELAXED, __HIP_MEMORY_SCOPE_AGENT);
                if (idx < 384u) { got = q * 384u + idx; break; } }
            *qslot = got; }
        __syncthreads();
        const unsigned gotv = *qslot;
        if (gotv == 0xffffffffu) break;
        const int qx = (int)(gotv / 384u), qi = (int)(gotv % 384u);
        if (qi < 256) {
        const int qb = 31 - (qi & 31), bh = (qi >> 5) * 8 + qx, b = bh >> 2, h = bh & 3, map = wave >> 2, wq = wave & 3;
        const size_t tok0 = (size_t)b * SEQ;
        const int q0 = qb * 128 + wq * 32;
        f32x4 o[8][2];
        attn_core<128, true>(lds, proj + (tok0 + q0) * PLO + (2 * h + map) * 64, PLO, proj + tok0 * PLO + 512 + (2 * h) * 64, proj + tok0 * PLO + 512 + (2 * h + 1) * 64, PLO,
                             proj + tok0 * PLO + 1024 + h * 128, PLO, 2 * qb + 2, wq < 2, o);
        LAS float* ex = (LAS float*)(lds + LEX) + (size_t)wq * 4096 + lane;
        if (map == 1) {
            const float s1 = wave_sum(P->lq1[lane] * P->lk1[lane]), s2 = wave_sum(P->lq2[lane] * P->lk2[lane]); const float lam = expf(s1) - expf(s2) + 0.2f;
#pragma unroll
            for (int dt = 0; dt < 8; ++dt)
#pragma unroll
                for (int qt = 0; qt < 2; ++qt)
#pragma unroll
                    for (int j = 0; j < 4; ++j) ex[((dt * 2 + qt) * 4 + j) * 64] = o[dt][qt][j] * lam;
        }
        __syncthreads();
        if (map == 0) {
#pragma unroll
            for (int qt = 0; qt < 2; ++qt) { float ss = 0.f;
#pragma unroll
                for (int dt = 0; dt < 8; ++dt)
#pragma unroll
                    for (int j = 0; j < 4; ++j) { const float v = o[dt][qt][j] - ex[((dt * 2 + qt) * 4 + j) * 64]; o[dt][qt][j] = v; ss += v * v; }
                ss = xquad_sum(ss);
                const float rs = rsqrtf(ss * (1.0f / 128.0f) + 1e-6f) * 0.8f;
                int ro = r * 1024 + quad * 4; asm volatile("" : "+v"(ro));
                bf16_t* op = (bf16_t*)(P->ws + WS_OA) + (tok0 + q0 + qt * 16) * 1024 + h * 128 + ro;
#pragma unroll
                for (int dt = 0; dt < 8; ++dt) { const f32x4 g = *(const f32x4*)(P->subln + dt * 16 + quad * 4); const f32x4 v = o[dt][qt] * g * rs;
                    u32x2 w; w.x = cvt_pk_bf16(v[0], v[1]); w.y = cvt_pk_bf16(v[2], v[3]); *(u32x2*)(op + dt * 16) = w; } }
        }
    }
        else { const int j = qi - 256;
        const int b = (j >> 6) * 8 + qx, qblk = b * 16 + ((j & 63) >> 2), hx = j & 3;
        const size_t tokq = (size_t)qblk * 256 + wave * 32;
        f32x4 o[4][2];
        attn_core<64, false>(lds, proj + tokq * PLO + 2560 + hx * 64, PLO, kvm + (size_t)b * 256 * 512 + hx * 64, nullptr, 512,
                             kvm + (size_t)b * 256 * 512 + 256 + hx * 64, 512, 4, false, o);
#pragma unroll
        for (int qt = 0; qt < 2; ++qt) { int ro = r * 1024 + quad * 4; asm volatile("" : "+v"(ro)); bf16_t* op = (bf16_t*)(P->ws + WS_OA) + 768 + (tokq + qt * 16) * 1024 + hx * 64 + ro;
#pragma unroll
            for (int dt = 0; dt < 4; ++dt) { const f32x4 v = o[dt][qt]; u32x2 w; w.x = cvt_pk_bf16(v[0], v[1]); w.y = cvt_pk_bf16(v[2], v[3]); *(u32x2*)(op + dt * 16) = w; } }
    }
    }
}

__device__ __forceinline__ float red16(float v) { v += DPP_F(v, 0xB1); v += DPP_F(v, 0x4E); v += DPP_F(v, 0x141); v += DPP_F(v, 0x140); return v; }
constexpr int SB = 64;
__device__ __forceinline__ void rwkv_scan(KP P, LAS unsigned char* lds, int wg) {
    const int bh = wg >> 1, half = wg & 1, b = bh >> 2, h = bh & 3, tid = opaque_tid();
    LAS float* __restrict__ vec = (LAS float*)lds;
    LAS float* __restrict__ ybuf = (LAS float*)lds + SB * 384;
    const bf16_t* proj = (const bf16_t*)(P->ws + WS_ACT);
    const float* dec = (const float*)(P->ws + WS_DEC);
    const bf16_t* asg = (const bf16_t*)(P->ws + WS_ASG);
    float* yraw = (float*)(P->ws + WS_YRAW);
    const int tl = tid >> 4, l4 = (tid & 15) * 4, c4 = h * 64 + l4;
    const f32x4 mu_r = *(const f32x4*)(P->rw_mu + c4), mu_k = *(const f32x4*)(P->rw_mu + 256 + c4), mu_v = *(const f32x4*)(P->rw_mu + 512 + c4);
    const f32x4 kkp = *(const f32x4*)(P->rw_k_k + c4), kap = *(const f32x4*)(P->rw_k_a + c4);
    const int il = tid >> 4, irow = half * 32 + il;
    f32x4 st = {0.f, 0.f, 0.f, 0.f};
    constexpr int NP = SB / 32;
    u32x2 ur[NP], uk[NP], uv[NP], urp[NP], ukp[NP], uvp[NP], as2[NP]; f32x4 dc[NP];
    const size_t tokb = (size_t)b * SEQ;
    auto load_raw = [&](int blk) {
#pragma unroll
        for (int q = 0; q < NP; ++q) {
        const int tt = blk * SB + tl + 32 * q; const size_t tok = tokb + tt;
        const bf16_t* base = proj + tok * PLO + 1536 + c4;
        ur[q] = *(const u32x2*)base; uk[q] = *(const u32x2*)(base + 256); uv[q] = *(const u32x2*)(base + 512);
        if (tt > 0) { urp[q] = *(const u32x2*)(base - PLO); ukp[q] = *(const u32x2*)(base - PLO + 256); uvp[q] = *(const u32x2*)(base - PLO + 512); }
        else { urp[q] = (u32x2){0u, 0u}; ukp[q] = urp[q]; uvp[q] = urp[q]; }
        dc[q] = *(const f32x4*)(dec + tok * 256 + c4); as2[q] = *(const u32x2*)(asg + tok * 256 + c4); }
    };
    auto prep = [&]() {
#pragma unroll
        for (int q = 0; q < NP; ++q) {
        const f32x4 r0 = unpk4(ur[q]), rp = unpk4(urp[q]), k0 = unpk4(uk[q]), kp = unpk4(ukp[q]), v0 = unpk4(uv[q]), vp = unpk4(uvp[q]), a = unpk4(as2[q]);
        const f32x4 rr = r0 + (rp - r0) * mu_r, kx = k0 + (kp - k0) * mu_k, vv = v0 + (vp - v0) * mu_v;
        f32x4 kk = kx * kkp;
        const float nrm = sqrtf(red16(kk[0] * kk[0] + kk[1] * kk[1] + kk[2] * kk[2] + kk[3] * kk[3]));
        kk = kk * fast_rcp(fmaxf(nrm, 1e-12f));
        const f32x4 kmod = kx * (1.0f + (a - 1.0f) * kap);
        LAS float* vt = vec + (tl + 32 * q) * 384 + l4;
        *(LAS f32x4*)(vt) = rr; *(LAS f32x4*)(vt + 64) = dc[q]; *(LAS f32x4*)(vt + 128) = kmod; *(LAS f32x4*)(vt + 192) = -kk; *(LAS f32x4*)(vt + 256) = kk * a; *(LAS f32x4*)(vt + 320) = vv; }
    };
    load_raw(0); prep(); __syncthreads();
    for (int blk = 0; blk < SEQ / SB; ++blk) {
        if (blk + 1 < SEQ / SB) load_raw(blk + 1);
        {
            LAS const float* vt = vec;
            f32x4 a4 = *(LAS const f32x4*)(vt + 192 + l4), w4 = *(LAS const f32x4*)(vt + 64 + l4), b4 = *(LAS const f32x4*)(vt + 256 + l4), k4 = *(LAS const f32x4*)(vt + 128 + l4), r4 = *(LAS const f32x4*)(vt + l4);
            float vi = vt[320 + irow], yprev = 0.f;
#pragma unroll 16
            for (int t = 0; t < SB; ++t) {
                const int tn = (t + 1 < SB) ? t + 1 : t; LAS const float* vn = vec + tn * 384;
                const f32x4 a4n = *(LAS const f32x4*)(vn + 192 + l4), w4n = *(LAS const f32x4*)(vn + 64 + l4), b4n = *(LAS const f32x4*)(vn + 256 + l4), k4n = *(LAS const f32x4*)(vn + 128 + l4), r4n = *(LAS const f32x4*)(vn + l4);
                const float vin = vn[320 + irow];
                float sa = st[0] * a4[0] + st[1] * a4[1] + st[2] * a4[2] + st[3] * a4[3];
                sa += DPP_F(sa, 0xB1); yprev += DPP_F(yprev, 0xB1);
                sa += DPP_F(sa, 0x4E); yprev += DPP_F(yprev, 0x4E);
                sa += DPP_F(sa, 0x141); yprev += DPP_F(yprev, 0x141);
                sa += DPP_F(sa, 0x140); yprev += DPP_F(yprev, 0x140);
                if (t > 0 && (tid & 15) == 0) ybuf[(t - 1) * 32 + il] = yprev;
                st = st * w4 + (b4 * sa + k4 * vi);
                yprev = st[0] * r4[0] + st[1] * r4[1] + st[2] * r4[2] + st[3] * r4[3];
                a4 = a4n; w4 = w4n; b4 = b4n; k4 = k4n; r4 = r4n; vi = vin; }
            yprev = red16(yprev);
            if ((tid & 15) == 0) ybuf[(SB - 1) * 32 + il] = yprev; }
        __syncthreads();
#pragma unroll
        for (int q = 0; q < NP; ++q) { const size_t tok = tokb + blk * SB + tl + 32 * q; const int p2 = (tid & 15) * 2;
          const float y0 = ybuf[(tl + 32 * q) * 32 + p2], y1 = ybuf[(tl + 32 * q) * 32 + p2 + 1];
          float2 yy; yy.x = y0; yy.y = y1;
          *(float2*)(yraw + tok * 256 + h * 64 + half * 32 + p2) = yy; }
        if (blk + 1 < SEQ / SB) prep();
        __syncthreads();
    }
}
__device__ __forceinline__ void rwkv_post(KP P) {
    const bf16_t* proj = (const bf16_t*)(P->ws + WS_ACT);
    const bf16_t* asg = (const bf16_t*)(P->ws + WS_ASG);
    const bf16_t* ggp = (const bf16_t*)(P->ws + WS_GG);
    const float* yraw = (const float*)(P->ws + WS_YRAW);
    bf16_t* ob = (bf16_t*)(P->ws + WS_OA) + 512;
    for (int idx = (int)blockIdx.x * 512 + opaque_tid(); idx < T * 64; idx += (int)gridDim.x * 512) {
        const int tok = idx >> 6, c4 = (idx & 63) * 4;
        const bf16_t* base = proj + (size_t)tok * PLO + 1536 + c4;
        const f32x4 r0 = unpk4(*(const u32x2*)base), k0 = unpk4(*(const u32x2*)(base + 256)), v0 = unpk4(*(const u32x2*)(base + 512));
        f32x4 rp = {0.f, 0.f, 0.f, 0.f}, kp = rp, vp = rp;
        if ((tok & (SEQ - 1)) != 0) { rp = unpk4(*(const u32x2*)(base - PLO)); kp = unpk4(*(const u32x2*)(base - PLO + 256)); vp = unpk4(*(const u32x2*)(base - PLO + 512)); }
        const f32x4 a = unpk4(*(const u32x2*)(asg + (size_t)tok * 256 + c4)), g = unpk4(*(const u32x2*)(ggp + (size_t)tok * 256 + c4));
        const f32x4 y = *(const f32x4*)(yraw + (size_t)tok * 256 + c4);
        const f32x4 mu_r = *(const f32x4*)(P->rw_mu + c4), mu_k = *(const f32x4*)(P->rw_mu + 256 + c4), mu_v = *(const f32x4*)(P->rw_mu + 512 + c4);
        const f32x4 kap = *(const f32x4*)(P->rw_k_a + c4), rkp = *(const f32x4*)(P->rw_r_k + c4), lnw = *(const f32x4*)(P->rw_ln_w + c4), lnb = *(const f32x4*)(P->rw_ln_b + c4);
        const f32x4 rr = r0 + (rp - r0) * mu_r, kx = k0 + (kp - k0) * mu_k, vv = v0 + (vp - v0) * mu_v;
        const f32x4 kmod = kx * (1.0f + (a - 1.0f) * kap), tb = rr * kmod * rkp;
        const float bon = red16(tb[0] + tb[1] + tb[2] + tb[3]);
        const float mean = red16(y[0] + y[1] + y[2] + y[3]) * (1.0f / 64.0f); const f32x4 d = y - mean;
        const float var = red16(d[0] * d[0] + d[1] * d[1] + d[2] * d[2] + d[3] * d[3]) * (1.0f / 64.0f);
        f32x4 yn = d * rsqrtf(var + 64e-5f) * lnw + lnb; yn = (yn + vv * bon) * g;
        u32x2 w; w.x = cvt_pk_bf16(yn[0], yn[1]); w.y = cvt_pk_bf16(yn[2], yn[3]);
        *(u32x2*)(ob + (size_t)tok * 1024 + c4) = w;
    }
}

#define XB_TMO      128
#define XB_XCNT(j)  (256  + 64 * (j))
#define XB_XSUB(j)  (1280 + 64 * (j))
#define XB_XGEN(j)  (2304 + 64 * (j))
#define XB_TOP      3328
#define XB_TOPGEN   3392
#define XCD_BAR_WORDS 3456
#define XB_SPIN_CAP (1u << 18)

__device__ __forceinline__ unsigned xb_ld(unsigned* p)              { return __hip_atomic_load(p, __ATOMIC_RELAXED, __HIP_MEMORY_SCOPE_AGENT); }
__device__ __forceinline__ unsigned xb_add(unsigned* p, unsigned v) { return __hip_atomic_fetch_add(p, v, __ATOMIC_RELAXED, __HIP_MEMORY_SCOPE_AGENT); }
__device__ __forceinline__ unsigned xb_xcc_id() { return (unsigned)__builtin_amdgcn_s_getreg((3 << 11) | 20) & 0xFu; }
#define XB_SPIN(cond, bar) do { unsigned _sp = 0; while (cond) { __builtin_amdgcn_s_sleep(1); \
    if ((++_sp & 255u) == 0u) { if (xb_ld(&(bar)[XB_TMO])) break; if (_sp > XB_SPIN_CAP) { atomicAdd(&(bar)[XB_TMO], 1u); break; } } } } while (0)

struct XcdBarrier {
    unsigned* bar; unsigned x;
    volatile PG8_LAS unsigned* st;
};

__device__ __forceinline__ XcdBarrier xcd_barrier_post(unsigned* bar, volatile PG8_LAS unsigned* st) {
    XcdBarrier b; b.bar = bar; b.x = xb_xcc_id(); b.st = st;
    if (threadIdx.x == 0) (void)xb_add(&bar[XB_XCNT(b.x)], 1u);
    return b;
}
__device__ __forceinline__ void xcd_barrier_complete(unsigned* bar, unsigned x, unsigned& nloc, unsigned& nx) {
    const unsigned G = gridDim.x * gridDim.y * gridDim.z;
    unsigned sum, cnt, mine, sp = 0u;
    for (;;) {
        sum = 0u; cnt = 0u; mine = 0u;
#pragma unroll
        for (unsigned j = 0; j < 16; ++j) { const unsigned c = xb_ld(&bar[XB_XCNT(j)]); sum += c; cnt += (c > 0u) ? 1u : 0u; mine = (j == x) ? c : mine; }
        if (sum == G) break;
        __builtin_amdgcn_s_sleep(1);
        if ((++sp & 255u) == 0u) { if (xb_ld(&bar[XB_TMO])) break; if (sp > XB_SPIN_CAP) { atomicAdd(&bar[XB_TMO], 1u); break; } }
    }
    nloc = mine > 0u ? mine : 1u; nx = cnt > 0u ? cnt : 1u;
}

__device__ __forceinline__ void xcd_barrier(const XcdBarrier& b) {
    asm volatile("s_waitcnt vmcnt(0)" ::: "memory");
    __syncthreads();
    if (threadIdx.x == 0) {
        unsigned* bar = b.bar;
        __builtin_amdgcn_s_waitcnt(0);
        unsigned nloc = b.st[0], nx = b.st[1];
        if (nloc == 0u) { xcd_barrier_complete(bar, b.x, nloc, nx); b.st[0] = nloc; b.st[1] = nx; }
        const unsigned old = xb_add(&bar[XB_XSUB(b.x)], 1u);
        const unsigned gen = old / nloc;
        if (old + 1u == (gen + 1u) * nloc) {
            __builtin_amdgcn_fence(__ATOMIC_RELEASE, "agent");
            asm volatile("s_waitcnt vmcnt(0)" ::: "memory");
            const unsigned og = xb_add(&bar[XB_TOP], 1u);
            const unsigned tg = og / nx;
            if (og + 1u == (tg + 1u) * nx) xb_add(&bar[XB_TOPGEN], 1u);
            else XB_SPIN(xb_ld(&bar[XB_TOPGEN]) == tg, bar);
            __builtin_amdgcn_fence(__ATOMIC_ACQUIRE, "agent");
            xb_add(&bar[XB_XGEN(b.x)], 1u);
            asm volatile("s_waitcnt vmcnt(0)" ::: "memory");
        } else {
            XB_SPIN(xb_ld(&bar[XB_XGEN(b.x)]) == gen, bar);
            __builtin_amdgcn_fence(__ATOMIC_ACQUIRE, "agent");
            asm volatile("s_waitcnt vmcnt(0)" ::: "memory");
        }
    }
    __syncthreads();
}
#define GRID_SYNC() do { XcdBarrier xb_; xb_.bar = (unsigned*)(ws + WS_BAR); xb_.x = xb_xcc_id(); xb_.st = (volatile PG8_LAS unsigned*)(lds + 131072); xcd_barrier(xb_); } while (0)
__global__ void __launch_bounds__(512, 2) fwd_megakernel(Params Pk_unused) {
#define P kp_fresh()
    extern __shared__ __attribute__((aligned(16))) unsigned char shm[];
    LAS unsigned char* lds = (LAS unsigned char*)shm;
    cg::grid_group grid = cg::this_grid();
#define ws (P->ws)
    const int nth = gridDim.x * 512;
#define GTID ((int)blockIdx.x * 512 + opaque_tid())
#define H ((bf16_t*)(ws + WS_H))
#define ACT ((bf16_t*)(ws + WS_ACT))
#define X (P->out)
#define CS ((float*)(ws + WS_CS))
    grid.sync();
    { volatile PG8_LAS unsigned* st = (volatile PG8_LAS unsigned*)(lds + 131072); if (threadIdx.x == 0) { st[0] = 0u; st[1] = 0u; } __syncthreads();
      (void)xcd_barrier_post((unsigned*)(ws + WS_BAR), st); }

    {
    { const float *w1 = P->ffn1_w1, *w3 = P->ffn1_w3, *w2 = P->ffn1_w2;
      conv_w((bf16_t*)(ws + W_UP1), 5632, 1024, [=](int R, int k) { return ((R & 128) ? w3 : w1)[(size_t)k * DFF + swiglu_col(R)]; }, lds);
      conv_w((bf16_t*)(ws + W_DN1), 1024, 2816, [=](int R, int k) { return w2[(size_t)k * 1024 + perm_col(R, false)]; }, lds); }
    { const float *w1 = P->ffn2_w1, *w3 = P->ffn2_w3, *w2 = P->ffn2_w2, *gn = P->ffn2_norm;
      conv_w((bf16_t*)(ws + W_UP2), 5632, 1024, [=](int R, int k) { return gn[k] * ((R & 128) ? w3 : w1)[(size_t)k * DFF + swiglu_col(R)]; }, lds);
      conv_w((bf16_t*)(ws + W_DN2), 1024, 2816, [=](int R, int k) { return w2[(size_t)k * 1024 + perm_col(R, false)]; }, lds); }
    { const float *wi = P->w_in, *gn = P->mix_norm;
      conv_w((bf16_t*)(ws + W_INLO), 2816, 1024, [=](int R, int k) { return gn[k] * wi[(size_t)k * PCOLS + perm_col(R, R < 1024)]; }, lds);
      conv_w((bf16_t*)(ws + W_GATE), 3072, 1024, [=](int R, int k) { return gn[k] * wi[(size_t)k * PCOLS + 2816 + perm_col(R, false)]; }, lds); }
    { const float *ua = P->w_up_a, *ub = P->w_up_b, *uc = P->w_up_c, *wo = P->w_out, *mk = P->w_mem_kv;
      conv_w((bf16_t*)(ws + W_UPA), 1024, 1024, [=](int R0, int k) { const int R = perm_col(R0, false); return k < 512 ? ua[(size_t)k * 1024 + R] : (k < 768 ? ub[(size_t)(k - 512) * 1024 + R] : uc[(size_t)(k - 768) * 1024 + R]); }, lds);
      conv_w((bf16_t*)(ws + W_OUT), 1024, 1024, [=](int R, int k) { return wo[(size_t)k * 1024 + perm_col(R, false)]; }, lds);
      conv_w((bf16_t*)(ws + W_MKV), 512, 1024, [=](int R, int k) { return mk[(size_t)k * 512 + perm_col(R, false)]; }, lds); }
    { const float *w2 = P->rw_w2, *a2 = P->rw_a2, *g2 = P->rw_g2;
      conv_w((bf16_t*)(ws + W_LR), 768, 256, [=](int R, int k) { float v = 0.f;
          if (R < 256) { if (k < 64) v = w2[k * 256 + R]; }
          else if (R < 512) { if (k >= 64 && k < 128) v = a2[(k - 64) * 256 + (R - 256)]; }
          else { if (k >= 128) v = g2[(k - 128) * 256 + (R - 512)]; }
          return v; }, lds); }
    for (int idx = GTID; idx < 2 * T; idx += nth) ((float*)(ws + WS_SS1))[idx] = 0.f;
    norm_rows(P->x, P->ffn1_norm, H, nullptr, T);
    norm_rows(P->mem, P->mem_norm, (bf16_t*)(ws + WS_HM), nullptr, MEMT);
    for (int idx = GTID; idx < T * 8; idx += nth) {
        const int t = idx >> 3, i = idx & 7;
        const float ang = (float)P->pos[t] * INVF[i];
        const double rev = (double)ang * 0.15915494309189535; const double fr = rev - rint(rev); const double rr = fr * 6.283185307179586, r2 = rr * rr;
        double cterm = 1.0, sterm = rr, cc = 1.0, sn = rr;
#pragma unroll
        for (int k = 1; k <= 14; ++k) { cterm *= -r2 * (1.0 / ((2.0 * k - 1.0) * (2.0 * k))); sterm *= -r2 * (1.0 / ((2.0 * k) * (2.0 * k + 1.0))); cc += cterm; sn += sterm; }
        CS[idx * 2] = (float)cc; CS[idx * 2 + 1] = (float)sn;
    }
    GRID_SYNC();
    { EpiSwiglu e; e.act = ACT; e.rowss = nullptr; e.tlast = 14; run_gemm(lds, H, (const bf16_t*)(ws + W_UP1), T, 5632, 1024, e); }
    GRID_SYNC();
    { EpiRes<true, false, false, true> e; e.resf = P->x; e.resb = nullptr; e.outf = nullptr; e.outb = H; e.rowss = (float*)(ws + WS_SS1); run_gemm(lds, ACT, (const bf16_t*)(ws + W_DN1), T, 1024, 2816, e); }
    GRID_SYNC();
    { EpiPerm e; e.O = ACT; e.ld = PLO; e.cs = CS; e.rowss = (const float*)(ws + WS_SS1); e.tlast = 14; run_gemm(lds, H, (const bf16_t*)(ws + W_INLO), T, 2816, 1024, e); }
    GRID_SYNC();
    { EpiPerm e; e.O = (bf16_t*)(ws + WS_KVM); e.ld = 512; e.cs = nullptr; e.rowss = nullptr; e.tlast = 14; run_gemm(lds, (const bf16_t*)(ws + WS_HM), (const bf16_t*)(ws + W_MKV), MEMT, 512, 1024, e); }
    { bf16_t* alr = (bf16_t*)(ws + WS_ALR);
      if (blockIdx.x >= 32) for (int idx = ((int)blockIdx.x - 32) * 512 + opaque_tid(); idx < T * 32; idx += ((int)gridDim.x - 32) * 512) {
          const int t = idx >> 5, col = (idx & 31) * 8;
          const bf16_t* up = ACT + (size_t)t * PLO + 1536 + 768 + col;
          const u32x4 cur = *(const u32x4*)up; u32x4 prv = {0u, 0u, 0u, 0u}; if ((t & (SEQ - 1)) != 0) prv = *(const u32x4*)(up - PLO);
          const f32x4 m0 = *(const f32x4*)(P->rw_mu + 768 + col), m1 = *(const f32x4*)(P->rw_mu + 768 + col + 4);
          float v[8];
#pragma unroll
          for (int e = 0; e < 8; ++e) { const float cu = (e & 1) ? bfhi(cur[e >> 1]) : bflo(cur[e >> 1]), pv = (e & 1) ? bfhi(prv[e >> 1]) : bflo(prv[e >> 1]);
              const float mu = e < 4 ? m0[e & 3] : m1[e & 3]; const float xs = cu + (pv - cu) * mu;
              v[e] = col < 64 ? (1.0f - 2.0f * fast_rcp(__expf(2.0f * xs) + 1.0f)) : (col < 128 ? xs : sigmoidf_(xs)); }
          u32x4 w; w.x = cvt_pk_bf16(v[0], v[1]); w.y = cvt_pk_bf16(v[2], v[3]); w.z = cvt_pk_bf16(v[4], v[5]); w.w = cvt_pk_bf16(v[6], v[7]);
          *(u32x4*)(alr + (size_t)t * 256 + col) = w; } }
    GRID_SYNC();
    { EpiLR e; e.dec = (float*)(ws + WS_DEC); e.asg = (bf16_t*)(ws + WS_ASG); e.gg = (bf16_t*)(ws + WS_GG); e.w0 = P->rw_w0; e.a0 = P->rw_a0;
      run_gemm(lds, (const bf16_t*)(ws + WS_ALR), (const bf16_t*)(ws + W_LR), T, 768, 256, e); }
    GRID_SYNC();
    if ((int)blockIdx.x < NSCAN) rwkv_scan(P, lds, blockIdx.x);
    attention_phase(P, lds);
    GRID_SYNC();
    rwkv_post(P);
    GRID_SYNC();
    { EpiSig e; e.G = (bf16_t*)(ws + WS_ACT); e.bias = P->gate_bias; e.rowss = (const float*)(ws + WS_SS1); e.tlast = 14; run_gemm(lds, H, (const bf16_t*)(ws + W_GATE), T, 3072, 1024, e); }
    GRID_SYNC();
    { EpiMix e; e.G = (const bf16_t*)(ws + WS_ACT); e.merged = (bf16_t*)(ws + WS_DEC); run_gemm(lds, (const bf16_t*)(ws + WS_OA), (const bf16_t*)(ws + W_UPA), T, 1024, 1024, e); }
    GRID_SYNC();
    { EpiRes<false, true, false, true> e; e.resf = nullptr; e.resb = H; e.outf = nullptr; e.outb = H; e.rowss = (float*)(ws + WS_SS2); run_gemm(lds, (const bf16_t*)(ws + WS_DEC), (const bf16_t*)(ws + W_OUT), T, 1024, 1024, e); }
    GRID_SYNC();
    { EpiSwiglu e; e.act = ACT; e.rowss = (const float*)(ws + WS_SS2); e.tlast = 14; run_gemm(lds, H, (const bf16_t*)(ws + W_UP2), T, 5632, 1024, e); }
    GRID_SYNC();
    { EpiRes<true, true, false, false> e; e.resf = nullptr; e.resb = H; e.outf = nullptr; e.outb = H; e.rowss = nullptr; run_gemm(lds, ACT, (const bf16_t*)(ws + W_DN2), T, 1024, 2816, e); }
    GRID_SYNC();
    norm_rows_b(H, P->final_norm, X, T);
    }
}

#undef P
#undef ws
#undef H
#undef ACT
#undef X
#undef CS
#undef GTID
extern "C" void kernel_launch(void* const* d_in, const int* in_sizes, int n_in, void* d_out, int out_size, void* d_ws, size_t ws_size, hipStream_t stream) {
    constexpr int LDS_BYTES = 131072 + 256;
    static int grid_blocks = 0;
    if (grid_blocks == 0) {
        if (n_in != 37 || ws_size < WS_END) { fprintf(stderr, "kernel_launch: unexpected inputs (n_in %d, ws %zu, need %zu)\n", n_in, ws_size, (size_t)WS_END); grid_blocks = -1; return; }
        int dev = 0, cus = 0, per_cu = 0;
        hipGetDevice(&dev);
        hipDeviceGetAttribute(&cus, hipDeviceAttributeMultiprocessorCount, dev);
        hipFuncSetAttribute((const void*)fwd_megakernel, hipFuncAttributeMaxDynamicSharedMemorySize, LDS_BYTES);
        hipOccupancyMaxActiveBlocksPerMultiprocessor(&per_cu, (const void*)fwd_megakernel, 512, LDS_BYTES);
        if (per_cu < 1) per_cu = 1;
        grid_blocks = cus * per_cu;
        (void)hipGetLastError();
    }
    if (grid_blocks < 0) return;
    hipMemsetAsync((unsigned char*)d_ws + WS_BAR, 0, 16384 + 2048, stream);
    Params p{};
    p.x = (const float*)d_in[0]; p.mem = (const float*)d_in[1]; p.pos = (const int*)d_in[2];
    p.ffn1_norm = (const float*)d_in[3]; p.ffn1_w1 = (const float*)d_in[4]; p.ffn1_w3 = (const float*)d_in[5]; p.ffn1_w2 = (const float*)d_in[6];
    p.mix_norm = (const float*)d_in[7]; p.w_in = (const float*)d_in[8]; p.gate_bias = (const float*)d_in[9];
    p.lq1 = (const float*)d_in[10]; p.lk1 = (const float*)d_in[11]; p.lq2 = (const float*)d_in[12]; p.lk2 = (const float*)d_in[13]; p.subln = (const float*)d_in[14];
    p.rw_mu = (const float*)d_in[15]; p.rw_w0 = (const float*)d_in[16]; p.rw_w2 = (const float*)d_in[17]; p.rw_a0 = (const float*)d_in[18]; p.rw_a2 = (const float*)d_in[19];
    p.rw_g2 = (const float*)d_in[20]; p.rw_k_k = (const float*)d_in[21]; p.rw_k_a = (const float*)d_in[22]; p.rw_r_k = (const float*)d_in[23];
    p.rw_ln_w = (const float*)d_in[24]; p.rw_ln_b = (const float*)d_in[25];
    p.mem_norm = (const float*)d_in[26]; p.w_mem_kv = (const float*)d_in[27]; p.w_up_a = (const float*)d_in[28]; p.w_up_b = (const float*)d_in[29]; p.w_up_c = (const float*)d_in[30];
    p.w_out = (const float*)d_in[31]; p.ffn2_norm = (const float*)d_in[32]; p.ffn2_w1 = (const float*)d_in[33]; p.ffn2_w3 = (const float*)d_in[34]; p.ffn2_w2 = (const float*)d_in[35];
    p.final_norm = (const float*)d_in[36];
    p.out = (float*)d_out; p.ws = (unsigned char*)d_ws;
    void* args[] = {&p};
    hipError_t e = hipLaunchCooperativeKernel((const void*)fwd_megakernel, dim3(grid_blocks), dim3(512), args, LDS_BYTES, stream);
    if (e != hipSuccess) fprintf(stderr, "cooperative launch failed: %s (grid %d)\n", hipGetErrorString(e), grid_blocks);
}
```
